# Optimizing an MI355X kernel written in HIP

```python
import math
import jax, jax.numpy as jnp
from jax import lax
import numpy as np

D_MODEL = 1024
BATCH = 8
SEQ = 4096
DEPTH = 1
DEC_BATCH = 128
DEC_SEQ = 8
PAST_LEN = 16384
PAGE_SIZE = 128

HEAD_DIM = 64
A_HEADS = 16
A_KV_HEADS = 4
A_GROUP = A_HEADS // A_KV_HEADS
A_WIDTH = A_HEADS * HEAD_DIM
KV_WIDTH = A_KV_HEADS * HEAD_DIM
WINDOW = 128
BLOCK = WINDOW
ATTN_SCALE = HEAD_DIM ** -0.5
N_BUCKETS = 32
MAX_DISTANCE = 128
B_HEADS = 16
B_WIDTH = B_HEADS * HEAD_DIM
DECAY_LORA = 64
A_LORA = 64
SHIFT_W = 3 * B_WIDTH + DECAY_LORA + A_LORA
GN_EPS = 64e-5
NORM_EPS = 1e-6
IN_SIZES = (A_WIDTH, KV_WIDTH, KV_WIDTH, A_WIDTH, SHIFT_W, B_WIDTH, D_MODEL, D_MODEL)
IN_COLS = 2 * A_WIDTH + 2 * KV_WIDTH + SHIFT_W + B_WIDTH + 2 * D_MODEL
SHIFT_SIZES = (B_WIDTH, B_WIDTH, B_WIDTH, DECAY_LORA, A_LORA)

kernel_name = "hybrid_swa_sink_rwkv7_gated_merge_step"


def _split(p, sizes):
    out, start = [], 0
    for n in sizes:
        out.append(p[..., start:start + n])
        start += n
    return out


def rmsnorm(x, g):
    xf = x.astype(jnp.float32)
    y = xf * lax.rsqrt(jnp.mean(xf * xf, axis=-1, keepdims=True) + NORM_EPS)
    return (y * g.astype(jnp.float32)).astype(x.dtype)


def t5_bucket(dist):
    max_exact = N_BUCKETS // 2
    d = jnp.maximum(dist, 1).astype(jnp.float32)
    large = max_exact + (jnp.log(d / max_exact) / math.log(MAX_DISTANCE / max_exact)
                         * (N_BUCKETS - max_exact)).astype(jnp.int32)
    large = jnp.minimum(large, N_BUCKETS - 1)
    return jnp.where(dist < max_exact, dist, large)


def window_bias(rel_bias, q_pos, k_pos):
    dist = q_pos[:, None] - k_pos[None, :]
    valid = (dist >= 0) & (dist <= WINDOW)
    bias = rel_bias.astype(jnp.float32)[t5_bucket(jnp.maximum(dist, 0))]
    bias = jnp.moveaxis(bias, -1, 0).reshape(A_KV_HEADS, A_GROUP, q_pos.shape[0], k_pos.shape[0])
    return bias, valid


def sink_softmax(s, sinks):
    sk = sinks.astype(jnp.float32)[..., None]
    m = jnp.maximum(jnp.max(s, axis=-1), sk)
    p = jnp.exp(s - m[..., None])
    denom = jnp.sum(p, axis=-1) + jnp.exp(sk - m)
    return p / denom[..., None]


def swa_banded(q, k, v, rel_bias, sinks):
    Bn, T = q.shape[0], q.shape[1]
    nb = T // BLOCK
    qb = q.reshape(Bn, nb, BLOCK, A_KV_HEADS, A_GROUP, HEAD_DIM)
    kb = k.reshape(Bn, nb, BLOCK, A_KV_HEADS, HEAD_DIM)
    vb = v.reshape(Bn, nb, BLOCK, A_KV_HEADS, HEAD_DIM)
    kband = jnp.concatenate([jnp.concatenate([jnp.zeros_like(kb[:, :1]), kb[:, :-1]], 1), kb], 2)
    vband = jnp.concatenate([jnp.concatenate([jnp.zeros_like(vb[:, :1]), vb[:, :-1]], 1), vb], 2)
    k_pos = jnp.arange(2 * BLOCK)
    bias, valid = window_bias(rel_bias, BLOCK + jnp.arange(BLOCK), k_pos)
    no_prev = (jnp.arange(nb)[:, None, None] == 0) & (k_pos[None, None, :] < BLOCK)
    valid_b = valid[None] & ~no_prev

    def one_sequence(args):
        qs, ks, vs = args
        s = jnp.einsum('nqhgd,nkhd->nhgqk', qs, ks, preferred_element_type=jnp.float32) * ATTN_SCALE + bias
        s = jnp.where(valid_b[:, None, None], s, -jnp.inf)
        p = sink_softmax(s, sinks)
        return jnp.einsum('nhgqk,nkhd->nqhgd', p.astype(vs.dtype), vs)

    o = lax.map(one_sequence, (qb, kband, vband))
    return o.reshape(Bn, T, A_WIDTH)


def swa_with_buffer(q, k, v, k_buf, v_buf, rel_bias, sinks):
    Bn, S = q.shape[0], q.shape[1]
    L = k_buf.shape[1]
    kc = jnp.concatenate([k_buf.astype(k.dtype), k], 1)
    vc = jnp.concatenate([v_buf.astype(v.dtype), v], 1)
    bias, valid = window_bias(rel_bias, L + jnp.arange(S), jnp.arange(L + S))
    s = jnp.einsum('bqhgd,bkhd->bhgqk', q, kc, preferred_element_type=jnp.float32) * ATTN_SCALE + bias
    s = jnp.where(valid, s, -jnp.inf)
    p = sink_softmax(s, sinks)
    o = jnp.einsum('bhgqk,bkhd->bqhgd', p.astype(vc.dtype), vc)
    return o.reshape(Bn, S, A_WIDTH), kc[:, S:], vc[:, S:]


def wkv_scan(r, w, k, v, a, b, S0):
    xs = tuple(jnp.moveaxis(t, 1, 0) for t in (r, w, k, v, a, b))

    def step(S, inp):
        rt, wt, kt, vt, at, bt = inp
        sa = jnp.einsum('bhvk,bhk->bhv', S, at)
        S = S * wt[:, :, None, :] + sa[..., None] * bt[:, :, None, :] + vt[..., None] * kt[:, :, None, :]
        return S, jnp.einsum('bhvk,bhk->bhv', S, rt)

    S_T, ys = lax.scan(step, S0.astype(jnp.float32), xs)
    return jnp.moveaxis(ys, 0, 1), S_T


def rwkv_time_mix(ps, shift0, wkv0, mu, w0, w2, a0, a2, k_k, k_a, r_k, lnx_g, lnx_b):
    Bn, T, _ = ps.shape
    prev = jnp.concatenate([shift0[:, None].astype(ps.dtype), ps[:, :-1]], 1)
    z = ps + (prev - ps) * mu
    r, k, v, wl, al = _split(z, SHIFT_SIZES)
    w_raw = -jax.nn.softplus(-(w0 + jnp.tanh(wl) @ w2)) - 0.5
    decay = jnp.exp(-jnp.exp(w_raw.astype(jnp.float32)))
    a = jax.nn.sigmoid((a0 + al @ a2).astype(jnp.float32))

    def heads(t):
        return t.reshape(Bn, T, B_HEADS, HEAD_DIM).astype(jnp.float32)

    r, k, v, a, decay = heads(r), heads(k), heads(v), heads(a), heads(decay)
    kk = k * k_k.reshape(B_HEADS, HEAD_DIM).astype(jnp.float32)
    kk = kk / jnp.maximum(jnp.sqrt(jnp.sum(kk * kk, axis=-1, keepdims=True)), 1e-12)
    k = k * (1.0 + (a - 1.0) * k_a.reshape(B_HEADS, HEAD_DIM).astype(jnp.float32))
    y, wkv_T = wkv_scan(r, decay, k, v, -kk, kk * a, wkv0)
    mean = jnp.mean(y, axis=-1, keepdims=True)
    var = jnp.mean(jnp.square(y - mean), axis=-1, keepdims=True)
    y = (y - mean) * lax.rsqrt(var + GN_EPS) * lnx_g.reshape(B_HEADS, HEAD_DIM).astype(jnp.float32) \
        + lnx_b.reshape(B_HEADS, HEAD_DIM).astype(jnp.float32)
    y = y + jnp.sum(r * k * r_k.astype(jnp.float32), axis=-1, keepdims=True) * v
    return y.reshape(Bn, T, B_WIDTH).astype(ps.dtype), wkv_T


def mixer_layer(x, k_buf, v_buf, wkv0, shift0, rel_bias, norm_g, w_in, sinks, mu, w0, w2, a0, a2,
                k_k, k_a, r_k, lnx_g, lnx_b, w_out_a, w_out_b, w_o):
    Bn, T, _ = x.shape
    h = rmsnorm(x, norm_g)
    p = jnp.einsum('btd,dc->btc', h, w_in)
    q, k, v, ga, ps, gb, ma, mb = _split(p, IN_SIZES)
    q = q.reshape(Bn, T, A_KV_HEADS, A_GROUP, HEAD_DIM)
    k = k.reshape(Bn, T, A_KV_HEADS, HEAD_DIM)
    v = v.reshape(Bn, T, A_KV_HEADS, HEAD_DIM)
    sinks_g = sinks.reshape(A_KV_HEADS, A_GROUP)
    if k_buf is None:
        o = swa_banded(q, k, v, rel_bias, sinks_g)
        keep = min(WINDOW, T)
        new_k, new_v = k[:, T - keep:], v[:, T - keep:]
        shift0 = jnp.zeros((Bn, SHIFT_W), ps.dtype)
        wkv0 = jnp.zeros((Bn, B_HEADS, HEAD_DIM, HEAD_DIM), jnp.float32)
    else:
        o, new_k, new_v = swa_with_buffer(q, k, v, k_buf, v_buf, rel_bias, sinks_g)
    ya = jnp.einsum('btc,cd->btd', o * jax.nn.silu(ga), w_out_a)
    yb_raw, wkv_T = rwkv_time_mix(ps, shift0, wkv0, mu, w0, w2, a0, a2, k_k, k_a, r_k, lnx_g, lnx_b)
    yb = jnp.einsum('btc,cd->btd', yb_raw * jax.nn.silu(gb), w_out_b)
    merged = jax.nn.sigmoid(ma) * ya + jax.nn.sigmoid(mb) * yb
    out = x + jnp.einsum('btd,de->bte', merged, w_o)
    return out, new_k, new_v, wkv_T, ps[:, -1]


def setup_inputs(seed: int = 0) -> dict:
    key = jax.random.key(seed)
    ks = jax.random.split(key, 24)

    def nrm(k, shape, scale):
        return jax.random.normal(k, shape, jnp.float32) * scale

    win = min(WINDOW, PAST_LEN)
    return {
        "x_prompt": nrm(ks[0], (BATCH, SEQ, D_MODEL), 1.0),
        "x_sample": nrm(ks[1], (DEC_BATCH, DEC_SEQ, D_MODEL), 1.0),
        "cache_k_win": nrm(ks[2], (DEPTH, DEC_BATCH, win, A_KV_HEADS, HEAD_DIM), 1.0),
        "cache_v_win": nrm(ks[3], (DEPTH, DEC_BATCH, win, A_KV_HEADS, HEAD_DIM), 1.0),
        "state_wkv": nrm(ks[4], (DEPTH, DEC_BATCH, B_HEADS, HEAD_DIM, HEAD_DIM), 0.3),
        "state_shift": nrm(ks[5], (DEPTH, DEC_BATCH, SHIFT_W), 1.0),
        "rel_bias": nrm(ks[6], (N_BUCKETS, A_HEADS), 0.3),
        "norm_g": 1.0 + nrm(ks[7], (DEPTH, D_MODEL), 0.02),
        "w_in": nrm(ks[8], (DEPTH, D_MODEL, IN_COLS), D_MODEL ** -0.5),
        "attn_sinks": nrm(ks[9], (DEPTH, A_HEADS), 0.5),
        "shift_mu": jax.random.uniform(ks[10], (DEPTH, SHIFT_W), jnp.float32),
        "rwkv_w0": jax.random.uniform(ks[11], (DEPTH, B_WIDTH), jnp.float32, -4.0, 1.0),
        "rwkv_w2": nrm(ks[12], (DEPTH, DECAY_LORA, B_WIDTH), 0.1 * DECAY_LORA ** -0.5),
        "rwkv_a0": nrm(ks[13], (DEPTH, B_WIDTH), 0.3),
        "rwkv_a2": nrm(ks[14], (DEPTH, A_LORA, B_WIDTH), 0.1 * A_LORA ** -0.5),
        "rwkv_k_k": 0.85 + nrm(ks[15], (DEPTH, B_WIDTH), 0.05),
        "rwkv_k_a": 1.0 + nrm(ks[16], (DEPTH, B_WIDTH), 0.05),
        "rwkv_r_k": nrm(ks[17], (DEPTH, B_HEADS, HEAD_DIM), 0.1),
        "lnx_g": 1.0 + nrm(ks[18], (DEPTH, B_WIDTH), 0.02),
        "lnx_b": nrm(ks[19], (DEPTH, B_WIDTH), 0.02),
        "w_out_a": nrm(ks[20], (DEPTH, A_WIDTH, D_MODEL), A_WIDTH ** -0.5),
        "w_out_b": nrm(ks[21], (DEPTH, B_WIDTH, D_MODEL), B_WIDTH ** -0.5),
        "w_o": nrm(ks[22], (DEPTH, D_MODEL, D_MODEL), D_MODEL ** -0.5),
        "final_g": 1.0 + nrm(ks[23], (D_MODEL,), 0.02),
    }


def reference(x_prompt, x_sample, cache_k_win, cache_v_win, state_wkv, state_shift, rel_bias, norm_g,
              w_in, attn_sinks, shift_mu, rwkv_w0, rwkv_w2, rwkv_a0, rwkv_a2, rwkv_k_k, rwkv_k_a,
              rwkv_r_k, lnx_g, lnx_b, w_out_a, w_out_b, w_o, final_g):
    hp, hs = x_prompt, x_sample
    pk, pv, pw, psh, sk, sv, sw, ssh = [], [], [], [], [], [], [], []
    for l in range(DEPTH):
        lw = (norm_g[l], w_in[l], attn_sinks[l], shift_mu[l], rwkv_w0[l], rwkv_w2[l], rwkv_a0[l],
              rwkv_a2[l], rwkv_k_k[l], rwkv_k_a[l], rwkv_r_k[l], lnx_g[l], lnx_b[l],
              w_out_a[l], w_out_b[l], w_o[l])
        hp, k1, v1, s1, t1 = mixer_layer(hp, None, None, None, None, rel_bias, *lw)
        hs, k2, v2, s2, t2 = mixer_layer(hs, cache_k_win[l], cache_v_win[l], state_wkv[l],
                                         state_shift[l], rel_bias, *lw)
        pk.append(k1); pv.append(v1); pw.append(s1); psh.append(t1)
        sk.append(k2); sv.append(v2); sw.append(s2); ssh.append(t2)
    y_prompt = rmsnorm(hp, final_g)
    y_sample = rmsnorm(hs, final_g)
    prompt_k_win, prompt_v_win = jnp.stack(pk), jnp.stack(pv)
    prompt_wkv, prompt_shift = jnp.stack(pw), jnp.stack(psh)
    sample_k_win, sample_v_win = jnp.stack(sk), jnp.stack(sv)
    sample_wkv, sample_shift = jnp.stack(sw), jnp.stack(ssh)
    return (y_prompt, y_sample, prompt_k_win, prompt_v_win, prompt_wkv, prompt_shift,
            sample_k_win, sample_v_win, sample_wkv, sample_shift)
```

```cpp
#include <hip/hip_runtime.h>
#include <cstdio>
#include <cstdint>
#include <cmath>
namespace pg8 {
#define PG8_LAS __attribute__((address_space(3)))
typedef unsigned short bf16_t;
typedef short bf16x8 __attribute__((ext_vector_type(8)));
typedef float f32x4 __attribute__((ext_vector_type(4)));
typedef unsigned u32x4 __attribute__((ext_vector_type(4)));
constexpr int BM = 256, BK = 64, HALF = 128, HTB = HALF * BK * 2  , STAGE_BYTES = 8 * HTB, NXCD = 8, WGM = 8;

__host__ __device__ __forceinline__ int lds_byte(int r, int c) { const int st = (r >> 4) * 2 + (c >> 5), rr = r & 15, cc = c & 31, ob = rr * 64 + cc * 2; return st * 1024 + (ob ^ (((ob >> 9) & 1) << 5)); }
__host__ __device__ __forceinline__ void stage_rc(int b, int& R, int& C) { const int st = b / 1024, sb = b % 1024, swz = sb ^ (((sb >> 9) & 1) << 5); R = (st >> 1) * 16 + swz / 64; C = (st & 1) * 32 + (swz % 64) / 2; }
__host__ __device__ __forceinline__ int perm32(int rho) { const int n = rho >> 4, i = rho & 15; return 8 * (i >> 2) + 4 * n + (i & 3); }

struct Unit { int pm, pn; };
struct Gemm { const bf16_t* A; const bf16_t* Bt; int M, N, K; };

struct StaticOrder {
    int nM, nN, nwg, G, c;
    __host__ __device__ void init(int M, int N, int G_, int c_) { nM = M / BM; nN = N / BM; nwg = nM * nN; G = G_; c = c_; }
    __host__ __device__ bool next(int i, Unit& u) const {
        const long L = (long)i * G + c; if (L >= nwg) return false;
        int wgid = (int)L; { const int q = nwg / NXCD, r = nwg % NXCD, xcd = wgid % NXCD, off = wgid / NXCD; wgid = (xcd < r ? xcd * (q + 1) : r * (q + 1) + (xcd - r) * q) + off; }
        const int nig = WGM * nN, gid = wgid / nig, fm = gid * WGM, gsz = (nM - fm) < WGM ? (nM - fm) : WGM;
        u.pm = fm + ((wgid % nig) % gsz); u.pn = (wgid % nig) / gsz; return true;
    }
    __device__ __forceinline__ void a_ready(const Unit&) const {}
    __device__ __forceinline__ void done(const Unit&) const {}
};

__device__ __forceinline__ unsigned cvt_pk_bf16(float lo, float hi) { unsigned r; asm volatile("v_cvt_pk_bf16_f32 %0, %1, %2" : "=v"(r) : "v"(lo), "v"(hi)); return r; }
typedef float f32x2 __attribute__((ext_vector_type(2)));
template <class Epi, class Sched, bool ALIGN_EPI = false, bool SP2 = false>
__device__ __forceinline__ void gemm_phase(PG8_LAS unsigned char* lds, const Gemm g, const Sched& S, const Epi& E) {
    const int tid = threadIdx.x, wid = __builtin_amdgcn_readfirstlane(tid >> 6), lane = tid & 63, wr = wid >> 2, wc = wid & 3, fr = lane & 15, fq = lane >> 4;
    const int K = g.K, nt = K / BK;
    unsigned voffA[2], voffB[2];
#pragma unroll
    for (int i = 0; i < 2; ++i) { int R, C; stage_rc(tid * 16 + i * 8192, R, C); const int Rb = Epi::PERM ? ((R & ~31) + perm32(R & 31)) : R;
        voffA[i] = (unsigned)(R * K + C) * 2u; voffB[i] = (unsigned)(Rb * K + C) * 2u; }
    const size_t kstep = (size_t)(BK * 2);
    const size_t hstep = (size_t)HALF * K * 2;
    const size_t tstep = 2 * hstep;
    const unsigned ldsw = (unsigned)wid * 1024u;
    const int aoff = lds_byte(wr * 64 + fr, fq * 8), boff = lds_byte(wc * 32 + fr, fq * 8);
#define PG8_SA(b, h) (((b) * 2 + (h)) * HTB)
#define PG8_SB(b, h) ((4 + (b) * 2 + (h)) * HTB)
#define PG8_STAGE(bufoff, gbase, voff) do { _Pragma("unroll") for (int _i = 0; _i < 2; ++_i) \
        __builtin_amdgcn_global_load_lds((const unsigned*)((const char*)(gbase) + (voff)[_i]), (PG8_LAS unsigned*)(lds + (bufoff) + ldsw + _i * 8192), 16, 0, 0); } while (0)
#define PG8_LDA(dst, b, h) do { _Pragma("unroll") for (int m = 0; m < 4; ++m) _Pragma("unroll") for (int k = 0; k < 2; ++k) dst[m][k] = *(const PG8_LAS bf16x8*)(lds + PG8_SA(b, h) + aoff + m * 2048 + k * 1024); } while (0)
#define PG8_LDB(dst, b, h) do { _Pragma("unroll") for (int n = 0; n < 2; ++n) _Pragma("unroll") for (int k = 0; k < 2; ++k) dst[n][k] = *(const PG8_LAS bf16x8*)(lds + PG8_SB(b, h) + boff + n * 2048 + k * 1024); } while (0)
#define PG8_MMA(ai, bj, At, Bt) do { __builtin_amdgcn_s_setprio(1); _Pragma("unroll") for (int m = 0; m < 4; ++m) _Pragma("unroll") for (int n = 0; n < 2; ++n) _Pragma("unroll") for (int k = 0; k < 2; ++k) \
        acc[ai][bj][m][n] = __builtin_amdgcn_mfma_f32_16x16x32_bf16(Bt[n][k], At[m][k], acc[ai][bj][m][n], 0, 0, 0); __builtin_amdgcn_s_setprio(0); } while (0)
#define PG8_WAIT_V(n) asm volatile("s_waitcnt vmcnt(" #n ")" ::: "memory")
#define PG8_WAIT_L(n) asm volatile("s_waitcnt lgkmcnt(" #n ")" ::: "memory")
#define PG8_BAR __builtin_amdgcn_s_barrier()
#define PG8_SCHED __builtin_amdgcn_sched_barrier(0)
    Unit cur, nxt; int ui = 0;
    if (!S.next(0, cur)) return;
    f32x4 acc[2][2][4][2];
#pragma unroll
    for (int a = 0; a < 2; ++a)
#pragma unroll
        for (int b = 0; b < 2; ++b)
#pragma unroll
            for (int m = 0; m < 4; ++m)
#pragma unroll
                for (int n = 0; n < 2; ++n) acc[a][b][m][n] = (f32x4){0.f, 0.f, 0.f, 0.f};
    bf16x8 At[4][2], B0[2][2], B1[2][2];
    const char* cA = (const char*)g.A + (size_t)cur.pm * tstep; const char* cB = (const char*)g.Bt + (size_t)cur.pn * tstep;
    S.a_ready(cur);
    if constexpr (SP2) {
        PG8_STAGE(PG8_SB(0, 0), cB, voffB); PG8_STAGE(PG8_SB(0, 1), cB + hstep, voffB); PG8_STAGE(PG8_SA(0, 0), cA, voffA); PG8_STAGE(PG8_SA(0, 1), cA + hstep, voffA);
        if (wr == 1) PG8_BAR;
        PG8_WAIT_V(2); PG8_BAR;
        PG8_STAGE(PG8_SB(1, 0), cB + kstep, voffB); PG8_STAGE(PG8_SA(1, 0), cA + kstep, voffA); PG8_STAGE(PG8_SB(1, 1), cB + hstep + kstep, voffB);
        PG8_WAIT_V(6); PG8_BAR;
    } else {
        PG8_STAGE(PG8_SB(0, 0), cB, voffB); PG8_STAGE(PG8_SA(0, 0), cA, voffA); PG8_STAGE(PG8_SB(0, 1), cB + hstep, voffB); PG8_STAGE(PG8_SA(0, 1), cA + hstep, voffA);
        if (wr == 1) PG8_BAR;
        PG8_WAIT_V(4); PG8_BAR;
        PG8_STAGE(PG8_SB(1, 0), cB + kstep, voffB); PG8_STAGE(PG8_SA(1, 0), cA + kstep, voffA); PG8_STAGE(PG8_SB(1, 1), cB + hstep + kstep, voffB);
        PG8_WAIT_V(6); PG8_BAR;
    }
    for (;;) {
        const bool has_next = S.next(ui + 1, nxt);
        const char* nA = has_next ? (const char*)g.A + (size_t)nxt.pm * tstep : cA; const char* nB = has_next ? (const char*)g.Bt + (size_t)nxt.pn * tstep : cB;
        for (int t = 0; t < nt; t += 2) {
            const bool last = (t == nt - 2);
            const char* a1 = cA + (size_t)(t + 1) * kstep;
            const char* a2 = last ? nA : cA + (size_t)(t + 2) * kstep; const char* b2 = last ? nB : cB + (size_t)(t + 2) * kstep;
            const char* a3 = a2 + kstep; const char* b3 = b2 + kstep;
            if (last && has_next) S.a_ready(nxt);
            if constexpr (SP2) {
            PG8_LDB(B0, 0, 0); PG8_LDB(B1, 0, 1); PG8_SCHED; PG8_LDA(At, 0, 0); PG8_STAGE(PG8_SA(1, 1), a1 + hstep, voffA);
            PG8_WAIT_V(8); PG8_WAIT_L(0); PG8_BAR; PG8_MMA(0, 0, At, B0); PG8_MMA(0, 1, At, B1); PG8_BAR; PG8_SCHED;
            PG8_LDA(At, 0, 1); PG8_STAGE(PG8_SB(0, 0), b2, voffB); PG8_STAGE(PG8_SB(0, 1), b2 + hstep, voffB); PG8_STAGE(PG8_SA(0, 0), a2, voffA);
            PG8_WAIT_V(8); PG8_WAIT_L(0); PG8_BAR; PG8_MMA(1, 0, At, B0); PG8_MMA(1, 1, At, B1); PG8_BAR; PG8_SCHED;
            PG8_LDB(B0, 1, 0); PG8_LDB(B1, 1, 1); PG8_SCHED; PG8_LDA(At, 1, 0); PG8_STAGE(PG8_SA(0, 1), a2 + hstep, voffA);
            PG8_WAIT_V(8); PG8_WAIT_L(0); PG8_BAR; PG8_MMA(0, 0, At, B0); PG8_MMA(0, 1, At, B1); PG8_BAR; PG8_SCHED;
            PG8_LDA(At, 1, 1); PG8_STAGE(PG8_SB(1, 0), b3, voffB); PG8_STAGE(PG8_SB(1, 1), b3 + hstep, voffB); PG8_STAGE(PG8_SA(1, 0), a3, voffA);
            PG8_WAIT_V(8); PG8_WAIT_L(0); PG8_BAR; PG8_MMA(1, 0, At, B0); PG8_MMA(1, 1, At, B1); PG8_BAR; PG8_SCHED;
            } else {
            PG8_LDB(B0, 0, 0); PG8_SCHED; PG8_LDA(At, 0, 0); PG8_STAGE(PG8_SA(1, 1), a1 + hstep, voffA);
            PG8_WAIT_L(8); PG8_BAR; PG8_WAIT_L(0); PG8_MMA(0, 0, At, B0); PG8_BAR; PG8_SCHED;
            PG8_LDB(B1, 0, 1); PG8_STAGE(PG8_SB(0, 0), b2, voffB);
            PG8_BAR; PG8_WAIT_L(0); PG8_MMA(0, 1, At, B1); PG8_BAR;
            PG8_LDA(At, 0, 1); PG8_STAGE(PG8_SA(0, 0), a2, voffA);
            PG8_BAR; PG8_WAIT_L(0); PG8_MMA(1, 0, At, B0); PG8_BAR; PG8_SCHED;
            PG8_STAGE(PG8_SB(0, 1), b2 + hstep, voffB);
            PG8_WAIT_V(6); PG8_BAR; PG8_MMA(1, 1, At, B1); PG8_BAR;
            PG8_LDB(B0, 1, 0); PG8_SCHED; PG8_LDA(At, 1, 0); PG8_STAGE(PG8_SA(0, 1), a2 + hstep, voffA);
            PG8_WAIT_L(8); PG8_BAR; PG8_WAIT_L(0); PG8_MMA(0, 0, At, B0); PG8_BAR; PG8_SCHED;
            PG8_LDB(B1, 1, 1); PG8_STAGE(PG8_SB(1, 0), b3, voffB);
            PG8_BAR; PG8_WAIT_L(0); PG8_MMA(0, 1, At, B1); PG8_BAR;
            PG8_LDA(At, 1, 1); PG8_STAGE(PG8_SA(1, 0), a3, voffA);
            PG8_BAR; PG8_WAIT_L(0); PG8_MMA(1, 0, At, B0); PG8_BAR; PG8_SCHED;
            PG8_STAGE(PG8_SB(1, 1), b3 + hstep, voffB);
            PG8_WAIT_V(6); PG8_BAR; PG8_MMA(1, 1, At, B1); PG8_BAR;
            }
        }
        if constexpr (ALIGN_EPI) { if (wr == 0) PG8_BAR; }
        if constexpr (!Epi::AFTER_DRAIN) { E(acc, cur, wr, wc, fr, fq); S.done(cur); }
        if (!has_next) break;
#pragma unroll
        for (int a = 0; a < 2; ++a)
#pragma unroll
            for (int b = 0; b < 2; ++b)
#pragma unroll
                for (int m = 0; m < 4; ++m)
#pragma unroll
                    for (int n = 0; n < 2; ++n) acc[a][b][m][n] = (f32x4){0.f, 0.f, 0.f, 0.f};
        cur = nxt; cA = nA; cB = nB; ++ui;
        if constexpr (ALIGN_EPI) { if (wr == 1) PG8_BAR; }
    }
    PG8_WAIT_V(0);
    if constexpr (!ALIGN_EPI) { if (wr == 0) PG8_BAR; }
    PG8_BAR;
    if constexpr (Epi::AFTER_DRAIN) { E.fused(acc, cur, wr, wc, fr, fq, lds, wid, lane); S.done(cur); }
#undef PG8_SA
#undef PG8_SB
#undef PG8_STAGE
#undef PG8_LDA
#undef PG8_LDB
#undef PG8_MMA
#undef PG8_WAIT_V
#undef PG8_WAIT_L
#undef PG8_BAR
#undef PG8_SCHED
}
}

constexpr int DM = 1024, NBATCH = 8, SEQ = 4096, DECB = 128, DECS = 8;
constexpr int MP = NBATCH * SEQ, MS = DECB * DECS, MT = MP + MS;
constexpr int HD = 64, NH = 16, NKV = 4, WIN = 128, KVW = 256;
constexpr int SHW = 3200, INC = 8832;
constexpr int N1A = 2560, N1B = 6400, N1 = N1A + N1B;
constexpr float NORM_EPS = 1e-6f, GN_EPS = 64e-5f;

constexpr size_t O_Y = 0;
constexpr size_t O_PKW = (size_t)MT * DM;
constexpr size_t O_PVW = O_PKW + (size_t)NBATCH * WIN * KVW;
constexpr size_t O_PWKV = O_PVW + (size_t)NBATCH * WIN * KVW;
constexpr size_t O_PSH = O_PWKV + (size_t)NBATCH * NH * HD * HD;
constexpr size_t O_SKW = O_PSH + (size_t)NBATCH * SHW;
constexpr size_t O_SVW = O_SKW + (size_t)DECB * WIN * KVW;
constexpr size_t O_SWKV = O_SVW + (size_t)DECB * WIN * KVW;
constexpr size_t O_SSH = O_SWKV + (size_t)DECB * NH * HD * HD;
constexpr size_t O_END = O_SSH + (size_t)DECB * SHW;
static_assert(O_END == 52864000, "output size");

constexpr size_t MiB = 1u << 20;
constexpr size_t WS_CTL = 0, CTL_ZERO_BYTES = 1 * MiB;
constexpr size_t WS_SS = 512 * 1024;
constexpr size_t WS_W1T = 2 * MiB;
constexpr size_t WS_WAT = 20 * MiB, WS_WBT = 22 * MiB, WS_WOT = 24 * MiB;
constexpr size_t WS_XN = 26 * MiB;
constexpr size_t WS_Q = 92 * MiB;
constexpr size_t WS_K = 158 * MiB;
constexpr size_t WS_V = WS_K + (size_t)MT * KVW * 2;
constexpr size_t WS_GA = 191 * MiB;
constexpr size_t WS_PS = 257 * MiB;
constexpr size_t WS_END = 464 * MiB;
static_assert(WS_W1T + (size_t)N1 * DM * 2 <= WS_WAT && WS_V + (size_t)MT * KVW * 2 <= WS_GA && WS_PS + (size_t)MT * SHW * 2 <= WS_END, "ws map");

constexpr int CW_BAR = 4096;

constexpr int RING_BYTES = 131072;
constexpr int LDSCTL_OFF = RING_BYTES, MISC_OFF = LDSCTL_OFF + 320, SMALL_OFF = LDSCTL_OFF + 1024;
constexpr int LDS_BYTES = 147456;
constexpr int NWAVES = 8, NTHR = 512;

#define GAS __attribute__((address_space(1)))
#define LAS __attribute__((address_space(3)))
typedef unsigned short bf16;
typedef unsigned v4u __attribute__((ext_vector_type(4)));
typedef unsigned v2u __attribute__((ext_vector_type(2)));
typedef float f32x4 __attribute__((ext_vector_type(4)));
typedef float f32x16 __attribute__((ext_vector_type(16)));
typedef short bf16x8 __attribute__((ext_vector_type(8)));
typedef GAS unsigned gu32;
#define RLX_AGENT __ATOMIC_RELAXED, __HIP_MEMORY_SCOPE_AGENT
#define LDS_WAIT() asm volatile("s_waitcnt lgkmcnt(0)" ::: "memory")
#define VM_WAIT() asm volatile("s_waitcnt vmcnt(0)" ::: "memory")
__device__ __forceinline__ unsigned f2bf(float f) { unsigned u = __builtin_bit_cast(unsigned, f); return (u + 0x7fffu + ((u >> 16) & 1u)) >> 16; }
__device__ __forceinline__ unsigned pk2(float lo, float hi) { return f2bf(lo) | (f2bf(hi) << 16); }
__device__ __forceinline__ float bflo(unsigned u) { return __builtin_bit_cast(float, u << 16); }
__device__ __forceinline__ float bfhi(unsigned u) { return __builtin_bit_cast(float, u & 0xffff0000u); }
__device__ __forceinline__ float sigmoidf_(float x) { return __builtin_amdgcn_rcpf(1.0f + __expf(-x)); }

#define XB_TMO      128
#define XB_XCNT(j)  (256  + 64 * (j))
#define XB_XSUB(j)  (1280 + 64 * (j))
#define XB_XGEN(j)  (2304 + 64 * (j))
#define XB_TOP      3328
#define XB_TOPGEN   3392
#define XCD_BAR_WORDS 3456
#define XB_SPIN_CAP (1u << 23)
__device__ __forceinline__ unsigned xb_ld(unsigned* p)              { return __hip_atomic_load(p, __ATOMIC_RELAXED, __HIP_MEMORY_SCOPE_AGENT); }
__device__ __forceinline__ unsigned xb_add(unsigned* p, unsigned v) { return __hip_atomic_fetch_add(p, v, __ATOMIC_RELAXED, __HIP_MEMORY_SCOPE_AGENT); }
__device__ __forceinline__ unsigned xb_xcc_id() { return (unsigned)__builtin_amdgcn_s_getreg((3 << 11) | 20) & 0xFu; }
#define XB_SPIN(cond, bar) do { unsigned _sp = 0; while (cond) { __builtin_amdgcn_s_sleep(1); \
    if ((++_sp & 255u) == 0u) { if (xb_ld(&(bar)[XB_TMO])) break; if (_sp > XB_SPIN_CAP) { atomicAdd(&(bar)[XB_TMO], 1u); break; } } } } while (0)
struct XcdBarrier { unsigned* bar; unsigned x; volatile LAS unsigned* st; };
__device__ __forceinline__ XcdBarrier xcd_barrier_post(unsigned* bar, volatile LAS unsigned* st) {
    XcdBarrier b; b.bar = bar; b.x = xb_xcc_id(); b.st = st;
    if (threadIdx.x == 0) (void)xb_add(&bar[XB_XCNT(b.x)], 1u);
    return b;
}
__device__ __forceinline__ void xcd_barrier_complete(unsigned* bar, unsigned x, unsigned& nloc, unsigned& nx) {
    const unsigned G = gridDim.x * gridDim.y * gridDim.z;
    unsigned sum, cnt, mine, sp = 0u;
    for (;;) {
        sum = 0u; cnt = 0u; mine = 0u;
#pragma unroll
        for (unsigned j = 0; j < 16; ++j) { const unsigned c = xb_ld(&bar[XB_XCNT(j)]); sum += c; cnt += (c > 0u) ? 1u : 0u; mine = (j == x) ? c : mine; }
        if (sum == G) break;
        __builtin_amdgcn_s_sleep(1);
        if ((++sp & 255u) == 0u) { if (xb_ld(&bar[XB_TMO])) break; if (sp > XB_SPIN_CAP) { atomicAdd(&bar[XB_TMO], 1u); break; } }
    }
    nloc = mine > 0u ? mine : 1u; nx = cnt > 0u ? cnt : 1u;
}
__device__ __forceinline__ void xcd_barrier(const XcdBarrier& b) {
    asm volatile("s_waitcnt vmcnt(0)" ::: "memory");
    __syncthreads();
    if (threadIdx.x == 0) {
        unsigned* bar = b.bar;
        __builtin_amdgcn_s_waitcnt(0);
        unsigned nloc = b.st[0], nx = b.st[1];
        if (nloc == 0u) { xcd_barrier_complete(bar, b.x, nloc, nx); b.st[0] = nloc; b.st[1] = nx; }
        const unsigned old = xb_add(&bar[XB_XSUB(b.x)], 1u);
        const unsigned gen = old / nloc;
        if (old + 1u == (gen + 1u) * nloc) {
            __builtin_amdgcn_fence(__ATOMIC_RELEASE, "agent");
            asm volatile("s_waitcnt vmcnt(0)" ::: "memory");
            const unsigned og = xb_add(&bar[XB_TOP], 1u);
            const unsigned tg = og / nx;
            if (og + 1u == (tg + 1u) * nx) xb_add(&bar[XB_TOPGEN], 1u);
            else XB_SPIN(xb_ld(&bar[XB_TOPGEN]) == tg, bar);
            __builtin_amdgcn_fence(__ATOMIC_ACQUIRE, "agent");
            xb_add(&bar[XB_XGEN(b.x)], 1u);
            asm volatile("s_waitcnt vmcnt(0)" ::: "memory");
        } else {
            XB_SPIN(xb_ld(&bar[XB_XGEN(b.x)]) == gen, bar);
            __builtin_amdgcn_fence(__ATOMIC_ACQUIRE, "agent");
            asm volatile("s_waitcnt vmcnt(0)" ::: "memory");
        }
    }
    __syncthreads();
}

struct Args { const float* in[24]; float* out; unsigned char* ws; int ph_lo, ph_hi; };
static_assert(sizeof(Args) == 24 * 8 + 8 + 8 + 8, "no padding");
struct Frame {
    LAS unsigned char* lds;
    int wave, G, vcu;
    float* out; unsigned char* ws;
};
__device__ __forceinline__ int lane_id() { return (int)__builtin_amdgcn_mbcnt_hi(~0u, __builtin_amdgcn_mbcnt_lo(~0u, 0u)); }
enum { I_XP = 0, I_XS, I_CK, I_CV, I_SWKV, I_SSHIFT, I_RELB, I_NORMG, I_WIN, I_SINK, I_MU, I_W0, I_W2, I_A0, I_A2, I_KK, I_KA, I_RK, I_LNG, I_LNB, I_WOA, I_WOB, I_WO, I_FING };

__device__ __forceinline__ float wave_sum(float v) {
#pragma unroll
    for (int o = 1; o < 64; o <<= 1) v += __shfl_xor(v, o);
    return v;
}

__device__ __forceinline__ void p0_transpose_item(const float* W, int ldw, int srccol0, int K, bf16* WT, int dstrow0, LAS float* scr, int kb, int lane) {
    const int k0 = 64 * kb;
    if (srccol0 >= 0) {
#pragma unroll 8
        for (int i = 0; i < 32; ++i) { const int kk = 2 * i + (lane >> 5); scr[kk * 33 + (lane & 31)] = W[(size_t)(k0 + kk) * ldw + srccol0 + (lane & 31)]; }
    }
    LDS_WAIT(); asm volatile("" ::: "memory");
    const int c = lane & 7;
#pragma unroll
    for (int j = 0; j < 4; ++j) { const int n = (lane >> 3) + 8 * j; const LAS float* s = scr + (8 * c) * 33 + n;
        v4u o = (v4u){0u, 0u, 0u, 0u};
        if (srccol0 >= 0) { o.x = pk2(s[0 * 33], s[1 * 33]); o.y = pk2(s[2 * 33], s[3 * 33]); o.z = pk2(s[4 * 33], s[5 * 33]); o.w = pk2(s[6 * 33], s[7 * 33]); }
        *(GAS v4u*)(WT + (size_t)(dstrow0 + n) * K + k0 + 8 * c) = o; }
    LDS_WAIT(); asm volatile("" ::: "memory");
}
__device__ __forceinline__ void rms_row_to_bf16(const float* xrow, const float* g, bf16* orow, int lane) {
    const GAS f32x4* xr = (const GAS f32x4*)xrow + lane; const GAS f32x4* gr = (const GAS f32x4*)g + lane;
    f32x4 v[4]; float s = 0.f;
#pragma unroll
    for (int j = 0; j < 4; ++j) { v[j] = xr[64 * j]; s += (v[j].x * v[j].x + v[j].y * v[j].y) + (v[j].z * v[j].z + v[j].w * v[j].w); }
    const float sc = 1.0f / sqrtf(wave_sum(s) * (1.f / DM) + NORM_EPS);
    GAS v2u* o8 = (GAS v2u*)orow + lane;
#pragma unroll
    for (int j = 0; j < 4; ++j) { const f32x4 gv = gr[64 * j]; v2u o; o.x = pk2(v[j].x * sc * gv.x, v[j].y * sc * gv.y); o.y = pk2(v[j].z * sc * gv.z, v[j].w * sc * gv.w); o8[64 * j] = o; }
}
__device__ __forceinline__ void p0_prologue(const Frame& F, const Args& AR) {
    const int lane = lane_id();
    LAS float* scr = (LAS float*)(F.lds + F.wave * 16384);
    const int gw = F.vcu * NWAVES + F.wave, NGW = F.G * NWAVES;
    constexpr int I_1 = 16 * (N1 / 32), I_S = 16 * 32, NITEMS = I_1 + 3 * I_S;
    bf16* W1T = (bf16*)(F.ws + WS_W1T);
    for (int it = gw; it < NITEMS; it += NGW) {
        int r = it;
        if (r < I_1) { const int kb = r / (N1 / 32), nb = r % (N1 / 32), n0 = 32 * nb;
            const int src = n0 < 5760 ? n0 : (n0 < 5888 ? -1 : n0 - 128);
            p0_transpose_item(AR.in[I_WIN], INC, src, DM, W1T, n0, scr, kb, lane); continue; }
        r -= I_1;
        const int which = r / I_S; r -= which * I_S;
        const float* W = which == 0 ? AR.in[I_WOA] : (which == 1 ? AR.in[I_WOB] : AR.in[I_WO]);
        bf16* WT = (bf16*)(F.ws + (which == 0 ? WS_WAT : (which == 1 ? WS_WBT : WS_WOT)));
        p0_transpose_item(W, DM, 32 * (r % 32), DM, WT, 32 * (r % 32), scr, r / 32, lane);
    }
    bf16* XN = (bf16*)(F.ws + WS_XN);
    for (int m = gw; m < MT; m += NGW) {
        const float* xr = m < MP ? AR.in[I_XP] + (size_t)m * DM : AR.in[I_XS] + (size_t)(m - MP) * DM;
        rms_row_to_bf16(xr, AR.in[I_NORMG], XN + (size_t)m * DM, lane);
    }
}

struct EpiG1 {
    static constexpr bool PERM = true, AFTER_DRAIN = false;
    int part; unsigned char* ws; float* out;
    __device__ __forceinline__ void operator()(const f32x4 (&acc)[2][2][4][2], const pg8::Unit& u, int wr, int wc, int fr, int fq) const {
        bf16* dst; int ld, act = 0, valid = 256, side = 0;
        const int pn = u.pn;
        if (part == 0) {
            if (pn < 4) { dst = (bf16*)(ws + WS_Q) + pn * 256; ld = DM; }
            else if (pn == 4) { dst = (bf16*)(ws + WS_K); ld = KVW; side = 1; }
            else if (pn == 5) { dst = (bf16*)(ws + WS_V); ld = KVW; side = 2; }
            else { dst = (bf16*)(ws + WS_GA) + (pn - 6) * 256; ld = DM; act = 1; }
        } else {
            if (pn < 13) { dst = (bf16*)(ws + WS_PS) + pn * 256; ld = SHW; side = 3; if (pn == 12) valid = 128; }
            else if (pn < 17) { dst = (bf16*)(ws + WS_GA) + (pn - 13) * 256; ld = DM; act = 1; }
            else if (pn < 21) { dst = (bf16*)out + (pn - 17) * 256; ld = DM; act = 2; }
            else { dst = (bf16*)out + (size_t)MT * DM + (pn - 21) * 256; ld = DM; act = 2; }
        }
        const int rt0 = wr * 64 + fr, cit0 = wc * 32 + 8 * fq;
#pragma unroll
        for (int ai = 0; ai < 2; ++ai)
#pragma unroll
            for (int m = 0; m < 4; ++m) { bf16* rowp = dst + (size_t)(u.pm * 256 + rt0 + ai * 128 + m * 16) * ld + cit0;
#pragma unroll
                for (int bj = 0; bj < 2; ++bj) { if (bj * 128 >= valid) continue;
                    f32x4 v0 = acc[ai][bj][m][0], v1 = acc[ai][bj][m][1];
                    if (act) {
#pragma unroll
                        for (int e = 0; e < 4; ++e) { const float s0 = sigmoidf_(v0[e]), s1 = sigmoidf_(v1[e]); v0[e] = act == 1 ? v0[e] * s0 : s0; v1[e] = act == 1 ? v1[e] * s1 : s1; }
                    }
                    pg8::u32x4 w; w.x = pg8::cvt_pk_bf16(v0[0], v0[1]); w.y = pg8::cvt_pk_bf16(v0[2], v0[3]); w.z = pg8::cvt_pk_bf16(v1[0], v1[1]); w.w = pg8::cvt_pk_bf16(v1[2], v1[3]);
                    *(pg8::u32x4*)(rowp + bj * 128) = w; } }
        int r0 = rt0, c0 = cit0;
        if (side) asm volatile("" : "+v"(r0), "+v"(c0));
        if (side == 1 || side == 2) {
            if (u.pm < 128) {
                if ((u.pm & 15) == 15) { float* base = out + (side == 1 ? O_PKW : O_PVW) + (size_t)(u.pm >> 4) * WIN * KVW;
#pragma unroll
                    for (int m = 0; m < 4; ++m) { float* rp = base + (size_t)(r0 + m * 16) * KVW + c0;
#pragma unroll
                        for (int bj = 0; bj < 2; ++bj)
#pragma unroll
                            for (int n = 0; n < 2; ++n) *(f32x4*)(rp + bj * 128 + 4 * n) = acc[1][bj][m][n]; } }
            } else { float* base = out + (side == 1 ? O_SKW : O_SVW);
#pragma unroll
                for (int ai = 0; ai < 2; ++ai)
#pragma unroll
                    for (int m = 0; m < 4; ++m) { const int rs = (u.pm - 128) * 256 + r0 + ai * 128 + m * 16; float* rp = base + ((size_t)(rs >> 3) * WIN + 120 + (rs & 7)) * KVW + c0;
#pragma unroll
                        for (int bj = 0; bj < 2; ++bj)
#pragma unroll
                            for (int n = 0; n < 2; ++n) *(f32x4*)(rp + bj * 128 + 4 * n) = acc[ai][bj][m][n]; }
            }
        } else if (side == 3) {
            if (u.pm < 128) {
                if ((u.pm & 15) == 15 && wr == 1 && fr == 15) { float* rp = out + O_PSH + (size_t)(u.pm >> 4) * SHW + pn * 256 + c0;
#pragma unroll
                    for (int bj = 0; bj < 2; ++bj) { if (bj * 128 >= valid) continue;
#pragma unroll
                        for (int n = 0; n < 2; ++n) *(f32x4*)(rp + bj * 128 + 4 * n) = acc[1][bj][3][n]; } }
            } else if ((fr & 7) == 7) {
#pragma unroll
                for (int ai = 0; ai < 2; ++ai)
#pragma unroll
                    for (int m = 0; m < 4; ++m) { const int rs = (u.pm - 128) * 256 + r0 + ai * 128 + m * 16; float* rp = out + O_SSH + (size_t)(rs >> 3) * SHW + pn * 256 + c0;
#pragma unroll
                        for (int bj = 0; bj < 2; ++bj) { if (bj * 128 >= valid) continue;
#pragma unroll
                            for (int n = 0; n < 2; ++n) *(f32x4*)(rp + bj * 128 + 4 * n) = acc[ai][bj][m][n]; } }
            }
        }
    }
};
struct EpiGate {
    static constexpr bool PERM = true, AFTER_DRAIN = false;
    int mode; const bf16* gate; const bf16* tin; bf16* dst;
    __device__ __forceinline__ void operator()(const f32x4 (&acc)[2][2][4][2], const pg8::Unit& u, int wr, int wc, int fr, int fq) const {
        const int rt0 = u.pm * 256 + wr * 64 + fr, c0 = u.pn * 256 + wc * 32 + 8 * fq;
#pragma unroll
        for (int ai = 0; ai < 2; ++ai)
#pragma unroll
            for (int m = 0; m < 4; ++m) { const size_t ro = (size_t)(rt0 + ai * 128 + m * 16) * DM + c0;
#pragma unroll
                for (int bj = 0; bj < 2; ++bj) {
                    const v4u g = *(const v4u*)(gate + ro + bj * 128);
                    f32x4 v0 = acc[ai][bj][m][0], v1 = acc[ai][bj][m][1];
                    v0[0] *= bflo(g.x); v0[1] *= bfhi(g.x); v0[2] *= bflo(g.y); v0[3] *= bfhi(g.y); v1[0] *= bflo(g.z); v1[1] *= bfhi(g.z); v1[2] *= bflo(g.w); v1[3] *= bfhi(g.w);
                    if (mode == 1) { const v4u t = *(const v4u*)(tin + ro + bj * 128);
                        v0[0] += bflo(t.x); v0[1] += bfhi(t.x); v0[2] += bflo(t.y); v0[3] += bfhi(t.y); v1[0] += bflo(t.z); v1[1] += bfhi(t.z); v1[2] += bflo(t.w); v1[3] += bfhi(t.w); }
                    pg8::u32x4 w; w.x = pg8::cvt_pk_bf16(v0[0], v0[1]); w.y = pg8::cvt_pk_bf16(v0[2], v0[3]); w.z = pg8::cvt_pk_bf16(v1[0], v1[1]); w.w = pg8::cvt_pk_bf16(v1[2], v1[3]);
                    *(pg8::u32x4*)(dst + ro + bj * 128) = w; } }
    }
};
struct EpiOut {
    static constexpr bool PERM = false, AFTER_DRAIN = false;
    const float* xp; const float* xs; float* out; float* ss;
    __device__ __forceinline__ void operator()(const f32x4 (&acc)[2][2][4][2], const pg8::Unit& u, int wr, int wc, int fr, int fq) const {
        const int rt0 = u.pm * 256 + wr * 64 + fr, c0 = u.pn * 256 + wc * 32 + 4 * fq;
#pragma unroll
        for (int ai = 0; ai < 2; ++ai)
#pragma unroll
            for (int m = 0; m < 4; ++m) { const int row = rt0 + ai * 128 + m * 16;
                const float* xr = (row < MP ? xp + (size_t)row * DM : xs + (size_t)(row - MP) * DM) + c0; float* orow = out + (size_t)row * DM + c0; float s = 0.f;
#pragma unroll
                for (int bj = 0; bj < 2; ++bj)
#pragma unroll
                    for (int n = 0; n < 2; ++n) { const f32x4 xv = *(const f32x4*)(xr + bj * 128 + n * 16); const f32x4 o = xv + acc[ai][bj][m][n];
                        *(f32x4*)(orow + bj * 128 + n * 16) = o; s += (o[0] * o[0] + o[1] * o[1]) + (o[2] * o[2] + o[3] * o[3]); }
                s += __shfl_xor(s, 16); s += __shfl_xor(s, 32);
                if (fq == 0) atomicAdd(ss + row, s); }
    }
};

__device__ const unsigned char T5B[132] = {0, 1, 2, 3, 4, 5, 6, 7, 8, 9, 10, 11, 12, 13, 14, 15, 16, 16, 16, 17, 17, 18, 18, 18, 19, 19, 19, 20, 20, 20, 20, 21, 21, 21, 21, 22, 22, 22, 22, 22, 23, 23, 23, 23, 23, 23, 24, 24, 24, 24, 24, 24, 25, 25, 25, 25, 25, 25, 25, 26, 26, 26, 26, 26, 26, 26, 26, 27, 27, 27, 27, 27, 27, 27, 27, 27, 27, 28, 28, 28, 28, 28, 28, 28, 28, 28, 28, 29, 29, 29, 29, 29, 29, 29, 29, 29, 29, 29, 29, 30, 30, 30, 30, 30, 30, 30, 30, 30, 30, 30, 30, 30, 30, 31, 31, 31, 31, 31, 31, 31, 31, 31, 31, 31, 31, 31, 31, 31, 31, 31, 31, 31};
constexpr int AT_KP = 144, AT_VP = 520, AT_VT_OFF = 256 * AT_KP, AT_BT_OFF = AT_VT_OFF + 64 * AT_VP;
__device__ __forceinline__ int crow(int r, int hi) { return (r & 3) + 8 * (r >> 2) + 4 * hi; }

template <int MODE>
__device__ __forceinline__ void attn_task(const Frame& F, const Args& AR, int b, int kvh, int n, int g_, int i) {
    LAS unsigned char* KL = F.lds; LAS unsigned char* VT = F.lds + AT_VT_OFF; LAS float* BT = (LAS float*)(F.lds + AT_BT_OFF);
    const int lane = lane_id(), q = lane & 31, hi = lane >> 5;
    int g, mq, dq;
    if (MODE == 0) { g = g_; mq = b * SEQ + n * 128 + 32 * i + q; dq = 128 + q; }
    else { g = q >> 3; mq = MP + b * DECS + (q & 7); dq = 128 + (q & 7); }
    const int h = kvh * 4 + g;
    bf16* QO = (bf16*)(F.ws + WS_Q); const bf16* GA = (const bf16*)(F.ws + WS_GA);
    bf16x8 qf[4];
    { const bf16* qp = QO + (size_t)mq * DM + h * HD + 8 * hi;
#pragma unroll
      for (int s = 0; s < 4; ++s) qf[s] = *(const bf16x8*)(qp + 16 * s); }
    const int kt0 = MODE == 0 ? i : 0;
    f32x16 sc[5];
    const float sink = AR.in[I_SINK][h];
    const LAS float* bt = BT + g * 192 + 32 + dq - 4 * hi;
    float mx = sink;
#pragma unroll
    for (int t = 0; t < 5; ++t) { const LAS unsigned char* kp = KL + (32 * (kt0 + t) + q) * AT_KP + 16 * hi; f32x16 a = {0.f, 0.f, 0.f, 0.f, 0.f, 0.f, 0.f, 0.f, 0.f, 0.f, 0.f, 0.f, 0.f, 0.f, 0.f, 0.f};
#pragma unroll
        for (int s = 0; s < 4; ++s) { const bf16x8 kf = *(const LAS bf16x8*)(kp + 32 * s); a = __builtin_amdgcn_mfma_f32_32x32x16_bf16(kf, qf[s], a, 0, 0, 0); }
        const bool dead = (MODE == 0) && n == 0 && (i + t) < 4;
#pragma unroll
        for (int r = 0; r < 16; ++r) { const int kb0 = 32 * t + (r & 3) + 8 * (r >> 2);
            float sv = a[r] * 0.125f + bt[-kb0]; sv = dead ? -INFINITY : sv; a[r] = sv; mx = fmaxf(mx, sv); }
        sc[t] = a;
        __builtin_amdgcn_sched_barrier(0); }
    mx = fmaxf(mx, __shfl_xor(mx, 32));
    float sum = 0.f;
#pragma unroll
    for (int t = 0; t < 5; ++t)
#pragma unroll
        for (int r = 0; r < 16; ++r) { const float p = __expf(sc[t][r] - mx); sum += p; sc[t][r] = p; }
    sum += __shfl_xor(sum, 32); sum += __expf(sink - mx);
    const float inv = 1.0f / sum;
    f32x16 o[2];
#pragma unroll
    for (int d = 0; d < 2; ++d) o[d] = (f32x16){0.f, 0.f, 0.f, 0.f, 0.f, 0.f, 0.f, 0.f, 0.f, 0.f, 0.f, 0.f, 0.f, 0.f, 0.f, 0.f};
#pragma unroll
    for (int t = 0; t < 5; ++t)
#pragma unroll
        for (int s2 = 0; s2 < 2; ++s2) {
            v4u pw; pw.x = pk2(sc[t][8 * s2 + 0], sc[t][8 * s2 + 1]); pw.y = pk2(sc[t][8 * s2 + 2], sc[t][8 * s2 + 3]); pw.z = pk2(sc[t][8 * s2 + 4], sc[t][8 * s2 + 5]); pw.w = pk2(sc[t][8 * s2 + 6], sc[t][8 * s2 + 7]);
            const bf16x8 pb = __builtin_bit_cast(bf16x8, pw);
#pragma unroll
            for (int d = 0; d < 2; ++d) { const LAS unsigned char* vp = VT + (32 * d + q) * AT_VP + (32 * (kt0 + t) + 16 * s2 + 4 * hi) * 2;
                const v2u lo = *(const LAS v2u*)vp, hi2 = *(const LAS v2u*)(vp + 16);
                v4u aw; aw.x = lo.x; aw.y = lo.y; aw.z = hi2.x; aw.w = hi2.y;
                o[d] = __builtin_amdgcn_mfma_f32_32x32x16_bf16(__builtin_bit_cast(bf16x8, aw), pb, o[d], 0, 0, 0); }
            __builtin_amdgcn_sched_barrier(0); }
    bf16* op = QO + (size_t)mq * DM + h * HD; const bf16* gp = GA + (size_t)mq * DM + h * HD;
#pragma unroll
    for (int d = 0; d < 2; ++d)
#pragma unroll
        for (int rq = 0; rq < 4; ++rq) { const int dv0 = 32 * d + 8 * rq + 4 * hi; const v2u gv = *(const v2u*)(gp + dv0);
            v2u w; w.x = pk2(o[d][4 * rq + 0] * inv * bflo(gv.x), o[d][4 * rq + 1] * inv * bfhi(gv.x)); w.y = pk2(o[d][4 * rq + 2] * inv * bflo(gv.y), o[d][4 * rq + 3] * inv * bfhi(gv.y));
            *(v2u*)(op + dv0) = w; }
}

__device__ __forceinline__ void attn_unit(const Frame& F, const Args& AR, int unit) {
    LAS unsigned char* KL = F.lds; LAS unsigned char* VT = F.lds + AT_VT_OFF; LAS float* BT = (LAS float*)(F.lds + AT_BT_OFF);
    const bf16* Kb = (const bf16*)(F.ws + WS_K); const bf16* Vb = (const bf16*)(F.ws + WS_V);
    const int tid = F.wave * 64 + lane_id();
    __syncthreads();
    int b, kvh, n = 0;
    const bool sample = unit >= 1024;
    if (!sample) {
        kvh = unit & 3; n = (unit >> 2) & 31; b = unit >> 7;
        const int t0 = (n - 1) * 128;
#pragma unroll
        for (int it = 0; it < 4; ++it) { const int c = it * NTHR + tid, key = c >> 3, part = c & 7, tok = t0 + key; v4u val = (v4u){0u, 0u, 0u, 0u};
            if (tok >= 0) val = *(const v4u*)(Kb + (size_t)(b * SEQ + tok) * KVW + kvh * HD + part * 8);
            *(LAS v4u*)(KL + key * AT_KP + part * 16) = val; }
#pragma unroll
        for (int it = 0; it < 4; ++it) { const int c = it * NTHR + tid, key = c & 255, part = c >> 8, tok = t0 + key; v4u val = (v4u){0u, 0u, 0u, 0u};
            if (tok >= 0) val = *(const v4u*)(Vb + (size_t)(b * SEQ + tok) * KVW + kvh * HD + part * 8);
            LAS bf16* vt = (LAS bf16*)(VT + (part * 8) * AT_VP + key * 2);
            vt[0 * (AT_VP / 2)] = (bf16)val.x; vt[1 * (AT_VP / 2)] = (bf16)(val.x >> 16); vt[2 * (AT_VP / 2)] = (bf16)val.y; vt[3 * (AT_VP / 2)] = (bf16)(val.y >> 16);
            vt[4 * (AT_VP / 2)] = (bf16)val.z; vt[5 * (AT_VP / 2)] = (bf16)(val.z >> 16); vt[6 * (AT_VP / 2)] = (bf16)val.w; vt[7 * (AT_VP / 2)] = (bf16)(val.w >> 16); }
    } else {
        const int su = unit - 1024; kvh = su & 3; b = su >> 2;
        for (int c = tid; c < 160 * 8; c += NTHR) {
            { const int key = c >> 3, part = c & 7; v4u val = (v4u){0u, 0u, 0u, 0u};
              if (key < 128) { const float* src = AR.in[I_CK] + ((size_t)(b * WIN + key) * NKV + kvh) * HD + part * 8; const f32x4 a = *(const f32x4*)src, bb = *(const f32x4*)(src + 4);
                  val.x = pk2(a.x, a.y); val.y = pk2(a.z, a.w); val.z = pk2(bb.x, bb.y); val.w = pk2(bb.z, bb.w);
                  if (key >= 8) { float* d = F.out + O_SKW + ((size_t)(b * WIN + key - 8) * NKV + kvh) * HD + part * 8; *(f32x4*)d = a; *(f32x4*)(d + 4) = bb; } }
              else if (key < 136) val = *(const v4u*)(Kb + (size_t)(MP + b * DECS + key - 128) * KVW + kvh * HD + part * 8);
              *(LAS v4u*)(KL + key * AT_KP + part * 16) = val; }
            { const int key = c % 160, part = c / 160; v4u val = (v4u){0u, 0u, 0u, 0u};
              if (key < 128) { const float* src = AR.in[I_CV] + ((size_t)(b * WIN + key) * NKV + kvh) * HD + part * 8; const f32x4 a = *(const f32x4*)src, bb = *(const f32x4*)(src + 4);
                  val.x = pk2(a.x, a.y); val.y = pk2(a.z, a.w); val.z = pk2(bb.x, bb.y); val.w = pk2(bb.z, bb.w);
                  if (key >= 8) { float* d = F.out + O_SVW + ((size_t)(b * WIN + key - 8) * NKV + kvh) * HD + part * 8; *(f32x4*)d = a; *(f32x4*)(d + 4) = bb; } }
              else if (key < 136) val = *(const v4u*)(Vb + (size_t)(MP + b * DECS + key - 128) * KVW + kvh * HD + part * 8);
              LAS bf16* vt = (LAS bf16*)(VT + (part * 8) * AT_VP + key * 2);
              vt[0 * (AT_VP / 2)] = (bf16)val.x; vt[1 * (AT_VP / 2)] = (bf16)(val.x >> 16); vt[2 * (AT_VP / 2)] = (bf16)val.y; vt[3 * (AT_VP / 2)] = (bf16)(val.y >> 16);
              vt[4 * (AT_VP / 2)] = (bf16)val.z; vt[5 * (AT_VP / 2)] = (bf16)(val.z >> 16); vt[6 * (AT_VP / 2)] = (bf16)val.w; vt[7 * (AT_VP / 2)] = (bf16)(val.w >> 16); }
        }
    }
    for (int idx = tid; idx < 4 * 192; idx += NTHR) { const int g = idx / 192, d = idx - g * 192 - 32; BT[idx] = (d >= 0 && d <= 128) ? AR.in[I_RELB][(int)T5B[d] * NH + kvh * 4 + g] : -INFINITY; }
    __syncthreads();
    if (!sample) { for (int task = F.wave; task < 16; task += NWAVES) attn_task<0>(F, AR, b, kvh, n, task >> 2, task & 3); }
    else if (F.wave == 0) attn_task<1>(F, AR, b, kvh, 0, 0, 0);
}

__device__ __forceinline__ float dppf(float x, const int ctrl) { return x; }
#define DPP_ADD(x, ctrl) ((x) + __builtin_bit_cast(float, __builtin_amdgcn_update_dpp(0, __builtin_bit_cast(int, (x)), (ctrl), 0xF, 0xF, true)))
__device__ __forceinline__ float reduce8(float x) { x = DPP_ADD(x, 0xB1); x = DPP_ADD(x, 0x4E); x = DPP_ADD(x, 0x141); return x; }

__device__ __forceinline__ void scan_unit(const Frame& F, const Args& AR, int unit) {
    LAS float* R = (LAS float*)F.lds; LAS float* KP = R + 4096; LAS float* V = R + 8192; LAS float* W = R + 12288; LAS float* A = R + 16384; LAS float* B = R + 20480; LAS float* Y = R + 24576;
    LAS float* RK = (LAS float*)(F.lds + SMALL_OFF);
    const int lane = lane_id(), wave = F.wave, tid = wave * 64 + lane;
    const bool sample = unit >= 128;
    int b, h;
    if (!sample) { b = unit >> 4; h = unit & 15; } else { const int su = unit - 128; b = su >> 4; h = su & 15; }
    const int T = sample ? DECS : SEQ; const size_t m0 = sample ? (size_t)MP + (size_t)b * DECS : (size_t)b * SEQ;
    const int tok = tid >> 3, cg = tid & 7, c0 = cg * 8, ch0 = h * HD + c0;
    const bf16* PS = (const bf16*)(F.ws + WS_PS); bf16* GB = (bf16*)(F.ws + WS_GA);
    const int vrow = wave * 8 + (lane >> 3), kq = lane & 7;
    float S[8];
    { float* so = (sample ? (float*)AR.in[I_SWKV] : nullptr);
      if (sample) { const float* sp = AR.in[I_SWKV] + (((size_t)(b * NH + h) * HD + vrow) * HD + 8 * kq); const f32x4 a = *(const f32x4*)sp, bb = *(const f32x4*)(sp + 4);
          S[0] = a.x; S[1] = a.y; S[2] = a.z; S[3] = a.w; S[4] = bb.x; S[5] = bb.y; S[6] = bb.z; S[7] = bb.w; }
      else {
#pragma unroll
          for (int i = 0; i < 8; ++i) S[i] = 0.f; }
      (void)so; }
    const int nch = sample ? 1 : SEQ / 64;
    for (int chn = 0; chn < nch; ++chn) {
        const int t0 = chn * 64; const int ntok = sample ? DECS : 64;
        __syncthreads();
        if (tok < ntok) {
            const size_t row = m0 + t0 + tok; const bf16* P = PS + row * SHW; const bool first = (t0 + tok) == 0;
            const bf16* Pp = P - SHW;
#pragma unroll
            for (int grp = 0; grp < 5; ++grp) {
                const int col = grp < 3 ? grp * 1024 + ch0 : (grp == 3 ? 3072 + c0 : 3136 + c0);
                const v4u cu = *(const v4u*)(P + col); float cur[8] = {bflo(cu.x), bfhi(cu.x), bflo(cu.y), bfhi(cu.y), bflo(cu.z), bfhi(cu.z), bflo(cu.w), bfhi(cu.w)};
                float prv[8];
                if (!first) { const v4u pu = *(const v4u*)(Pp + col); prv[0] = bflo(pu.x); prv[1] = bfhi(pu.x); prv[2] = bflo(pu.y); prv[3] = bfhi(pu.y); prv[4] = bflo(pu.z); prv[5] = bfhi(pu.z); prv[6] = bflo(pu.w); prv[7] = bfhi(pu.w); }
                else if (sample) { const float* sp = AR.in[I_SSHIFT] + (size_t)b * SHW + col; const f32x4 a = *(const f32x4*)sp, bb = *(const f32x4*)(sp + 4); prv[0] = a.x; prv[1] = a.y; prv[2] = a.z; prv[3] = a.w; prv[4] = bb.x; prv[5] = bb.y; prv[6] = bb.z; prv[7] = bb.w; }
                else {
#pragma unroll
                    for (int i = 0; i < 8; ++i) prv[i] = 0.f; }
                const float* mup = AR.in[I_MU] + col; const f32x4 m0v = *(const f32x4*)mup, m1v = *(const f32x4*)(mup + 4);
                const float mu[8] = {m0v.x, m0v.y, m0v.z, m0v.w, m1v.x, m1v.y, m1v.z, m1v.w};
                LAS float* dstp = (grp == 0 ? R : grp == 1 ? KP : grp == 2 ? V : grp == 3 ? W : A) + tok * 64 + c0;
#pragma unroll
                for (int i = 0; i < 8; ++i) { float z = cur[i] + (prv[i] - cur[i]) * mu[i]; if (grp == 3) z = tanhf(z); dstp[i] = z; }
            }
        }
        __syncthreads();
        float uw[8], ua[8];
        if (tok < ntok) {
            { const float* p = AR.in[I_W0] + ch0; const f32x4 a = *(const f32x4*)p, bb = *(const f32x4*)(p + 4); uw[0] = a.x; uw[1] = a.y; uw[2] = a.z; uw[3] = a.w; uw[4] = bb.x; uw[5] = bb.y; uw[6] = bb.z; uw[7] = bb.w; }
            { const float* p = AR.in[I_A0] + ch0; const f32x4 a = *(const f32x4*)p, bb = *(const f32x4*)(p + 4); ua[0] = a.x; ua[1] = a.y; ua[2] = a.z; ua[3] = a.w; ua[4] = bb.x; ua[5] = bb.y; ua[6] = bb.z; ua[7] = bb.w; }
            const float* w2p = AR.in[I_W2] + ch0; const float* a2p = AR.in[I_A2] + ch0;
#pragma unroll 4
            for (int j = 0; j < 64; ++j) { const float tw = W[tok * 64 + j], al = A[tok * 64 + j];
                const f32x4 wa = *(const f32x4*)(w2p + (size_t)j * DM), wb = *(const f32x4*)(w2p + (size_t)j * DM + 4), aa = *(const f32x4*)(a2p + (size_t)j * DM), ab = *(const f32x4*)(a2p + (size_t)j * DM + 4);
                uw[0] += tw * wa.x; uw[1] += tw * wa.y; uw[2] += tw * wa.z; uw[3] += tw * wa.w; uw[4] += tw * wb.x; uw[5] += tw * wb.y; uw[6] += tw * wb.z; uw[7] += tw * wb.w;
                ua[0] += al * aa.x; ua[1] += al * aa.y; ua[2] += al * aa.z; ua[3] += al * aa.w; ua[4] += al * ab.x; ua[5] += al * ab.y; ua[6] += al * ab.z; ua[7] += al * ab.w; }
        }
        __syncthreads();
        if (tok < ntok) {
            float kkv[8], asg[8], kv[8]; float ss = 0.f;
            const float* kkp = AR.in[I_KK] + ch0; const float* kap = AR.in[I_KA] + ch0; const float* rkp = AR.in[I_RK] + ch0;
#pragma unroll
            for (int i = 0; i < 8; ++i) { kv[i] = KP[tok * 64 + c0 + i]; kkv[i] = kv[i] * kkp[i]; ss += kkv[i] * kkv[i]; asg[i] = sigmoidf_(ua[i]); }
            ss += __shfl_xor(ss, 1); ss += __shfl_xor(ss, 2); ss += __shfl_xor(ss, 4);
            const float invn = 1.0f / fmaxf(sqrtf(ss), 1e-12f);
            float rk = 0.f;
#pragma unroll
            for (int i = 0; i < 8; ++i) { const float sg = sigmoidf_(uw[i]); const float w = __expf(-0.6065306597126334f * sg);
                const float kp = kv[i] * (1.0f + (asg[i] - 1.0f) * kap[i]); const float kn = kkv[i] * invn;
                W[tok * 64 + c0 + i] = w; KP[tok * 64 + c0 + i] = kp; A[tok * 64 + c0 + i] = -kn; B[tok * 64 + c0 + i] = kn * asg[i];
                rk += R[tok * 64 + c0 + i] * kp * rkp[i]; }
            rk += __shfl_xor(rk, 1); rk += __shfl_xor(rk, 2); rk += __shfl_xor(rk, 4);
            if (cg == 0) RK[tok] = rk;
        }
        __syncthreads();
        for (int t = 0; t < ntok; ++t) {
            const LAS float* wp = W + t * 64 + 8 * kq; const LAS float* ap = A + t * 64 + 8 * kq; const LAS float* bp = B + t * 64 + 8 * kq; const LAS float* kp = KP + t * 64 + 8 * kq; const LAS float* rp = R + t * 64 + 8 * kq;
            const f32x4 w0 = *(const LAS f32x4*)wp, w1 = *(const LAS f32x4*)(wp + 4), a0 = *(const LAS f32x4*)ap, a1 = *(const LAS f32x4*)(ap + 4), b0 = *(const LAS f32x4*)bp, b1 = *(const LAS f32x4*)(bp + 4);
            const f32x4 k0 = *(const LAS f32x4*)kp, k1 = *(const LAS f32x4*)(kp + 4), r0 = *(const LAS f32x4*)rp, r1 = *(const LAS f32x4*)(rp + 4);
            const float vv = V[t * 64 + vrow];
            float sa = (S[0] * a0.x + S[1] * a0.y) + (S[2] * a0.z + S[3] * a0.w) + (S[4] * a1.x + S[5] * a1.y) + (S[6] * a1.z + S[7] * a1.w);
            sa = reduce8(sa);
            S[0] = S[0] * w0.x + sa * b0.x + vv * k0.x; S[1] = S[1] * w0.y + sa * b0.y + vv * k0.y; S[2] = S[2] * w0.z + sa * b0.z + vv * k0.z; S[3] = S[3] * w0.w + sa * b0.w + vv * k0.w;
            S[4] = S[4] * w1.x + sa * b1.x + vv * k1.x; S[5] = S[5] * w1.y + sa * b1.y + vv * k1.y; S[6] = S[6] * w1.z + sa * b1.z + vv * k1.z; S[7] = S[7] * w1.w + sa * b1.w + vv * k1.w;
            float y = (S[0] * r0.x + S[1] * r0.y) + (S[2] * r0.z + S[3] * r0.w) + (S[4] * r1.x + S[5] * r1.y) + (S[6] * r1.z + S[7] * r1.w);
            y = reduce8(y);
            if (kq == 0) Y[t * 64 + vrow] = y;
        }
        __syncthreads();
        if (tok < ntok) {
            float y[8]; float s = 0.f;
#pragma unroll
            for (int i = 0; i < 8; ++i) { y[i] = Y[tok * 64 + c0 + i]; s += y[i]; }
            s += __shfl_xor(s, 1); s += __shfl_xor(s, 2); s += __shfl_xor(s, 4);
            const float mean = s * (1.0f / 64.0f); float q = 0.f;
#pragma unroll
            for (int i = 0; i < 8; ++i) { y[i] -= mean; q += y[i] * y[i]; }
            q += __shfl_xor(q, 1); q += __shfl_xor(q, 2); q += __shfl_xor(q, 4);
            const float rstd = 1.0f / sqrtf(q * (1.0f / 64.0f) + GN_EPS);
            const float rk = RK[tok];
            const float* lg = AR.in[I_LNG] + ch0; const float* lb = AR.in[I_LNB] + ch0;
            bf16* gp = GB + (m0 + t0 + tok) * DM + ch0; const v4u gv = *(const v4u*)gp;
            const float gt[8] = {bflo(gv.x), bfhi(gv.x), bflo(gv.y), bfhi(gv.y), bflo(gv.z), bfhi(gv.z), bflo(gv.w), bfhi(gv.w)};
            float o[8];
#pragma unroll
            for (int i = 0; i < 8; ++i) o[i] = (y[i] * rstd * lg[i] + lb[i] + rk * V[tok * 64 + c0 + i]) * gt[i];
            v4u w; w.x = pk2(o[0], o[1]); w.y = pk2(o[2], o[3]); w.z = pk2(o[4], o[5]); w.w = pk2(o[6], o[7]);
            *(v4u*)gp = w;
        }
    }
    { float* dp = F.out + (sample ? O_SWKV : O_PWKV) + (((size_t)(b * NH + h) * HD + vrow) * HD + 8 * kq);
      *(f32x4*)dp = (f32x4){S[0], S[1], S[2], S[3]}; *(f32x4*)(dp + 4) = (f32x4){S[4], S[5], S[6], S[7]}; }
}

__device__ __forceinline__ void final_norm(const Frame& F, const Args& AR) {
    const int gw = F.vcu * NWAVES + F.wave, NGW = F.G * NWAVES;
    const float* ss = (const float*)(F.ws + WS_SS); const int lane = lane_id(); const GAS f32x4* gr = (const GAS f32x4*)AR.in[I_FING] + lane;
    for (int m = gw; m < MT; m += NGW) {
        const float sc = 1.0f / sqrtf(ss[m] * (1.f / DM) + NORM_EPS);
        GAS f32x4* xr = (GAS f32x4*)(F.out + (size_t)m * DM) + lane;
#pragma unroll
        for (int j = 0; j < 4; ++j) { const f32x4 v = xr[64 * j], g = gr[64 * j]; xr[64 * j] = v * sc * g; }
    }
}

#ifndef MK_PER_PHASE
#define MK_PER_PHASE 0
#endif
constexpr int N_PHASES = 9;
__global__ void __launch_bounds__(NTHR, 2) hybrid_fwd(Args args) {
    extern __shared__ __attribute__((aligned(16))) unsigned char lds[];
    Frame F;
    F.lds = (LAS unsigned char*)lds;
    F.wave = __builtin_amdgcn_readfirstlane(threadIdx.x >> 6);
    F.G = gridDim.x; { const int bx = blockIdx.x; F.vcu = (F.G % 8 == 0) ? (bx % 8) * (F.G / 8) + bx / 8 : bx; }
    F.out = args.out; F.ws = args.ws;
    volatile LAS unsigned* MISC = (volatile LAS unsigned*)(F.lds + MISC_OFF);
    for (int u = threadIdx.x; u < (LDS_BYTES - LDSCTL_OFF) / 4; u += NTHR) ((LAS unsigned*)(F.lds + LDSCTL_OFF))[u] = 0u;
    __syncthreads();
    XcdBarrier bar; bar.bar = (unsigned*)(F.ws + WS_CTL) + CW_BAR; bar.x = 0; bar.st = nullptr;
    if (!MK_PER_PHASE) bar = xcd_barrier_post((unsigned*)(F.ws + WS_CTL) + CW_BAR, MISC + 8);
    const int lo = args.ph_lo, hi = args.ph_hi;
#ifndef PHMASK
#define PHMASK 0x1ff
#endif
#define IN(k) ((((PHMASK) >> (k)) & 1) && lo <= (k) && (k) < hi)
#define SEAM(k) do { if (IN(k) && IN((k) + 1)) xcd_barrier(bar); } while (0)

    if (IN(0)) { p0_prologue(F, args); }
    SEAM(0);
    if (IN(1)) {
        pg8::Gemm g{(const bf16*)(F.ws + WS_XN), (const bf16*)(F.ws + WS_W1T), MT, N1A, DM}; pg8::StaticOrder S; S.init(MT, N1A, F.G, (int)blockIdx.x);
        EpiG1 E{0, F.ws, F.out};
        pg8::gemm_phase<EpiG1, pg8::StaticOrder, true, true>(F.lds, g, S, E);
    }
    SEAM(1);
    if (IN(2)) { for (int u = F.vcu; u < 1024 + 512; u += F.G) attn_unit(F, args, u); }
    SEAM(2);
    if (IN(3)) {
        pg8::Gemm g{(const bf16*)(F.ws + WS_XN), (const bf16*)(F.ws + WS_W1T) + (size_t)N1A * DM, MT, N1B, DM}; pg8::StaticOrder S; S.init(MT, N1B, F.G, (int)blockIdx.x);
        EpiG1 E{1, F.ws, F.out};
        pg8::gemm_phase<EpiG1, pg8::StaticOrder, true, true>(F.lds, g, S, E);
    }
    SEAM(3);
    if (IN(4)) { for (int u = (int)blockIdx.x; u < 128 + 2048; u += F.G) scan_unit(F, args, u); }
    SEAM(4);
    if (IN(5)) {
        pg8::Gemm g{(const bf16*)(F.ws + WS_Q), (const bf16*)(F.ws + WS_WAT), MT, DM, DM}; pg8::StaticOrder S; S.init(MT, DM, F.G, (int)blockIdx.x);
        EpiGate E{0, (const bf16*)F.out, nullptr, (bf16*)(F.ws + WS_PS)};
        pg8::gemm_phase<EpiGate, pg8::StaticOrder, true, true>(F.lds, g, S, E);
    }
    SEAM(5);
    if (IN(6)) {
        pg8::Gemm g{(const bf16*)(F.ws + WS_GA), (const bf16*)(F.ws + WS_WBT), MT, DM, DM}; pg8::StaticOrder S; S.init(MT, DM, F.G, (int)blockIdx.x);
        EpiGate E{1, (const bf16*)F.out + (size_t)MT * DM, (const bf16*)(F.ws + WS_PS), (bf16*)(F.ws + WS_XN)};
        pg8::gemm_phase<EpiGate, pg8::StaticOrder, true, true>(F.lds, g, S, E);
    }
    SEAM(6);
    if (IN(7)) {
        pg8::Gemm g{(const bf16*)(F.ws + WS_XN), (const bf16*)(F.ws + WS_WOT), MT, DM, DM}; pg8::StaticOrder S; S.init(MT, DM, F.G, (int)blockIdx.x);
        EpiOut E{args.in[I_XP], args.in[I_XS], F.out, (float*)(F.ws + WS_SS)};
        pg8::gemm_phase<EpiOut, pg8::StaticOrder, true, true>(F.lds, g, S, E);
    }
    SEAM(7);
    if (IN(8)) { final_norm(F, args); }
#undef IN
#undef SEAM
}

extern "C" void kernel_launch(void* const* d_in, const int* in_sizes, int n_in, void* d_out, int out_size, void* d_ws, size_t ws_size, hipStream_t stream) {
    static int grid = 0;
    if (grid == 0) {
        if (n_in != 24 || (size_t)out_size != O_END || ws_size < WS_END) { fprintf(stderr, "kernel_launch: unexpected sizes: n_in %d out %d ws %zu (need %zu)\n", n_in, out_size, ws_size, (size_t)WS_END); grid = -1; return; }
        int dev = 0, cus = 0;
        if (hipGetDevice(&dev) != hipSuccess || hipDeviceGetAttribute(&cus, hipDeviceAttributeMultiprocessorCount, dev) != hipSuccess) { grid = -1; return; }
        if (hipFuncSetAttribute((const void*)hybrid_fwd, hipFuncAttributeMaxDynamicSharedMemorySize, LDS_BYTES) != hipSuccess) { fprintf(stderr, "kernel_launch: hipFuncSetAttribute failed\n"); grid = -1; return; }
        int per_cu = 0;
        if (hipOccupancyMaxActiveBlocksPerMultiprocessor(&per_cu, (const void*)hybrid_fwd, NTHR, LDS_BYTES) != hipSuccess || per_cu < 1) fprintf(stderr, "kernel_launch: occupancy query says %d\n", per_cu);
        (void)hipGetLastError();
        grid = cus;
    }
    if (grid < 0) return;
    (void)hipMemsetAsync((char*)d_ws + WS_CTL, 0, CTL_ZERO_BYTES, stream);
    Args a{};
    for (int i = 0; i < 24; ++i) a.in[i] = (const float*)d_in[i];
    a.out = (float*)d_out; a.ws = (unsigned char*)d_ws;
#if MK_PER_PHASE
    for (int p = 0; p < N_PHASES; ++p) { a.ph_lo = p; a.ph_hi = p + 1; hipLaunchKernelGGL(hybrid_fwd, dim3(grid), dim3(NTHR), LDS_BYTES, stream, a); }
#else
    a.ph_lo = 0; a.ph_hi = N_PHASES; hipLaunchKernelGGL(hybrid_fwd, dim3(grid), dim3(NTHR), LDS_BYTES, stream, a);
#endif
}
```

```cpp
#include <hip/hip_runtime.h>
#include <cstdio>
#include <cstdint>
#include <cmath>
namespace pg8 {
#define PG8_LAS __attribute__((address_space(3)))
typedef unsigned short bf16_t;
typedef short bf16x8 __attribute__((ext_vector_type(8)));
typedef float f32x4 __attribute__((ext_vector_type(4)));
typedef unsigned u32x4 __attribute__((ext_vector_type(4)));
constexpr int BM = 256, BK = 64, HALF = 128, HTB = HALF * BK * 2  , STAGE_BYTES = 8 * HTB, NXCD = 8, WGM = 8;

__host__ __device__ __forceinline__ int lds_byte(int r, int c) { const int st = (r >> 4) * 2 + (c >> 5), rr = r & 15, cc = c & 31, ob = rr * 64 + cc * 2; return st * 1024 + (ob ^ (((ob >> 9) & 1) << 5)); }
__host__ __device__ __forceinline__ void stage_rc(int b, int& R, int& C) { const int st = b / 1024, sb = b % 1024, swz = sb ^ (((sb >> 9) & 1) << 5); R = (st >> 1) * 16 + swz / 64; C = (st & 1) * 32 + (swz % 64) / 2; }
__host__ __device__ __forceinline__ int perm32(int rho) { const int n = rho >> 4, i = rho & 15; return 8 * (i >> 2) + 4 * n + (i & 3); }

struct Unit { int pm, pn; };
struct Gemm { const bf16_t* A; const bf16_t* Bt; int M, N, K; };

struct StaticOrder {
    int nM, nN, nwg, G, c;
    __host__ __device__ void init(int M, int N, int G_, int c_) { nM = M / BM; nN = N / BM; nwg = nM * nN; G = G_; c = c_; }
    __host__ __device__ bool next(int i, Unit& u) const {
        const long L = (long)i * G + c; if (L >= nwg) return false;
        int wgid = (int)L; { const int q = nwg / NXCD, r = nwg % NXCD, xcd = wgid % NXCD, off = wgid / NXCD; wgid = (xcd < r ? xcd * (q + 1) : r * (q + 1) + (xcd - r) * q) + off; }
        const int nig = WGM * nN, gid = wgid / nig, fm = gid * WGM, gsz = (nM - fm) < WGM ? (nM - fm) : WGM;
        u.pm = fm + ((wgid % nig) % gsz); u.pn = (wgid % nig) / gsz; return true;
    }
    __device__ __forceinline__ void a_ready(const Unit&) const {}
    __device__ __forceinline__ void done(const Unit&) const {}
};

__device__ __forceinline__ unsigned cvt_pk_bf16(float lo, float hi) { unsigned r; asm volatile("v_cvt_pk_bf16_f32 %0, %1, %2" : "=v"(r) : "v"(lo), "v"(hi)); return r; }
typedef float f32x2 __attribute__((ext_vector_type(2)));
template <class Epi, class Sched, bool ALIGN_EPI = false, bool SP2 = false>
__device__ __forceinline__ void gemm_phase(PG8_LAS unsigned char* lds, const Gemm g, const Sched& S, const Epi& E) {
    const int tid = threadIdx.x, wid = __builtin_amdgcn_readfirstlane(tid >> 6), lane = tid & 63, wr = wid >> 2, wc = wid & 3, fr = lane & 15, fq = lane >> 4;
    const int K = g.K, nt = K / BK;
    unsigned voffA[2], voffB[2];
#pragma unroll
    for (int i = 0; i < 2; ++i) { int R, C; stage_rc(tid * 16 + i * 8192, R, C); const int Rb = Epi::PERM ? ((R & ~31) + perm32(R & 31)) : R;
        voffA[i] = (unsigned)(R * K + C) * 2u; voffB[i] = (unsigned)(Rb * K + C) * 2u; }
    const size_t kstep = (size_t)(BK * 2);
    const size_t hstep = (size_t)HALF * K * 2;
    const size_t tstep = 2 * hstep;
    const unsigned ldsw = (unsigned)wid * 1024u;
    const int aoff = lds_byte(wr * 64 + fr, fq * 8), boff = lds_byte(wc * 32 + fr, fq * 8);
#define PG8_SA(b, h) (((b) * 2 + (h)) * HTB)
#define PG8_SB(b, h) ((4 + (b) * 2 + (h)) * HTB)
#define PG8_STAGE(bufoff, gbase, voff) do { _Pragma("unroll") for (int _i = 0; _i < 2; ++_i) \
        __builtin_amdgcn_global_load_lds((const unsigned*)((const char*)(gbase) + (voff)[_i]), (PG8_LAS unsigned*)(lds + (bufoff) + ldsw + _i * 8192), 16, 0, 0); } while (0)
#define PG8_LDA(dst, b, h) do { _Pragma("unroll") for (int m = 0; m < 4; ++m) _Pragma("unroll") for (int k = 0; k < 2; ++k) dst[m][k] = *(const PG8_LAS bf16x8*)(lds + PG8_SA(b, h) + aoff + m * 2048 + k * 1024); } while (0)
#define PG8_LDB(dst, b, h) do { _Pragma("unroll") for (int n = 0; n < 2; ++n) _Pragma("unroll") for (int k = 0; k < 2; ++k) dst[n][k] = *(const PG8_LAS bf16x8*)(lds + PG8_SB(b, h) + boff + n * 2048 + k * 1024); } while (0)
#define PG8_MMA(ai, bj, At, Bt) do { __builtin_amdgcn_s_setprio(1); _Pragma("unroll") for (int m = 0; m < 4; ++m) _Pragma("unroll") for (int n = 0; n < 2; ++n) _Pragma("unroll") for (int k = 0; k < 2; ++k) \
        acc[ai][bj][m][n] = __builtin_amdgcn_mfma_f32_16x16x32_bf16(Bt[n][k], At[m][k], acc[ai][bj][m][n], 0, 0, 0); __builtin_amdgcn_s_setprio(0); } while (0)
#define PG8_WAIT_V(n) asm volatile("s_waitcnt vmcnt(" #n ")" ::: "memory")
#define PG8_WAIT_L(n) asm volatile("s_waitcnt lgkmcnt(" #n ")" ::: "memory")
#define PG8_BAR __builtin_amdgcn_s_barrier()
#define PG8_SCHED __builtin_amdgcn_sched_barrier(0)
    Unit cur, nxt; int ui = 0;
    if (!S.next(0, cur)) return;
    f32x4 acc[2][2][4][2];
#pragma unroll
    for (int a = 0; a < 2; ++a)
#pragma unroll
        for (int b = 0; b < 2; ++b)
#pragma unroll
            for (int m = 0; m < 4; ++m)
#pragma unroll
                for (int n = 0; n < 2; ++n) acc[a][b][m][n] = (f32x4){0.f, 0.f, 0.f, 0.f};
    bf16x8 At[4][2], B0[2][2], B1[2][2];
    const char* cA = (const char*)g.A + (size_t)cur.pm * tstep; const char* cB = (const char*)g.Bt + (size_t)cur.pn * tstep;
    S.a_ready(cur);
    if constexpr (SP2) {
        PG8_STAGE(PG8_SB(0, 0), cB, voffB); PG8_STAGE(PG8_SB(0, 1), cB + hstep, voffB); PG8_STAGE(PG8_SA(0, 0), cA, voffA); PG8_STAGE(PG8_SA(0, 1), cA + hstep, voffA);
        if (wr == 1) PG8_BAR;
        PG8_WAIT_V(2); PG8_BAR;
        PG8_STAGE(PG8_SB(1, 0), cB + kstep, voffB); PG8_STAGE(PG8_SA(1, 0), cA + kstep, voffA); PG8_STAGE(PG8_SB(1, 1), cB + hstep + kstep, voffB);
        PG8_WAIT_V(6); PG8_BAR;
    } else {
        PG8_STAGE(PG8_SB(0, 0), cB, voffB); PG8_STAGE(PG8_SA(0, 0), cA, voffA); PG8_STAGE(PG8_SB(0, 1), cB + hstep, voffB); PG8_STAGE(PG8_SA(0, 1), cA + hstep, voffA);
        if (wr == 1) PG8_BAR;
        PG8_WAIT_V(4); PG8_BAR;
        PG8_STAGE(PG8_SB(1, 0), cB + kstep, voffB); PG8_STAGE(PG8_SA(1, 0), cA + kstep, voffA); PG8_STAGE(PG8_SB(1, 1), cB + hstep + kstep, voffB);
        PG8_WAIT_V(6); PG8_BAR;
    }
    for (;;) {
        const bool has_next = S.next(ui + 1, nxt);
        const char* nA = has_next ? (const char*)g.A + (size_t)nxt.pm * tstep : cA; const char* nB = has_next ? (const char*)g.Bt + (size_t)nxt.pn * tstep : cB;
        for (int t = 0; t < nt; t += 2) {
            const bool last = (t == nt - 2);
            const char* a1 = cA + (size_t)(t + 1) * kstep;
            const char* a2 = last ? nA : cA + (size_t)(t + 2) * kstep; const char* b2 = last ? nB : cB + (size_t)(t + 2) * kstep;
            const char* a3 = a2 + kstep; const char* b3 = b2 + kstep;
            if (last && has_next) S.a_ready(nxt);
            if constexpr (SP2) {
            PG8_LDB(B0, 0, 0); PG8_LDB(B1, 0, 1); PG8_SCHED; PG8_LDA(At, 0, 0); PG8_STAGE(PG8_SA(1, 1), a1 + hstep, voffA);
            PG8_WAIT_V(8); PG8_WAIT_L(0); PG8_BAR; PG8_MMA(0, 0, At, B0); PG8_MMA(0, 1, At, B1); PG8_BAR; PG8_SCHED;
            PG8_LDA(At, 0, 1); PG8_STAGE(PG8_SB(0, 0), b2, voffB); PG8_STAGE(PG8_SB(0, 1), b2 + hstep, voffB); PG8_STAGE(PG8_SA(0, 0), a2, voffA);
            PG8_WAIT_V(8); PG8_WAIT_L(0); PG8_BAR; PG8_MMA(1, 0, At, B0); PG8_MMA(1, 1, At, B1); PG8_BAR; PG8_SCHED;
            PG8_LDB(B0, 1, 0); PG8_LDB(B1, 1, 1); PG8_SCHED; PG8_LDA(At, 1, 0); PG8_STAGE(PG8_SA(0, 1), a2 + hstep, voffA);
            PG8_WAIT_V(8); PG8_WAIT_L(0); PG8_BAR; PG8_MMA(0, 0, At, B0); PG8_MMA(0, 1, At, B1); PG8_BAR; PG8_SCHED;
            PG8_LDA(At, 1, 1); PG8_STAGE(PG8_SB(1, 0), b3, voffB); PG8_STAGE(PG8_SB(1, 1), b3 + hstep, voffB); PG8_STAGE(PG8_SA(1, 0), a3, voffA);
            PG8_WAIT_V(8); PG8_WAIT_L(0); PG8_BAR; PG8_MMA(1, 0, At, B0); PG8_MMA(1, 1, At, B1); PG8_BAR; PG8_SCHED;
            } else {
            PG8_LDB(B0, 0, 0); PG8_SCHED; PG8_LDA(At, 0, 0); PG8_STAGE(PG8_SA(1, 1), a1 + hstep, voffA);
            PG8_WAIT_L(8); PG8_BAR; PG8_WAIT_L(0); PG8_MMA(0, 0, At, B0); PG8_BAR; PG8_SCHED;
            PG8_LDB(B1, 0, 1); PG8_STAGE(PG8_SB(0, 0), b2, voffB);
            PG8_BAR; PG8_WAIT_L(0); PG8_MMA(0, 1, At, B1); PG8_BAR;
            PG8_LDA(At, 0, 1); PG8_STAGE(PG8_SA(0, 0), a2, voffA);
            PG8_BAR; PG8_WAIT_L(0); PG8_MMA(1, 0, At, B0); PG8_BAR; PG8_SCHED;
            PG8_STAGE(PG8_SB(0, 1), b2 + hstep, voffB);
            PG8_WAIT_V(6); PG8_BAR; PG8_MMA(1, 1, At, B1); PG8_BAR;
            PG8_LDB(B0, 1, 0); PG8_SCHED; PG8_LDA(At, 1, 0); PG8_STAGE(PG8_SA(0, 1), a2 + hstep, voffA);
            PG8_WAIT_L(8); PG8_BAR; PG8_WAIT_L(0); PG8_MMA(0, 0, At, B0); PG8_BAR; PG8_SCHED;
            PG8_LDB(B1, 1, 1); PG8_STAGE(PG8_SB(1, 0), b3, voffB);
            PG8_BAR; PG8_WAIT_L(0); PG8_MMA(0, 1, At, B1); PG8_BAR;
            PG8_LDA(At, 1, 1); PG8_STAGE(PG8_SA(1, 0), a3, voffA);
            PG8_BAR; PG8_WAIT_L(0); PG8_MMA(1, 0, At, B0); PG8_BAR; PG8_SCHED;
            PG8_STAGE(PG8_SB(1, 1), b3 + hstep, voffB);
            PG8_WAIT_V(6); PG8_BAR; PG8_MMA(1, 1, At, B1); PG8_BAR;
            }
        }
        if constexpr (ALIGN_EPI) { if (wr == 0) PG8_BAR; }
        if constexpr (!Epi::AFTER_DRAIN) { E(acc, cur, wr, wc, fr, fq); S.done(cur); }
        if (!has_next) break;
#pragma unroll
        for (int a = 0; a < 2; ++a)
#pragma unroll
            for (int b = 0; b < 2; ++b)
#pragma unroll
                for (int m = 0; m < 4; ++m)
#pragma unroll
                    for (int n = 0; n < 2; ++n) acc[a][b][m][n] = (f32x4){0.f, 0.f, 0.f, 0.f};
        cur = nxt; cA = nA; cB = nB; ++ui;
        if constexpr (ALIGN_EPI) { if (wr == 1) PG8_BAR; }
    }
    PG8_WAIT_V(0);
    if constexpr (!ALIGN_EPI) { if (wr == 0) PG8_BAR; }
    PG8_BAR;
    if constexpr (Epi::AFTER_DRAIN) { E.fused(acc, cur, wr, wc, fr, fq, lds, wid, lane); S.done(cur); }
#undef PG8_SA
#undef PG8_SB
#undef PG8_STAGE
#undef PG8_LDA
#undef PG8_LDB
#undef PG8_MMA
#undef PG8_WAIT_V
#undef PG8_WAIT_L
#undef PG8_BAR
#undef PG8_SCHED
}
}

constexpr int DM = 1024, NBATCH = 8, SEQ = 4096, DECB = 128, DECS = 8;
constexpr int MP = NBATCH * SEQ, MS = DECB * DECS, MT = MP + MS;
constexpr int HD = 64, NH = 16, NKV = 4, WIN = 128, KVW = 256;
constexpr int SHW = 3200, INC = 8832;
constexpr int N1A = 2560, N1B = 6400, N1 = N1A + N1B;
constexpr float NORM_EPS = 1e-6f, GN_EPS = 64e-5f;

constexpr size_t O_Y = 0;
constexpr size_t O_PKW = (size_t)MT * DM;
constexpr size_t O_PVW = O_PKW + (size_t)NBATCH * WIN * KVW;
constexpr size_t O_PWKV = O_PVW + (size_t)NBATCH * WIN * KVW;
constexpr size_t O_PSH = O_PWKV + (size_t)NBATCH * NH * HD * HD;
constexpr size_t O_SKW = O_PSH + (size_t)NBATCH * SHW;
constexpr size_t O_SVW = O_SKW + (size_t)DECB * WIN * KVW;
constexpr size_t O_SWKV = O_SVW + (size_t)DECB * WIN * KVW;
constexpr size_t O_SSH = O_SWKV + (size_t)DECB * NH * HD * HD;
constexpr size_t O_END = O_SSH + (size_t)DECB * SHW;
static_assert(O_END == 52864000, "output size");

constexpr size_t MiB = 1u << 20;
constexpr size_t WS_CTL = 0, CTL_ZERO_BYTES = 1 * MiB;
constexpr size_t WS_SS = 512 * 1024;
constexpr size_t WS_W1T = 2 * MiB;
constexpr size_t WS_WAT = 20 * MiB, WS_WBT = 22 * MiB, WS_WOT = 24 * MiB;
constexpr size_t WS_XN = 26 * MiB;
constexpr size_t WS_Q = 92 * MiB;
constexpr size_t WS_K = 158 * MiB;
constexpr size_t WS_V = WS_K + (size_t)MT * KVW * 2;
constexpr size_t WS_GA = 191 * MiB;
constexpr size_t WS_PS = 257 * MiB;
constexpr size_t WS_END = 464 * MiB;
static_assert(WS_W1T + (size_t)N1 * DM * 2 <= WS_WAT && WS_V + (size_t)MT * KVW * 2 <= WS_GA && WS_PS + (size_t)MT * SHW * 2 <= WS_END, "ws map");

constexpr int CW_BAR = 4096;

constexpr int RING_BYTES = 131072;
constexpr int LDSCTL_OFF = RING_BYTES, MISC_OFF = LDSCTL_OFF + 320, SMALL_OFF = LDSCTL_OFF + 1024;
constexpr int LDS_BYTES = 147456;
constexpr int NWAVES = 8, NTHR = 512;

#define GAS __attribute__((address_space(1)))
#define LAS __attribute__((address_space(3)))
typedef unsigned short bf16;
typedef unsigned v4u __attribute__((ext_vector_type(4)));
typedef unsigned v2u __attribute__((ext_vector_type(2)));
typedef float f32x4 __attribute__((ext_vector_type(4)));
typedef float f32x16 __attribute__((ext_vector_type(16)));
typedef short bf16x8 __attribute__((ext_vector_type(8)));
typedef GAS unsigned gu32;
#define RLX_AGENT __ATOMIC_RELAXED, __HIP_MEMORY_SCOPE_AGENT
#define LDS_WAIT() asm volatile("s_waitcnt lgkmcnt(0)" ::: "memory")
#define VM_WAIT() asm volatile("s_waitcnt vmcnt(0)" ::: "memory")
__device__ __forceinline__ unsigned f2bf(float f) { unsigned u = __builtin_bit_cast(unsigned, f); return (u + 0x7fffu + ((u >> 16) & 1u)) >> 16; }
__device__ __forceinline__ unsigned pk2(float lo, float hi) { return f2bf(lo) | (f2bf(hi) << 16); }
__device__ __forceinline__ float bflo(unsigned u) { return __builtin_bit_cast(float, u << 16); }
__device__ __forceinline__ float bfhi(unsigned u) { return __builtin_bit_cast(float, u & 0xffff0000u); }
__device__ __forceinline__ float sigmoidf_(float x) { return __builtin_amdgcn_rcpf(1.0f + __expf(-x)); }

#define XB_TMO      128
#define XB_XCNT(j)  (256  + 64 * (j))
#define XB_XSUB(j)  (1280 + 64 * (j))
#define XB_XGEN(j)  (2304 + 64 * (j))
#define XB_TOP      3328
#define XB_TOPGEN   3392
#define XCD_BAR_WORDS 3456
#define XB_SPIN_CAP (1u << 23)
__device__ __forceinline__ unsigned xb_ld(unsigned* p)              { return __hip_atomic_load(p, __ATOMIC_RELAXED, __HIP_MEMORY_SCOPE_AGENT); }
__device__ __forceinline__ unsigned xb_add(unsigned* p, unsigned v) { return __hip_atomic_fetch_add(p, v, __ATOMIC_RELAXED, __HIP_MEMORY_SCOPE_AGENT); }
__device__ __forceinline__ unsigned xb_xcc_id() { return (unsigned)__builtin_amdgcn_s_getreg((3 << 11) | 20) & 0xFu; }
#define XB_SPIN(cond, bar) do { unsigned _sp = 0; while (cond) { __builtin_amdgcn_s_sleep(1); \
    if ((++_sp & 255u) == 0u) { if (xb_ld(&(bar)[XB_TMO])) break; if (_sp > XB_SPIN_CAP) { atomicAdd(&(bar)[XB_TMO], 1u); break; } } } } while (0)
struct XcdBarrier { unsigned* bar; unsigned x; volatile LAS unsigned* st; };
__device__ __forceinline__ XcdBarrier xcd_barrier_post(unsigned* bar, volatile LAS unsigned* st) {
    XcdBarrier b; b.bar = bar; b.x = xb_xcc_id(); b.st = st;
    if (threadIdx.x == 0) (void)xb_add(&bar[XB_XCNT(b.x)], 1u);
    return b;
}
__device__ __forceinline__ void xcd_barrier_complete(unsigned* bar, unsigned x, unsigned& nloc, unsigned& nx) {
    const unsigned G = gridDim.x * gridDim.y * gridDim.z;
    unsigned sum, cnt, mine, sp = 0u;
    for (;;) {
        sum = 0u; cnt = 0u; mine = 0u;
#pragma unroll
        for (unsigned j = 0; j < 16; ++j) { const unsigned c = xb_ld(&bar[XB_XCNT(j)]); sum += c; cnt += (c > 0u) ? 1u : 0u; mine = (j == x) ? c : mine; }
        if (sum == G) break;
        __builtin_amdgcn_s_sleep(1);
        if ((++sp & 255u) == 0u) { if (xb_ld(&bar[XB_TMO])) break; if (sp > XB_SPIN_CAP) { atomicAdd(&bar[XB_TMO], 1u); break; } }
    }
    nloc = mine > 0u ? mine : 1u; nx = cnt > 0u ? cnt : 1u;
}
__device__ __forceinline__ void xcd_barrier(const XcdBarrier& b) {
    asm volatile("s_waitcnt vmcnt(0)" ::: "memory");
    __syncthreads();
    if (threadIdx.x == 0) {
        unsigned* bar = b.bar;
        __builtin_amdgcn_s_waitcnt(0);
        unsigned nloc = b.st[0], nx = b.st[1];
        if (nloc == 0u) { xcd_barrier_complete(bar, b.x, nloc, nx); b.st[0] = nloc; b.st[1] = nx; }
        const unsigned old = xb_add(&bar[XB_XSUB(b.x)], 1u);
        const unsigned gen = old / nloc;
        if (old + 1u == (gen + 1u) * nloc) {
            __builtin_amdgcn_fence(__ATOMIC_RELEASE, "agent");
            asm volatile("s_waitcnt vmcnt(0)" ::: "memory");
            const unsigned og = xb_add(&bar[XB_TOP], 1u);
            const unsigned tg = og / nx;
            if (og + 1u == (tg + 1u) * nx) xb_add(&bar[XB_TOPGEN], 1u);
            else XB_SPIN(xb_ld(&bar[XB_TOPGEN]) == tg, bar);
            __builtin_amdgcn_fence(__ATOMIC_ACQUIRE, "agent");
            xb_add(&bar[XB_XGEN(b.x)], 1u);
            asm volatile("s_waitcnt vmcnt(0)" ::: "memory");
        } else {
            XB_SPIN(xb_ld(&bar[XB_XGEN(b.x)]) == gen, bar);
            __builtin_amdgcn_fence(__ATOMIC_ACQUIRE, "agent");
            asm volatile("s_waitcnt vmcnt(0)" ::: "memory");
        }
    }
    __syncthreads();
}

struct Args { const float* in[24]; float* out; unsigned char* ws; int ph_lo, ph_hi; };
static_assert(sizeof(Args) == 24 * 8 + 8 + 8 + 8, "no padding");
struct Frame {
    LAS unsigned char* lds;
    int wave, G, vcu;
    float* out; unsigned char* ws;
};
__device__ __forceinline__ int lane_id() { return (int)__builtin_amdgcn_mbcnt_hi(~0u, __builtin_amdgcn_mbcnt_lo(~0u, 0u)); }
enum { I_XP = 0, I_XS, I_CK, I_CV, I_SWKV, I_SSHIFT, I_RELB, I_NORMG, I_WIN, I_SINK, I_MU, I_W0, I_W2, I_A0, I_A2, I_KK, I_KA, I_RK, I_LNG, I_LNB, I_WOA, I_WOB, I_WO, I_FING };

__device__ __forceinline__ float wave_sum(float v) {
#pragma unroll
    for (int o = 1; o < 64; o <<= 1) v += __shfl_xor(v, o);
    return v;
}

__device__ __forceinline__ void p0_transpose_item(const float* W, int ldw, int srccol0, int K, bf16* WT, int dstrow0, LAS float* scr, int kb, int lane) {
    const int k0 = 64 * kb;
    if (srccol0 >= 0) {
#pragma unroll 8
        for (int i = 0; i < 32; ++i) { const int kk = 2 * i + (lane >> 5); scr[kk * 33 + (lane & 31)] = W[(size_t)(k0 + kk) * ldw + srccol0 + (lane & 31)]; }
    }
    LDS_WAIT(); asm volatile("" ::: "memory");
    const int c = lane & 7;
#pragma unroll
    for (int j = 0; j < 4; ++j) { const int n = (lane >> 3) + 8 * j; const LAS float* s = scr + (8 * c) * 33 + n;
        v4u o = (v4u){0u, 0u, 0u, 0u};
        if (srccol0 >= 0) { o.x = pk2(s[0 * 33], s[1 * 33]); o.y = pk2(s[2 * 33], s[3 * 33]); o.z = pk2(s[4 * 33], s[5 * 33]); o.w = pk2(s[6 * 33], s[7 * 33]); }
        *(GAS v4u*)(WT + (size_t)(dstrow0 + n) * K + k0 + 8 * c) = o; }
    LDS_WAIT(); asm volatile("" ::: "memory");
}
__device__ __forceinline__ void rms_row_to_bf16(const float* xrow, const float* g, bf16* orow, int lane) {
    const GAS f32x4* xr = (const GAS f32x4*)xrow + lane; const GAS f32x4* gr = (const GAS f32x4*)g + lane;
    f32x4 v[4]; float s = 0.f;
#pragma unroll
    for (int j = 0; j < 4; ++j) { v[j] = xr[64 * j]; s += (v[j].x * v[j].x + v[j].y * v[j].y) + (v[j].z * v[j].z + v[j].w * v[j].w); }
    const float sc = 1.0f / sqrtf(wave_sum(s) * (1.f / DM) + NORM_EPS);
    GAS v2u* o8 = (GAS v2u*)orow + lane;
#pragma unroll
    for (int j = 0; j < 4; ++j) { const f32x4 gv = gr[64 * j]; v2u o; o.x = pk2(v[j].x * sc * gv.x, v[j].y * sc * gv.y); o.y = pk2(v[j].z * sc * gv.z, v[j].w * sc * gv.w); o8[64 * j] = o; }
}
__device__ __forceinline__ void p0_prologue(const Frame& F, const Args& AR) {
    const int lane = lane_id();
    LAS float* scr = (LAS float*)(F.lds + F.wave * 16384);
    const int gw = F.vcu * NWAVES + F.wave, NGW = F.G * NWAVES;
    constexpr int I_1 = 16 * (N1 / 32), I_S = 16 * 32, NITEMS = I_1 + 3 * I_S;
    bf16* W1T = (bf16*)(F.ws + WS_W1T);
    for (int it = gw; it < NITEMS; it += NGW) {
        int r = it;
        if (r < I_1) { const int kb = r / (N1 / 32), nb = r % (N1 / 32), n0 = 32 * nb;
            const int src = n0 < 5760 ? n0 : (n0 < 5888 ? -1 : n0 - 128);
            p0_transpose_item(AR.in[I_WIN], INC, src, DM, W1T, n0, scr, kb, lane); continue; }
        r -= I_1;
        const int which = r / I_S; r -= which * I_S;
        const float* W = which == 0 ? AR.in[I_WOA] : (which == 1 ? AR.in[I_WOB] : AR.in[I_WO]);
        bf16* WT = (bf16*)(F.ws + (which == 0 ? WS_WAT : (which == 1 ? WS_WBT : WS_WOT)));
        p0_transpose_item(W, DM, 32 * (r % 32), DM, WT, 32 * (r % 32), scr, r / 32, lane);
    }
    bf16* XN = (bf16*)(F.ws + WS_XN);
    for (int m = gw; m < MT; m += NGW) {
        const float* xr = m < MP ? AR.in[I_XP] + (size_t)m * DM : AR.in[I_XS] + (size_t)(m - MP) * DM;
        rms_row_to_bf16(xr, AR.in[I_NORMG], XN + (size_t)m * DM, lane);
    }
}

struct EpiG1 {
    static constexpr bool PERM = true, AFTER_DRAIN = false;
    int part; unsigned char* ws; float* out;
    __device__ __forceinline__ void operator()(const f32x4 (&acc)[2][2][4][2], const pg8::Unit& u, int wr, int wc, int fr, int fq) const {
        bf16* dst; int ld, act = 0, valid = 256, side = 0;
        const int pn = u.pn;
        if (part == 0) {
            if (pn < 4) { dst = (bf16*)(ws + WS_Q) + pn * 256; ld = DM; }
            else if (pn == 4) { dst = (bf16*)(ws + WS_K); ld = KVW; side = 1; }
            else if (pn == 5) { dst = (bf16*)(ws + WS_V); ld = KVW; side = 2; }
            else { dst = (bf16*)(ws + WS_GA) + (pn - 6) * 256; ld = DM; act = 1; }
        } else {
            if (pn < 13) { dst = (bf16*)(ws + WS_PS) + pn * 256; ld = SHW; side = 3; if (pn == 12) valid = 128; }
            else if (pn < 17) { dst = (bf16*)(ws + WS_GA) + (pn - 13) * 256; ld = DM; act = 1; }
            else if (pn < 21) { dst = (bf16*)out + (pn - 17) * 256; ld = DM; act = 2; }
            else { dst = (bf16*)out + (size_t)MT * DM + (pn - 21) * 256; ld = DM; act = 2; }
        }
        const int rt0 = wr * 64 + fr, cit0 = wc * 32 + 8 * fq;
#pragma unroll
        for (int ai = 0; ai < 2; ++ai)
#pragma unroll
            for (int m = 0; m < 4; ++m) { bf16* rowp = dst + (size_t)(u.pm * 256 + rt0 + ai * 128 + m * 16) * ld + cit0;
#pragma unroll
                for (int bj = 0; bj < 2; ++bj) { if (bj * 128 >= valid) continue;
                    f32x4 v0 = acc[ai][bj][m][0], v1 = acc[ai][bj][m][1];
                    if (act) {
#pragma unroll
                        for (int e = 0; e < 4; ++e) { const float s0 = sigmoidf_(v0[e]), s1 = sigmoidf_(v1[e]); v0[e] = act == 1 ? v0[e] * s0 : s0; v1[e] = act == 1 ? v1[e] * s1 : s1; }
                    }
                    pg8::u32x4 w; w.x = pg8::cvt_pk_bf16(v0[0], v0[1]); w.y = pg8::cvt_pk_bf16(v0[2], v0[3]); w.z = pg8::cvt_pk_bf16(v1[0], v1[1]); w.w = pg8::cvt_pk_bf16(v1[2], v1[3]);
                    *(pg8::u32x4*)(rowp + bj * 128) = w; } }
        int r0 = rt0, c0 = cit0;
        if (side) asm volatile("" : "+v"(r0), "+v"(c0));
        if (side == 1 || side == 2) {
            if (u.pm < 128) {
                if ((u.pm & 15) == 15) { float* base = out + (side == 1 ? O_PKW : O_PVW) + (size_t)(u.pm >> 4) * WIN * KVW;
#pragma unroll
                    for (int m = 0; m < 4; ++m) { float* rp = base + (size_t)(r0 + m * 16) * KVW + c0;
#pragma unroll
                        for (int bj = 0; bj < 2; ++bj)
#pragma unroll
                            for (int n = 0; n < 2; ++n) *(f32x4*)(rp + bj * 128 + 4 * n) = acc[1][bj][m][n]; } }
            } else { float* base = out + (side == 1 ? O_SKW : O_SVW);
#pragma unroll
                for (int ai = 0; ai < 2; ++ai)
#pragma unroll
                    for (int m = 0; m < 4; ++m) { const int rs = (u.pm - 128) * 256 + r0 + ai * 128 + m * 16; float* rp = base + ((size_t)(rs >> 3) * WIN + 120 + (rs & 7)) * KVW + c0;
#pragma unroll
                        for (int bj = 0; bj < 2; ++bj)
#pragma unroll
                            for (int n = 0; n < 2; ++n) *(f32x4*)(rp + bj * 128 + 4 * n) = acc[ai][bj][m][n]; }
            }
        } else if (side == 3) {
            if (u.pm < 128) {
                if ((u.pm & 15) == 15 && wr == 1 && fr == 15) { float* rp = out + O_PSH + (size_t)(u.pm >> 4) * SHW + pn * 256 + c0;
#pragma unroll
                    for (int bj = 0; bj < 2; ++bj) { if (bj * 128 >= valid) continue;
#pragma unroll
                        for (int n = 0; n < 2; ++n) *(f32x4*)(rp + bj * 128 + 4 * n) = acc[1][bj][3][n]; } }
            } else if ((fr & 7) == 7) {
#pragma unroll
                for (int ai = 0; ai < 2; ++ai)
#pragma unroll
                    for (int m = 0; m < 4; ++m) { const int rs = (u.pm - 128) * 256 + r0 + ai * 128 + m * 16; float* rp = out + O_SSH + (size_t)(rs >> 3) * SHW + pn * 256 + c0;
#pragma unroll
                        for (int bj = 0; bj < 2; ++bj) { if (bj * 128 >= valid) continue;
#pragma unroll
                            for (int n = 0; n < 2; ++n) *(f32x4*)(rp + bj * 128 + 4 * n) = acc[ai][bj][m][n]; } }
            }
        }
    }
};
struct EpiGate {
    static constexpr bool PERM = true, AFTER_DRAIN = false;
    int mode; const bf16* gate; const bf16* tin; bf16* dst;
    __device__ __forceinline__ void operator()(const f32x4 (&acc)[2][2][4][2], const pg8::Unit& u, int wr, int wc, int fr, int fq) const {
        const int rt0 = u.pm * 256 + wr * 64 + fr, c0 = u.pn * 256 + wc * 32 + 8 * fq;
#pragma unroll
        for (int ai = 0; ai < 2; ++ai)
#pragma unroll
            for (int m = 0; m < 4; ++m) { const size_t ro = (size_t)(rt0 + ai * 128 + m * 16) * DM + c0;
#pragma unroll
                for (int bj = 0; bj < 2; ++bj) {
                    const v4u g = *(const v4u*)(gate + ro + bj * 128);
                    f32x4 v0 = acc[ai][bj][m][0], v1 = acc[ai][bj][m][1];
                    v0[0] *= bflo(g.x); v0[1] *= bfhi(g.x); v0[2] *= bflo(g.y); v0[3] *= bfhi(g.y); v1[0] *= bflo(g.z); v1[1] *= bfhi(g.z); v1[2] *= bflo(g.w); v1[3] *= bfhi(g.w);
                    if (mode == 1) { const v4u t = *(const v4u*)(tin + ro + bj * 128);
                        v0[0] += bflo(t.x); v0[1] += bfhi(t.x); v0[2] += bflo(t.y); v0[3] += bfhi(t.y); v1[0] += bflo(t.z); v1[1] += bfhi(t.z); v1[2] += bflo(t.w); v1[3] += bfhi(t.w); }
                    pg8::u32x4 w; w.x = pg8::cvt_pk_bf16(v0[0], v0[1]); w.y = pg8::cvt_pk_bf16(v0[2], v0[3]); w.z = pg8::cvt_pk_bf16(v1[0], v1[1]); w.w = pg8::cvt_pk_bf16(v1[2], v1[3]);
                    *(pg8::u32x4*)(dst + ro + bj * 128) = w; } }
    }
};
struct EpiOut {
    static constexpr bool PERM = false, AFTER_DRAIN = false;
    const float* xp; const float* xs; float* out; float* ss;
    __device__ __forceinline__ void operator()(const f32x4 (&acc)[2][2][4][2], const pg8::Unit& u, int wr, int wc, int fr, int fq) const {
        const int rt0 = u.pm * 256 + wr * 64 + fr, c0 = u.pn * 256 + wc * 32 + 4 * fq;
#pragma unroll
        for (int ai = 0; ai < 2; ++ai)
#pragma unroll
            for (int m = 0; m < 4; ++m) { const int row = rt0 + ai * 128 + m * 16;
                const float* xr = (row < MP ? xp + (size_t)row * DM : xs + (size_t)(row - MP) * DM) + c0; float* orow = out + (size_t)row * DM + c0; float s = 0.f;
#pragma unroll
                for (int bj = 0; bj < 2; ++bj)
#pragma unroll
                    for (int n = 0; n < 2; ++n) { const f32x4 xv = *(const f32x4*)(xr + bj * 128 + n * 16); const f32x4 o = xv + acc[ai][bj][m][n];
                        *(f32x4*)(orow + bj * 128 + n * 16) = o; s += (o[0] * o[0] + o[1] * o[1]) + (o[2] * o[2] + o[3] * o[3]); }
                s += __shfl_xor(s, 16); s += __shfl_xor(s, 32);
                if (fq == 0) atomicAdd(ss + row, s); }
    }
};

__device__ const unsigned char T5B[132] = {0, 1, 2, 3, 4, 5, 6, 7, 8, 9, 10, 11, 12, 13, 14, 15, 16, 16, 16, 17, 17, 18, 18, 18, 19, 19, 19, 20, 20, 20, 20, 21, 21, 21, 21, 22, 22, 22, 22, 22, 23, 23, 23, 23, 23, 23, 24, 24, 24, 24, 24, 24, 25, 25, 25, 25, 25, 25, 25, 26, 26, 26, 26, 26, 26, 26, 26, 27, 27, 27, 27, 27, 27, 27, 27, 27, 27, 28, 28, 28, 28, 28, 28, 28, 28, 28, 28, 29, 29, 29, 29, 29, 29, 29, 29, 29, 29, 29, 29, 30, 30, 30, 30, 30, 30, 30, 30, 30, 30, 30, 30, 30, 30, 31, 31, 31, 31, 31, 31, 31, 31, 31, 31, 31, 31, 31, 31, 31, 31, 31, 31, 31};
constexpr int AT_KP = 144, AT_VP = 520, AT_VT_OFF = 256 * AT_KP, AT_BT_OFF = AT_VT_OFF + 64 * AT_VP;
__device__ __forceinline__ int crow(int r, int hi) { return (r & 3) + 8 * (r >> 2) + 4 * hi; }

template <int MODE>
__device__ __forceinline__ void attn_task(const Frame& F, const Args& AR, int b, int kvh, int n, int g_, int i) {
    LAS unsigned char* KL = F.lds; LAS unsigned char* VT = F.lds + AT_VT_OFF; LAS float* BT = (LAS float*)(F.lds + AT_BT_OFF);
    const int lane = lane_id(), q = lane & 31, hi = lane >> 5;
    int g, mq, dq;
    if (MODE == 0) { g = g_; mq = b * SEQ + n * 128 + 32 * i + q; dq = 128 + q; }
    else { g = q >> 3; mq = MP + b * DECS + (q & 7); dq = 128 + (q & 7); }
    const int h = kvh * 4 + g;
    bf16* QO = (bf16*)(F.ws + WS_Q); const bf16* GA = (const bf16*)(F.ws + WS_GA);
    bf16x8 qf[4];
    { const bf16* qp = QO + (size_t)mq * DM + h * HD + 8 * hi;
#pragma unroll
      for (int s = 0; s < 4; ++s) qf[s] = *(const bf16x8*)(qp + 16 * s); }
    const int kt0 = MODE == 0 ? i : 0;
    f32x16 sc[5];
    const float sink = AR.in[I_SINK][h];
    const LAS float* bt = BT + g * 192 + 32 + dq - 4 * hi;
    float mx = sink;
#pragma unroll
    for (int t = 0; t < 5; ++t) { const LAS unsigned char* kp = KL + (32 * (kt0 + t) + q) * AT_KP + 16 * hi; f32x16 a = {0.f, 0.f, 0.f, 0.f, 0.f, 0.f, 0.f, 0.f, 0.f, 0.f, 0.f, 0.f, 0.f, 0.f, 0.f, 0.f};
#pragma unroll
        for (int s = 0; s < 4; ++s) { const bf16x8 kf = *(const LAS bf16x8*)(kp + 32 * s); a = __builtin_amdgcn_mfma_f32_32x32x16_bf16(kf, qf[s], a, 0, 0, 0); }
        const bool dead = (MODE == 0) && n == 0 && (i + t) < 4;
#pragma unroll
        for (int r = 0; r < 16; ++r) { const int kb0 = 32 * t + (r & 3) + 8 * (r >> 2);
            float sv = a[r] * 0.125f + bt[-kb0]; sv = dead ? -INFINITY : sv; a[r] = sv; mx = fmaxf(mx, sv); }
        sc[t] = a;
        __builtin_amdgcn_sched_barrier(0); }
    mx = fmaxf(mx, __shfl_xor(mx, 32));
    float sum = 0.f;
#pragma unroll
    for (int t = 0; t < 5; ++t)
#pragma unroll
        for (int r = 0; r < 16; ++r) { const float p = __expf(sc[t][r] - mx); sum += p; sc[t][r] = p; }
    sum += __shfl_xor(sum, 32); sum += __expf(sink - mx);
    const float inv = 1.0f / sum;
    f32x16 o[2];
#pragma unroll
    for (int d = 0; d < 2; ++d) o[d] = (f32x16){0.f, 0.f, 0.f, 0.f, 0.f, 0.f, 0.f, 0.f, 0.f, 0.f, 0.f, 0.f, 0.f, 0.f, 0.f, 0.f};
#pragma unroll
    for (int t = 0; t < 5; ++t)
#pragma unroll
        for (int s2 = 0; s2 < 2; ++s2) {
            v4u pw; pw.x = pk2(sc[t][8 * s2 + 0], sc[t][8 * s2 + 1]); pw.y = pk2(sc[t][8 * s2 + 2], sc[t][8 * s2 + 3]); pw.z = pk2(sc[t][8 * s2 + 4], sc[t][8 * s2 + 5]); pw.w = pk2(sc[t][8 * s2 + 6], sc[t][8 * s2 + 7]);
            const bf16x8 pb = __builtin_bit_cast(bf16x8, pw);
#pragma unroll
            for (int d = 0; d < 2; ++d) { const LAS unsigned char* vp = VT + (32 * d + q) * AT_VP + (32 * (kt0 + t) + 16 * s2 + 4 * hi) * 2;
                const v2u lo = *(const LAS v2u*)vp, hi2 = *(const LAS v2u*)(vp + 16);
                v4u aw; aw.x = lo.x; aw.y = lo.y; aw.z = hi2.x; aw.w = hi2.y;
                o[d] = __builtin_amdgcn_mfma_f32_32x32x16_bf16(__builtin_bit_cast(bf16x8, aw), pb, o[d], 0, 0, 0); }
            __builtin_amdgcn_sched_barrier(0); }
    bf16* op = QO + (size_t)mq * DM + h * HD; const bf16* gp = GA + (size_t)mq * DM + h * HD;
#pragma unroll
    for (int d = 0; d < 2; ++d)
#pragma unroll
        for (int rq = 0; rq < 4; ++rq) { const int dv0 = 32 * d + 8 * rq + 4 * hi; const v2u gv = *(const v2u*)(gp + dv0);
            v2u w; w.x = pk2(o[d][4 * rq + 0] * inv * bflo(gv.x), o[d][4 * rq + 1] * inv * bfhi(gv.x)); w.y = pk2(o[d][4 * rq + 2] * inv * bflo(gv.y), o[d][4 * rq + 3] * inv * bfhi(gv.y));
            *(v2u*)(op + dv0) = w; }
}

__device__ __forceinline__ void attn_unit(const Frame& F, const Args& AR, int unit) {
    LAS unsigned char* KL = F.lds; LAS unsigned char* VT = F.lds + AT_VT_OFF; LAS float* BT = (LAS float*)(F.lds + AT_BT_OFF);
    const bf16* Kb = (const bf16*)(F.ws + WS_K); const bf16* Vb = (const bf16*)(F.ws + WS_V);
    const int tid = F.wave * 64 + lane_id();
    __syncthreads();
    int b, kvh, n = 0;
    const bool sample = unit >= 1024;
    if (!sample) {
        kvh = unit & 3; n = (unit >> 2) & 31; b = unit >> 7;
        const int t0 = (n - 1) * 128;
#pragma unroll
        for (int it = 0; it < 4; ++it) { const int c = it * NTHR + tid, key = c >> 3, part = c & 7, tok = t0 + key; v4u val = (v4u){0u, 0u, 0u, 0u};
            if (tok >= 0) val = *(const v4u*)(Kb + (size_t)(b * SEQ + tok) * KVW + kvh * HD + part * 8);
            *(LAS v4u*)(KL + key * AT_KP + part * 16) = val; }
#pragma unroll
        for (int it = 0; it < 4; ++it) { const int c = it * NTHR + tid, key = c & 255, part = c >> 8, tok = t0 + key; v4u val = (v4u){0u, 0u, 0u, 0u};
            if (tok >= 0) val = *(const v4u*)(Vb + (size_t)(b * SEQ + tok) * KVW + kvh * HD + part * 8);
            LAS bf16* vt = (LAS bf16*)(VT + (part * 8) * AT_VP + key * 2);
            vt[0 * (AT_VP / 2)] = (bf16)val.x; vt[1 * (AT_VP / 2)] = (bf16)(val.x >> 16); vt[2 * (AT_VP / 2)] = (bf16)val.y; vt[3 * (AT_VP / 2)] = (bf16)(val.y >> 16);
            vt[4 * (AT_VP / 2)] = (bf16)val.z; vt[5 * (AT_VP / 2)] = (bf16)(val.z >> 16); vt[6 * (AT_VP / 2)] = (bf16)val.w; vt[7 * (AT_VP / 2)] = (bf16)(val.w >> 16); }
    } else {
        const int su = unit - 1024; kvh = su & 3; b = su >> 2;
        for (int c = tid; c < 160 * 8; c += NTHR) {
            { const int key = c >> 3, part = c & 7; v4u val = (v4u){0u, 0u, 0u, 0u};
              if (key < 128) { const float* src = AR.in[I_CK] + ((size_t)(b * WIN + key) * NKV + kvh) * HD + part * 8; const f32x4 a = *(const f32x4*)src, bb = *(const f32x4*)(src + 4);
                  val.x = pk2(a.x, a.y); val.y = pk2(a.z, a.w); val.z = pk2(bb.x, bb.y); val.w = pk2(bb.z, bb.w);
                  if (key >= 8) { float* d = F.out + O_SKW + ((size_t)(b * WIN + key - 8) * NKV + kvh) * HD + part * 8; *(f32x4*)d = a; *(f32x4*)(d + 4) = bb; } }
              else if (key < 136) val = *(const v4u*)(Kb + (size_t)(MP + b * DECS + key - 128) * KVW + kvh * HD + part * 8);
              *(LAS v4u*)(KL + key * AT_KP + part * 16) = val; }
            { const int key = c % 160, part = c / 160; v4u val = (v4u){0u, 0u, 0u, 0u};
              if (key < 128) { const float* src = AR.in[I_CV] + ((size_t)(b * WIN + key) * NKV + kvh) * HD + part * 8; const f32x4 a = *(const f32x4*)src, bb = *(const f32x4*)(src + 4);
                  val.x = pk2(a.x, a.y); val.y = pk2(a.z, a.w); val.z = pk2(bb.x, bb.y); val.w = pk2(bb.z, bb.w);
                  if (key >= 8) { float* d = F.out + O_SVW + ((size_t)(b * WIN + key - 8) * NKV + kvh) * HD + part * 8; *(f32x4*)d = a; *(f32x4*)(d + 4) = bb; } }
              else if (key < 136) val = *(const v4u*)(Vb + (size_t)(MP + b * DECS + key - 128) * KVW + kvh * HD + part * 8);
              LAS bf16* vt = (LAS bf16*)(VT + (part * 8) * AT_VP + key * 2);
              vt[0 * (AT_VP / 2)] = (bf16)val.x; vt[1 * (AT_VP / 2)] = (bf16)(val.x >> 16); vt[2 * (AT_VP / 2)] = (bf16)val.y; vt[3 * (AT_VP / 2)] = (bf16)(val.y >> 16);
              vt[4 * (AT_VP / 2)] = (bf16)val.z; vt[5 * (AT_VP / 2)] = (bf16)(val.z >> 16); vt[6 * (AT_VP / 2)] = (bf16)val.w; vt[7 * (AT_VP / 2)] = (bf16)(val.w >> 16); }
        }
    }
    for (int idx = tid; idx < 4 * 192; idx += NTHR) { const int g = idx / 192, d = idx - g * 192 - 32; BT[idx] = (d >= 0 && d <= 128) ? AR.in[I_RELB][(int)T5B[d] * NH + kvh * 4 + g] : -INFINITY; }
    __syncthreads();
    if (!sample) { for (int task = F.wave; task < 16; task += NWAVES) attn_task<0>(F, AR, b, kvh, n, task >> 2, task & 3); }
    else if (F.wave == 0) attn_task<1>(F, AR, b, kvh, 0, 0, 0);
}

namespace sc {
constexpr int P68 = 136, P36 = 72;
constexpr int W2T = 0, A2T = W2T + 64 * P68, TW = A2T + 64 * P68, AL = TW + 32 * P68, AT = AL + 32 * P68, RT = AT + 32 * P68, BT = RT + 32 * P68, KT = BT + 32 * P68, W1R = KT + 32 * P68;
constexpr int ATT = W1R + 32 * P68, BHT = ATT + 64 * P36, KHT = BHT + 64 * P36, VTT = KHT + 64 * P36;
constexpr int MAK = VTT + 64 * P36, MRK = MAK + 32 * P36, MRB = MRK + 32 * P36, TRM = MRB + 32 * P36, PRM = TRM + 32 * P36, ARM = PRM + 32 * P36;
constexpr int UW = ARM + 32 * P36, UA = UW + 32 * 65 * 4, YB = UA + 32 * 65 * 4, GC = YB + 32 * 65 * 4, END = GC + 256;
static_assert(END <= RING_BYTES && (UW % 16) == 0 && (GC % 16) == 0 && (MAK % 8) == 0, "scan LDS map");
}
typedef float f32x2_t __attribute__((ext_vector_type(2))); typedef __bf16 bf16x2_t __attribute__((ext_vector_type(2)));
__device__ __forceinline__ unsigned cvtpk(float lo, float hi) { f32x2_t v = {lo, hi}; bf16x2_t b = __builtin_convertvector(v, bf16x2_t); return __builtin_bit_cast(unsigned, b); }
__device__ __forceinline__ bf16x8 frag_nat(LAS const unsigned char* base, int pitch, int row, int col0) {
    LAS const unsigned char* p = base + row * pitch + col0 * 2; const v2u a = *(LAS const v2u*)p, b = *(LAS const v2u*)(p + 8);
    v4u w; w.x = a.x; w.y = a.y; w.z = b.x; w.w = b.y; return __builtin_bit_cast(bf16x8, w); }
__device__ __forceinline__ bf16x8 frag_perm(LAS const unsigned char* base, int pitch, int row, int c0, int hi) {
    LAS const unsigned char* p = base + row * pitch + (c0 + 4 * hi) * 2; const v2u a = *(LAS const v2u*)p, b = *(LAS const v2u*)(p + 16);
    v4u w; w.x = a.x; w.y = a.y; w.z = b.x; w.w = b.y; return __builtin_bit_cast(bf16x8, w); }
__device__ __forceinline__ bf16x8 pk8(const f32x16& x, int s) {
    v4u w; w.x = cvtpk(x[8 * s + 0], x[8 * s + 1]); w.y = cvtpk(x[8 * s + 2], x[8 * s + 3]); w.z = cvtpk(x[8 * s + 4], x[8 * s + 5]); w.w = cvtpk(x[8 * s + 6], x[8 * s + 7]); return __builtin_bit_cast(bf16x8, w); }
__device__ __forceinline__ void store_rm(LAS unsigned char* base, int pitch, const f32x16& x, int q, int hi) {
#pragma unroll
    for (int r = 0; r < 16; r += 2) { const unsigned w = cvtpk(x[r], x[r + 1]);
        *(LAS bf16*)(base + crow(r, hi) * pitch + 2 * q) = (bf16)w; *(LAS bf16*)(base + crow(r + 1, hi) * pitch + 2 * q) = (bf16)(w >> 16); }
}
#define MFMA32(a, b, c) __builtin_amdgcn_mfma_f32_32x32x16_bf16((a), (b), (c), 0, 0, 0)
#define ZERO16 ((f32x16){0.f, 0.f, 0.f, 0.f, 0.f, 0.f, 0.f, 0.f, 0.f, 0.f, 0.f, 0.f, 0.f, 0.f, 0.f, 0.f})
#define DPP_ADD(x, ctrl) ((x) + __builtin_bit_cast(float, __builtin_amdgcn_update_dpp(0, __builtin_bit_cast(int, (x)), (ctrl), 0xF, 0xF, true)))
__device__ __forceinline__ float reduce16(float x) { x = DPP_ADD(x, 0xB1); x = DPP_ADD(x, 0x4E); x = DPP_ADD(x, 0x141); x = DPP_ADD(x, 0x140); return x; }

__device__ __forceinline__ void scan_unit(const Frame& F, const Args& AR, int unit, int& cur_h) {
    LAS unsigned char* L = F.lds;
    const int lane = lane_id(), wave = F.wave, tid = wave * 64 + lane, q = lane & 31, hi = lane >> 5;
    const bool sample = unit >= 128;
    int b, h;
    if (!sample) { b = unit >> 4; h = unit & 15; } else { const int su = unit - 128; h = su >> 7; b = su & 127; }
    const size_t m0 = sample ? (size_t)MP + (size_t)b * DECS : (size_t)b * SEQ;
    const int ntok = sample ? DECS : 32, nch = sample ? 1 : SEQ / 32;
    const int tok = tid >> 4, cg = tid & 15, c0 = cg * 4, ch0 = h * HD + c0;
    const bf16* PS = (const bf16*)(F.ws + WS_PS); bf16* GB = (bf16*)(F.ws + WS_GA);
    __syncthreads();
    if (h != cur_h) {
        cur_h = h;
        const int j = tid >> 3, cb = (tid & 7) * 8;
        const float* p = AR.in[I_W2] + (size_t)j * DM + h * HD + cb; const f32x4 a0 = *(const f32x4*)p, a1 = *(const f32x4*)(p + 4);
        const float* p2 = AR.in[I_A2] + (size_t)j * DM + h * HD + cb; const f32x4 b0 = *(const f32x4*)p2, b1 = *(const f32x4*)(p2 + 4);
        const float wv[8] = {a0.x, a0.y, a0.z, a0.w, a1.x, a1.y, a1.z, a1.w}, av[8] = {b0.x, b0.y, b0.z, b0.w, b1.x, b1.y, b1.z, b1.w};
#pragma unroll
        for (int i = 0; i < 8; ++i) { *(LAS bf16*)(L + sc::W2T + (cb + i) * sc::P68 + 2 * j) = (bf16)cvtpk(wv[i], 0.f); *(LAS bf16*)(L + sc::A2T + (cb + i) * sc::P68 + 2 * j) = (bf16)cvtpk(av[i], 0.f); }
    }
    const int vh = wave - 4;
    f32x16 ST[2] = {ZERO16, ZERO16};
    if ((wave == 4 || wave == 5) && sample) {
        const float* sp = AR.in[I_SWKV] + ((size_t)(b * NH + h) * HD + 32 * vh + q) * HD;
#pragma unroll
        for (int kt = 0; kt < 2; ++kt)
#pragma unroll
            for (int g = 0; g < 4; ++g) { const f32x4 x = *(const f32x4*)(sp + 32 * kt + 8 * g + 4 * hi); ST[kt][4 * g + 0] = x.x; ST[kt][4 * g + 1] = x.y; ST[kt][4 * g + 2] = x.z; ST[kt][4 * g + 3] = x.w; }
    }
    for (int chn = 0; chn < nch; ++chn) {
        const int t0 = chn * 32; const bool act = tok < ntok;
        int tk = tok, cc = c0, qv = q, hv = hi;
        asm volatile("" : "+v"(tk), "+v"(cc), "+v"(qv), "+v"(hv));
        float zr[4], zk[4], zv[4], gt[4];
        {
            const size_t row = m0 + t0 + (act ? tok : 0); const bf16* P = PS + row * SHW; const bool first = (t0 + tok) == 0;
            float zz[5][4];
#pragma unroll
            for (int grp = 0; grp < 5; ++grp) {
                const int col = grp < 3 ? grp * 1024 + ch0 : (grp == 3 ? 3072 + c0 : 3136 + c0);
                const v2u cu = *(const v2u*)(P + col); const float cur[4] = {bflo(cu.x), bfhi(cu.x), bflo(cu.y), bfhi(cu.y)};
                float prv[4];
                if (!first) { const v2u pu = *(const v2u*)(P - SHW + col); prv[0] = bflo(pu.x); prv[1] = bfhi(pu.x); prv[2] = bflo(pu.y); prv[3] = bfhi(pu.y); }
                else if (sample) { const f32x4 a = *(const f32x4*)(AR.in[I_SSHIFT] + (size_t)b * SHW + col); prv[0] = a.x; prv[1] = a.y; prv[2] = a.z; prv[3] = a.w; }
                else { prv[0] = prv[1] = prv[2] = prv[3] = 0.f; }
                const f32x4 mu = *(const f32x4*)(AR.in[I_MU] + col);
#pragma unroll
                for (int i = 0; i < 4; ++i) zz[grp][i] = act ? cur[i] + (prv[i] - cur[i]) * mu[i] : 0.f;
            }
#pragma unroll
            for (int i = 0; i < 4; ++i) { zr[i] = zz[0][i]; zk[i] = zz[1][i]; zv[i] = zz[2][i]; }
            v2u w; w.x = cvtpk(tanhf(zz[3][0]), tanhf(zz[3][1])); w.y = cvtpk(tanhf(zz[3][2]), tanhf(zz[3][3])); *(LAS v2u*)(L + sc::TW + tk * sc::P68 + cc * 2) = w;
            w.x = cvtpk(zz[4][0], zz[4][1]); w.y = cvtpk(zz[4][2], zz[4][3]); *(LAS v2u*)(L + sc::AL + tk * sc::P68 + cc * 2) = w;
            const v2u gv = *(const v2u*)(GB + row * DM + ch0); gt[0] = bflo(gv.x); gt[1] = bfhi(gv.x); gt[2] = bflo(gv.y); gt[3] = bfhi(gv.y);
        }
        __syncthreads();
        if (wave < 4) {
            const int which = wave >> 1, ct = wave & 1; f32x16 acc = ZERO16;
            LAS const unsigned char* Aop = L + (which ? sc::AL : sc::TW); LAS const unsigned char* Bop = L + (which ? sc::A2T : sc::W2T);
#pragma unroll
            for (int s = 0; s < 4; ++s) acc = MFMA32(frag_nat(Aop, sc::P68, qv, 16 * s + 8 * hv), frag_nat(Bop, sc::P68, 32 * ct + qv, 16 * s + 8 * hv), acc);
            LAS float* o = (LAS float*)(L + (which ? sc::UA : sc::UW)) + 32 * ct + qv;
#pragma unroll
            for (int r = 0; r < 16; ++r) o[crow(r, hv) * 65] = acc[r];
        }
        __syncthreads();
        float lw[4], asg[4];
        {
            LAS float* uwp = (LAS float*)(L + sc::UW) + tk * 65 + cc; LAS const float* uap = (LAS const float*)(L + sc::UA) + tk * 65 + cc;
            const f32x4 w0 = *(const f32x4*)(AR.in[I_W0] + ch0), a0 = *(const f32x4*)(AR.in[I_A0] + ch0);
#pragma unroll
            for (int i = 0; i < 4; ++i) { lw[i] = act ? -0.6065306597126334f * sigmoidf_(uwp[i] + w0[i]) : 0.f; asg[i] = sigmoidf_(uap[i] + a0[i]); uwp[i] = lw[i]; }
        }
        __syncthreads();
        {
            const int c = tid >> 3, part = tid & 7; LAS float* p = (LAS float*)(L + sc::UW) + (4 * part) * 65 + c;
            float x0 = p[0], x1 = x0 + p[65], x2 = x1 + p[130], x3 = x2 + p[195];
            float inc = x3;
#pragma unroll
            for (int d = 1; d < 8; d <<= 1) { const float y = __shfl_up(inc, d, 8); if (part >= d) inc += y; }
            const float ex = inc - x3;
            p[0] = x0 + ex; p[65] = x1 + ex; p[130] = x2 + ex; p[195] = x3 + ex;
        }
        __syncthreads();
        float rk;
        {
            LAS const float* Lp_ = (LAS const float*)(L + sc::UW) + tk * 65 + cc; LAS const float* LCp = (LAS const float*)(L + sc::UW) + 31 * 65 + cc;
            const f32x4 kkw = *(const f32x4*)(AR.in[I_KK] + ch0), kaw = *(const f32x4*)(AR.in[I_KA] + ch0), rkw = *(const f32x4*)(AR.in[I_RK] + ch0);
            float kkv[4], ss = 0.f;
#pragma unroll
            for (int i = 0; i < 4; ++i) { kkv[i] = zk[i] * kkw[i]; ss += kkv[i] * kkv[i]; }
            ss = reduce16(ss);
            const float invn = 1.0f / fmaxf(sqrtf(ss), 1e-12f);
            float at[4], rt[4], bt[4], kt[4], bh[4], kh[4]; rk = 0.f;
#pragma unroll
            for (int i = 0; i < 4; ++i) { const float Lv = Lp_[i], LC = LCp[i];
                const float e2 = __expf(Lv), e1 = __expf(Lv - lw[i]), e3 = __expf(-Lv), e4 = __expf(LC - Lv);
                const float kn = kkv[i] * invn, kp = zk[i] * (1.0f + (asg[i] - 1.0f) * kaw[i]), bb = kn * asg[i];
                at[i] = -kn * e1; rt[i] = zr[i] * e2; bt[i] = bb * e3; kt[i] = kp * e3; bh[i] = bb * e4; kh[i] = kp * e4; rk += zr[i] * kp * rkw[i];
                if (tok == 31) ((LAS float*)(L + sc::GC))[cc + i] = __expf(LC); }
            rk = reduce16(rk);
            v2u w; w.x = cvtpk(at[0], at[1]); w.y = cvtpk(at[2], at[3]); *(LAS v2u*)(L + sc::AT + tk * sc::P68 + cc * 2) = w;
#pragma unroll
            for (int i = 0; i < 4; ++i) *(LAS bf16*)(L + sc::ATT + (cc + i) * sc::P36 + tk * 2) = (bf16)((i & 1) ? ((i & 2) ? w.y : w.x) >> 16 : ((i & 2) ? w.y : w.x));
            w.x = cvtpk(rt[0], rt[1]); w.y = cvtpk(rt[2], rt[3]); *(LAS v2u*)(L + sc::RT + tk * sc::P68 + cc * 2) = w;
            w.x = cvtpk(bt[0], bt[1]); w.y = cvtpk(bt[2], bt[3]); *(LAS v2u*)(L + sc::BT + tk * sc::P68 + cc * 2) = w;
            w.x = cvtpk(kt[0], kt[1]); w.y = cvtpk(kt[2], kt[3]); *(LAS v2u*)(L + sc::KT + tk * sc::P68 + cc * 2) = w;
            w.x = cvtpk(bh[0], bh[1]); w.y = cvtpk(bh[2], bh[3]);
#pragma unroll
            for (int i = 0; i < 4; ++i) *(LAS bf16*)(L + sc::BHT + (cc + i) * sc::P36 + tk * 2) = (bf16)((i & 1) ? ((i & 2) ? w.y : w.x) >> 16 : ((i & 2) ? w.y : w.x));
            w.x = cvtpk(kh[0], kh[1]); w.y = cvtpk(kh[2], kh[3]);
#pragma unroll
            for (int i = 0; i < 4; ++i) *(LAS bf16*)(L + sc::KHT + (cc + i) * sc::P36 + tk * 2) = (bf16)((i & 1) ? ((i & 2) ? w.y : w.x) >> 16 : ((i & 2) ? w.y : w.x));
            w.x = cvtpk(zv[0], zv[1]); w.y = cvtpk(zv[2], zv[3]);
#pragma unroll
            for (int i = 0; i < 4; ++i) *(LAS bf16*)(L + sc::VTT + (cc + i) * sc::P36 + tk * 2) = (bf16)((i & 1) ? ((i & 2) ? w.y : w.x) >> 16 : ((i & 2) ? w.y : w.x));
        }
        __syncthreads();
        f32x16 Pm = ZERO16;
        if (wave < 4) {
            LAS const unsigned char* Aop = L + ((wave < 2) ? sc::AT : sc::RT); LAS const unsigned char* Bop = L + ((wave == 0 || wave == 3) ? sc::BT : sc::KT);
#pragma unroll
            for (int s = 0; s < 4; ++s) Pm = MFMA32(frag_nat(Aop, sc::P68, qv, 16 * s + 8 * hv), frag_nat(Bop, sc::P68, qv, 16 * s + 8 * hv), Pm);
#pragma unroll
            for (int r = 0; r < 16; ++r) { const int t = crow(r, hv); const bool keep = (wave < 2) ? (qv < t) : (qv <= t); Pm[r] = keep ? Pm[r] : 0.f; }
            if (wave > 0) store_rm(L + (wave == 1 ? sc::MAK : (wave == 2 ? sc::MRK : sc::MRB)), sc::P36, Pm, qv, hv);
        }
        __syncthreads();
        f32x16 Xa = ZERO16, Y0 = ZERO16, H0[2] = {ZERO16, ZERO16};
        if (wave == 0) {
            f32x16 Am = Pm;
#pragma unroll
            for (int r = 0; r < 16; ++r) Am[r] += (crow(r, hv) == qv) ? 1.0f : 0.0f;
#pragma unroll
            for (int lv = 0; lv < 4; ++lv) {
                store_rm(L + sc::PRM, sc::P36, Pm, qv, hv); store_rm(L + sc::ARM, sc::P36, Am, qv, hv);
                const bf16x8 p0 = pk8(Pm, 0), p1 = pk8(Pm, 1);
                f32x16 Pn = MFMA32(frag_perm(L + sc::PRM, sc::P36, qv, 0, hv), p0, ZERO16); Pn = MFMA32(frag_perm(L + sc::PRM, sc::P36, qv, 16, hv), p1, Pn);
                const bf16x8 n0 = pk8(Pn, 0), n1 = pk8(Pn, 1);
                Am = MFMA32(frag_perm(L + sc::ARM, sc::P36, qv, 0, hv), n0, Am); Am = MFMA32(frag_perm(L + sc::ARM, sc::P36, qv, 16, hv), n1, Am);
                Pm = Pn;
            }
            store_rm(L + sc::TRM, sc::P36, Am, qv, hv);
#pragma unroll
            for (int nt = 0; nt < 2; ++nt) { f32x16 w1 = ZERO16;
#pragma unroll
                for (int s = 0; s < 2; ++s) w1 = MFMA32(frag_nat(L + sc::TRM, sc::P36, qv, 16 * s + 8 * hv), frag_nat(L + sc::ATT, sc::P36, 32 * nt + qv, 16 * s + 8 * hv), w1);
                store_rm(L + sc::W1R + 64 * nt, sc::P68, w1, qv, hv); }
        } else if (wave == 4 || wave == 5) {
            const bf16x8 vf0 = frag_nat(L + sc::VTT, sc::P36, 32 * vh + qv, 8 * hv), vf1 = frag_nat(L + sc::VTT, sc::P36, 32 * vh + qv, 16 + 8 * hv);
            Xa = MFMA32(frag_nat(L + sc::MAK, sc::P36, qv, 8 * hv), vf0, Xa); Xa = MFMA32(frag_nat(L + sc::MAK, sc::P36, qv, 16 + 8 * hv), vf1, Xa);
            Y0 = MFMA32(frag_nat(L + sc::MRK, sc::P36, qv, 8 * hv), vf0, Y0); Y0 = MFMA32(frag_nat(L + sc::MRK, sc::P36, qv, 16 + 8 * hv), vf1, Y0);
#pragma unroll
            for (int kt = 0; kt < 2; ++kt) { H0[kt] = MFMA32(frag_nat(L + sc::KHT, sc::P36, 32 * kt + qv, 8 * hv), vf0, H0[kt]); H0[kt] = MFMA32(frag_nat(L + sc::KHT, sc::P36, 32 * kt + qv, 16 + 8 * hv), vf1, H0[kt]); }
        }
        __syncthreads();
        if (wave == 4 || wave == 5) {
            f32x16 U = MFMA32(frag_perm(L + sc::TRM, sc::P36, qv, 0, hv), pk8(Xa, 0), ZERO16); U = MFMA32(frag_perm(L + sc::TRM, sc::P36, qv, 16, hv), pk8(Xa, 1), U);
            f32x16 Y = Y0;
#pragma unroll
            for (int kt = 0; kt < 2; ++kt)
#pragma unroll
                for (int s = 0; s < 2; ++s) { const bf16x8 sb = pk8(ST[kt], s);
                    U = MFMA32(frag_perm(L + sc::W1R, sc::P68, qv, 32 * kt + 16 * s, hv), sb, U);
                    Y = MFMA32(frag_perm(L + sc::RT, sc::P68, qv, 32 * kt + 16 * s, hv), sb, Y); }
            const bf16x8 u0 = pk8(U, 0), u1 = pk8(U, 1);
            Y = MFMA32(frag_perm(L + sc::MRB, sc::P36, qv, 0, hv), u0, Y); Y = MFMA32(frag_perm(L + sc::MRB, sc::P36, qv, 16, hv), u1, Y);
#pragma unroll
            for (int kt = 0; kt < 2; ++kt) { f32x16 acc;
#pragma unroll
                for (int g = 0; g < 4; ++g) { const f32x4 gc = *(LAS const f32x4*)(L + sc::GC + (32 * kt + 8 * g + 4 * hv) * 4);
                    acc[4 * g + 0] = gc.x * ST[kt][4 * g + 0] + H0[kt][4 * g + 0]; acc[4 * g + 1] = gc.y * ST[kt][4 * g + 1] + H0[kt][4 * g + 1];
                    acc[4 * g + 2] = gc.z * ST[kt][4 * g + 2] + H0[kt][4 * g + 2]; acc[4 * g + 3] = gc.w * ST[kt][4 * g + 3] + H0[kt][4 * g + 3]; }
                acc = MFMA32(frag_perm(L + sc::BHT, sc::P36, 32 * kt + qv, 0, hv), u0, acc); acc = MFMA32(frag_perm(L + sc::BHT, sc::P36, 32 * kt + qv, 16, hv), u1, acc);
                ST[kt] = acc; }
            LAS float* yo = (LAS float*)(L + sc::YB) + 32 * vh + qv;
#pragma unroll
            for (int r = 0; r < 16; ++r) yo[crow(r, hv) * 65] = Y[r];
        }
        __syncthreads();
        if (act) {
            LAS const float* yp = (LAS const float*)(L + sc::YB) + tk * 65 + cc;
            float y[4] = {yp[0], yp[1], yp[2], yp[3]};
            const float mean = reduce16((y[0] + y[1]) + (y[2] + y[3])) * (1.0f / 64.0f);
#pragma unroll
            for (int i = 0; i < 4; ++i) y[i] -= mean;
            const float var = reduce16((y[0] * y[0] + y[1] * y[1]) + (y[2] * y[2] + y[3] * y[3])) * (1.0f / 64.0f);
            const float rstd = 1.0f / sqrtf(var + GN_EPS);
            const f32x4 lg = *(const f32x4*)(AR.in[I_LNG] + ch0), lb = *(const f32x4*)(AR.in[I_LNB] + ch0);
            float o[4];
#pragma unroll
            for (int i = 0; i < 4; ++i) o[i] = (y[i] * rstd * lg[i] + lb[i] + rk * zv[i]) * gt[i];
            v2u w; w.x = cvtpk(o[0], o[1]); w.y = cvtpk(o[2], o[3]);
            *(v2u*)(GB + (m0 + t0 + tok) * DM + ch0) = w;
        }
    }
    if (wave == 4 || wave == 5) {
        float* dp = F.out + (sample ? O_SWKV : O_PWKV) + ((size_t)(b * NH + h) * HD + 32 * vh + q) * HD;
#pragma unroll
        for (int kt = 0; kt < 2; ++kt)
#pragma unroll
            for (int g = 0; g < 4; ++g) *(f32x4*)(dp + 32 * kt + 8 * g + 4 * hi) = (f32x4){ST[kt][4 * g + 0], ST[kt][4 * g + 1], ST[kt][4 * g + 2], ST[kt][4 * g + 3]};
    }
}

__device__ __forceinline__ void final_norm(const Frame& F, const Args& AR) {
    const int gw = F.vcu * NWAVES + F.wave, NGW = F.G * NWAVES;
    const float* ss = (const float*)(F.ws + WS_SS); const int lane = lane_id(); const GAS f32x4* gr = (const GAS f32x4*)AR.in[I_FING] + lane;
    for (int m = gw; m < MT; m += NGW) {
        const float sc = 1.0f / sqrtf(ss[m] * (1.f / DM) + NORM_EPS);
        GAS f32x4* xr = (GAS f32x4*)(F.out + (size_t)m * DM) + lane;
#pragma unroll
        for (int j = 0; j < 4; ++j) { const f32x4 v = xr[64 * j], g = gr[64 * j]; xr[64 * j] = v * sc * g; }
    }
}

#ifndef MK_PER_PHASE
#define MK_PER_PHASE 0
#endif
constexpr int N_PHASES = 9;
__global__ void __launch_bounds__(NTHR, 2) hybrid_fwd(Args args) {
    extern __shared__ __attribute__((aligned(16))) unsigned char lds[];
    Frame F;
    F.lds = (LAS unsigned char*)lds;
    F.wave = __builtin_amdgcn_readfirstlane(threadIdx.x >> 6);
    F.G = gridDim.x; { const int bx = blockIdx.x; F.vcu = (F.G % 8 == 0) ? (bx % 8) * (F.G / 8) + bx / 8 : bx; }
    F.out = args.out; F.ws = args.ws;
    volatile LAS unsigned* MISC = (volatile LAS unsigned*)(F.lds + MISC_OFF);
    for (int u = threadIdx.x; u < (LDS_BYTES - LDSCTL_OFF) / 4; u += NTHR) ((LAS unsigned*)(F.lds + LDSCTL_OFF))[u] = 0u;
    __syncthreads();
    XcdBarrier bar; bar.bar = (unsigned*)(F.ws + WS_CTL) + CW_BAR; bar.x = 0; bar.st = nullptr;
    if (!MK_PER_PHASE) bar = xcd_barrier_post((unsigned*)(F.ws + WS_CTL) + CW_BAR, MISC + 8);
    const int lo = args.ph_lo, hi = args.ph_hi;
#ifndef PHMASK
#define PHMASK 0x1ff
#endif
#define IN(k) ((((PHMASK) >> (k)) & 1) && lo <= (k) && (k) < hi)
#define SEAM(k) do { if (IN(k) && IN((k) + 1)) xcd_barrier(bar); } while (0)

    if (IN(0)) { p0_prologue(F, args); }
    SEAM(0);
    if (IN(1)) {
        pg8::Gemm g{(const bf16*)(F.ws + WS_XN), (const bf16*)(F.ws + WS_W1T), MT, N1A, DM}; pg8::StaticOrder S; S.init(MT, N1A, F.G, (int)blockIdx.x);
        EpiG1 E{0, F.ws, F.out};
        pg8::gemm_phase<EpiG1, pg8::StaticOrder, true, true>(F.lds, g, S, E);
    }
    SEAM(1);
    if (IN(2)) { for (int u = F.vcu; u < 1024 + 512; u += F.G) attn_unit(F, args, u); }
    SEAM(2);
    if (IN(3)) {
        pg8::Gemm g{(const bf16*)(F.ws + WS_XN), (const bf16*)(F.ws + WS_W1T) + (size_t)N1A * DM, MT, N1B, DM}; pg8::StaticOrder S; S.init(MT, N1B, F.G, (int)blockIdx.x);
        EpiG1 E{1, F.ws, F.out};
        pg8::gemm_phase<EpiG1, pg8::StaticOrder, true, true>(F.lds, g, S, E);
    }
    SEAM(3);
    if (IN(4)) { int cur_h = -1; const int bx = (int)blockIdx.x;
        int u0, cnt, stride;
        if (F.G >= 256) { if (bx < 128) { u0 = bx; cnt = 1; stride = 1; } else if (bx < 256) { u0 = 128 + (bx - 128) * 16; cnt = 16; stride = 1; } else { u0 = 0; cnt = 0; stride = 1; } }
        else { u0 = bx; stride = F.G; cnt = (128 + 2048 - bx + F.G - 1) / F.G; }
        for (int j = 0; j < cnt; ++j) scan_unit(F, args, u0 + j * stride, cur_h); }
    SEAM(4);
    if (IN(5)) {
        pg8::Gemm g{(const bf16*)(F.ws + WS_Q), (const bf16*)(F.ws + WS_WAT), MT, DM, DM}; pg8::StaticOrder S; S.init(MT, DM, F.G, (int)blockIdx.x);
        EpiGate E{0, (const bf16*)F.out, nullptr, (bf16*)(F.ws + WS_PS)};
        pg8::gemm_phase<EpiGate, pg8::StaticOrder, true, true>(F.lds, g, S, E);
    }
    SEAM(5);
    if (IN(6)) {
        pg8::Gemm g{(const bf16*)(F.ws + WS_GA), (const bf16*)(F.ws + WS_WBT), MT, DM, DM}; pg8::StaticOrder S; S.init(MT, DM, F.G, (int)blockIdx.x);
        EpiGate E{1, (const bf16*)F.out + (size_t)MT * DM, (const bf16*)(F.ws + WS_PS), (bf16*)(F.ws + WS_XN)};
        pg8::gemm_phase<EpiGate, pg8::StaticOrder, true, true>(F.lds, g, S, E);
    }
    SEAM(6);
    if (IN(7)) {
        pg8::Gemm g{(const bf16*)(F.ws + WS_XN), (const bf16*)(F.ws + WS_WOT), MT, DM, DM}; pg8::StaticOrder S; S.init(MT, DM, F.G, (int)blockIdx.x);
        EpiOut E{args.in[I_XP], args.in[I_XS], F.out, (float*)(F.ws + WS_SS)};
        pg8::gemm_phase<EpiOut, pg8::StaticOrder, true, true>(F.lds, g, S, E);
    }
    SEAM(7);
    if (IN(8)) { final_norm(F, args); }
#undef IN
#undef SEAM
}

extern "C" void kernel_launch(void* const* d_in, const int* in_sizes, int n_in, void* d_out, int out_size, void* d_ws, size_t ws_size, hipStream_t stream) {
    static int grid = 0;
    if (grid == 0) {
        if (n_in != 24 || (size_t)out_size != O_END || ws_size < WS_END) { fprintf(stderr, "kernel_launch: unexpected sizes: n_in %d out %d ws %zu (need %zu)\n", n_in, out_size, ws_size, (size_t)WS_END); grid = -1; return; }
        int dev = 0, cus = 0;
        if (hipGetDevice(&dev) != hipSuccess || hipDeviceGetAttribute(&cus, hipDeviceAttributeMultiprocessorCount, dev) != hipSuccess) { grid = -1; return; }
        if (hipFuncSetAttribute((const void*)hybrid_fwd, hipFuncAttributeMaxDynamicSharedMemorySize, LDS_BYTES) != hipSuccess) { fprintf(stderr, "kernel_launch: hipFuncSetAttribute failed\n"); grid = -1; return; }
        int per_cu = 0;
        if (hipOccupancyMaxActiveBlocksPerMultiprocessor(&per_cu, (const void*)hybrid_fwd, NTHR, LDS_BYTES) != hipSuccess || per_cu < 1) fprintf(stderr, "kernel_launch: occupancy query says %d\n", per_cu);
        (void)hipGetLastError();
        grid = cus;
    }
    if (grid < 0) return;
    (void)hipMemsetAsync((char*)d_ws + WS_CTL, 0, CTL_ZERO_BYTES, stream);
    Args a{};
    for (int i = 0; i < 24; ++i) a.in[i] = (const float*)d_in[i];
    a.out = (float*)d_out; a.ws = (unsigned char*)d_ws;
#if MK_PER_PHASE
    for (int p = 0; p < N_PHASES; ++p) { a.ph_lo = p; a.ph_hi = p + 1; hipLaunchKernelGGL(hybrid_fwd, dim3(grid), dim3(NTHR), LDS_BYTES, stream, a); }
#else
    a.ph_lo = 0; a.ph_hi = N_PHASES; hipLaunchKernelGGL(hybrid_fwd, dim3(grid), dim3(NTHR), LDS_BYTES, stream, a);
#endif
}
```

```cpp
#include <hip/hip_runtime.h>
#include <cstdio>
#include <cstdint>
#include <cmath>
namespace pg8 {
#define PG8_LAS __attribute__((address_space(3)))
typedef unsigned short bf16_t;
typedef short bf16x8 __attribute__((ext_vector_type(8)));
typedef float f32x4 __attribute__((ext_vector_type(4)));
typedef unsigned u32x4 __attribute__((ext_vector_type(4)));
constexpr int BM = 256, BK = 64, HALF = 128, HTB = HALF * BK * 2  , STAGE_BYTES = 8 * HTB, NXCD = 8, WGM = 8;

__host__ __device__ __forceinline__ int lds_byte(int r, int c) { const int st = (r >> 4) * 2 + (c >> 5), rr = r & 15, cc = c & 31, ob = rr * 64 + cc * 2; return st * 1024 + (ob ^ (((ob >> 9) & 1) << 5)); }
__host__ __device__ __forceinline__ void stage_rc(int b, int& R, int& C) { const int st = b / 1024, sb = b % 1024, swz = sb ^ (((sb >> 9) & 1) << 5); R = (st >> 1) * 16 + swz / 64; C = (st & 1) * 32 + (swz % 64) / 2; }
__host__ __device__ __forceinline__ int perm32(int rho) { const int n = rho >> 4, i = rho & 15; return 8 * (i >> 2) + 4 * n + (i & 3); }

struct Unit { int pm, pn; };
struct Gemm { const bf16_t* A; const bf16_t* Bt; int M, N, K; };

struct StaticOrder {
    int nM, nN, nwg, G, c;
    __host__ __device__ void init(int M, int N, int G_, int c_) { nM = M / BM; nN = N / BM; nwg = nM * nN; G = G_; c = c_; }
    __host__ __device__ bool next(int i, Unit& u) const {
        const long L = (long)i * G + c; if (L >= nwg) return false;
        int wgid = (int)L; { const int q = nwg / NXCD, r = nwg % NXCD, xcd = wgid % NXCD, off = wgid / NXCD; wgid = (xcd < r ? xcd * (q + 1) : r * (q + 1) + (xcd - r) * q) + off; }
        const int nig = WGM * nN, gid = wgid / nig, fm = gid * WGM, gsz = (nM - fm) < WGM ? (nM - fm) : WGM;
        u.pm = fm + ((wgid % nig) % gsz); u.pn = (wgid % nig) / gsz; return true;
    }
    __device__ __forceinline__ void a_ready(const Unit&) const {}
    __device__ __forceinline__ void done(const Unit&) const {}
};

__device__ __forceinline__ unsigned cvt_pk_bf16(float lo, float hi) { unsigned r; asm volatile("v_cvt_pk_bf16_f32 %0, %1, %2" : "=v"(r) : "v"(lo), "v"(hi)); return r; }
typedef float f32x2 __attribute__((ext_vector_type(2)));
template <class Epi, class Sched, bool ALIGN_EPI = false, bool SP2 = false>
__device__ __forceinline__ void gemm_phase(PG8_LAS unsigned char* lds, const Gemm g, const Sched& S, const Epi& E) {
    const int tid = threadIdx.x, wid = __builtin_amdgcn_readfirstlane(tid >> 6), lane = tid & 63, wr = wid >> 2, wc = wid & 3, fr = lane & 15, fq = lane >> 4;
    const int K = g.K, nt = K / BK;
    unsigned voffA[2], voffB[2];
#pragma unroll
    for (int i = 0; i < 2; ++i) { int R, C; stage_rc(tid * 16 + i * 8192, R, C); const int Rb = Epi::PERM ? ((R & ~31) + perm32(R & 31)) : R;
        voffA[i] = (unsigned)(R * K + C) * 2u; voffB[i] = (unsigned)(Rb * K + C) * 2u; }
    const size_t kstep = (size_t)(BK * 2);
    const size_t hstep = (size_t)HALF * K * 2;
    const size_t tstep = 2 * hstep;
    const unsigned ldsw = (unsigned)wid * 1024u;
    const int aoff = lds_byte(wr * 64 + fr, fq * 8), boff = lds_byte(wc * 32 + fr, fq * 8);
#define PG8_SA(b, h) (((b) * 2 + (h)) * HTB)
#define PG8_SB(b, h) ((4 + (b) * 2 + (h)) * HTB)
#define PG8_STAGE(bufoff, gbase, voff) do { _Pragma("unroll") for (int _i = 0; _i < 2; ++_i) \
        __builtin_amdgcn_global_load_lds((const unsigned*)((const char*)(gbase) + (voff)[_i]), (PG8_LAS unsigned*)(lds + (bufoff) + ldsw + _i * 8192), 16, 0, 0); } while (0)
#define PG8_LDA(dst, b, h) do { _Pragma("unroll") for (int m = 0; m < 4; ++m) _Pragma("unroll") for (int k = 0; k < 2; ++k) dst[m][k] = *(const PG8_LAS bf16x8*)(lds + PG8_SA(b, h) + aoff + m * 2048 + k * 1024); } while (0)
#define PG8_LDB(dst, b, h) do { _Pragma("unroll") for (int n = 0; n < 2; ++n) _Pragma("unroll") for (int k = 0; k < 2; ++k) dst[n][k] = *(const PG8_LAS bf16x8*)(lds + PG8_SB(b, h) + boff + n * 2048 + k * 1024); } while (0)
#define PG8_MMA(ai, bj, At, Bt) do { __builtin_amdgcn_s_setprio(1); _Pragma("unroll") for (int m = 0; m < 4; ++m) _Pragma("unroll") for (int n = 0; n < 2; ++n) _Pragma("unroll") for (int k = 0; k < 2; ++k) \
        acc[ai][bj][m][n] = __builtin_amdgcn_mfma_f32_16x16x32_bf16(Bt[n][k], At[m][k], acc[ai][bj][m][n], 0, 0, 0); __builtin_amdgcn_s_setprio(0); } while (0)
#define PG8_WAIT_V(n) asm volatile("s_waitcnt vmcnt(" #n ")" ::: "memory")
#define PG8_WAIT_L(n) asm volatile("s_waitcnt lgkmcnt(" #n ")" ::: "memory")
#define PG8_BAR __builtin_amdgcn_s_barrier()
#define PG8_SCHED __builtin_amdgcn_sched_barrier(0)
    Unit cur, nxt; int ui = 0;
    if (!S.next(0, cur)) return;
    f32x4 acc[2][2][4][2];
#pragma unroll
    for (int a = 0; a < 2; ++a)
#pragma unroll
        for (int b = 0; b < 2; ++b)
#pragma unroll
            for (int m = 0; m < 4; ++m)
#pragma unroll
                for (int n = 0; n < 2; ++n) acc[a][b][m][n] = (f32x4){0.f, 0.f, 0.f, 0.f};
    bf16x8 At[4][2], B0[2][2], B1[2][2];
    const char* cA = (const char*)g.A + (size_t)cur.pm * tstep; const char* cB = (const char*)g.Bt + (size_t)cur.pn * tstep;
    S.a_ready(cur);
    if constexpr (SP2) {
        PG8_STAGE(PG8_SB(0, 0), cB, voffB); PG8_STAGE(PG8_SB(0, 1), cB + hstep, voffB); PG8_STAGE(PG8_SA(0, 0), cA, voffA); PG8_STAGE(PG8_SA(0, 1), cA + hstep, voffA);
        if (wr == 1) PG8_BAR;
        PG8_WAIT_V(2); PG8_BAR;
        PG8_STAGE(PG8_SB(1, 0), cB + kstep, voffB); PG8_STAGE(PG8_SA(1, 0), cA + kstep, voffA); PG8_STAGE(PG8_SB(1, 1), cB + hstep + kstep, voffB);
        PG8_WAIT_V(6); PG8_BAR;
    } else {
        PG8_STAGE(PG8_SB(0, 0), cB, voffB); PG8_STAGE(PG8_SA(0, 0), cA, voffA); PG8_STAGE(PG8_SB(0, 1), cB + hstep, voffB); PG8_STAGE(PG8_SA(0, 1), cA + hstep, voffA);
        if (wr == 1) PG8_BAR;
        PG8_WAIT_V(4); PG8_BAR;
        PG8_STAGE(PG8_SB(1, 0), cB + kstep, voffB); PG8_STAGE(PG8_SA(1, 0), cA + kstep, voffA); PG8_STAGE(PG8_SB(1, 1), cB + hstep + kstep, voffB);
        PG8_WAIT_V(6); PG8_BAR;
    }
    for (;;) {
        const bool has_next = S.next(ui + 1, nxt);
        const char* nA = has_next ? (const char*)g.A + (size_t)nxt.pm * tstep : cA; const char* nB = has_next ? (const char*)g.Bt + (size_t)nxt.pn * tstep : cB;
        for (int t = 0; t < nt; t += 2) {
            const bool last = (t == nt - 2);
            const char* a1 = cA + (size_t)(t + 1) * kstep;
            const char* a2 = last ? nA : cA + (size_t)(t + 2) * kstep; const char* b2 = last ? nB : cB + (size_t)(t + 2) * kstep;
            const char* a3 = a2 + kstep; const char* b3 = b2 + kstep;
            if (last && has_next) S.a_ready(nxt);
            if constexpr (SP2) {
            PG8_LDB(B0, 0, 0); PG8_LDB(B1, 0, 1); PG8_SCHED; PG8_LDA(At, 0, 0); PG8_STAGE(PG8_SA(1, 1), a1 + hstep, voffA);
            PG8_WAIT_V(8); PG8_WAIT_L(0); PG8_BAR; PG8_MMA(0, 0, At, B0); PG8_MMA(0, 1, At, B1); PG8_BAR; PG8_SCHED;
            PG8_LDA(At, 0, 1); PG8_STAGE(PG8_SB(0, 0), b2, voffB); PG8_STAGE(PG8_SB(0, 1), b2 + hstep, voffB); PG8_STAGE(PG8_SA(0, 0), a2, voffA);
            PG8_WAIT_V(8); PG8_WAIT_L(0); PG8_BAR; PG8_MMA(1, 0, At, B0); PG8_MMA(1, 1, At, B1); PG8_BAR; PG8_SCHED;
            PG8_LDB(B0, 1, 0); PG8_LDB(B1, 1, 1); PG8_SCHED; PG8_LDA(At, 1, 0); PG8_STAGE(PG8_SA(0, 1), a2 + hstep, voffA);
            PG8_WAIT_V(8); PG8_WAIT_L(0); PG8_BAR; PG8_MMA(0, 0, At, B0); PG8_MMA(0, 1, At, B1); PG8_BAR; PG8_SCHED;
            PG8_LDA(At, 1, 1); PG8_STAGE(PG8_SB(1, 0), b3, voffB); PG8_STAGE(PG8_SB(1, 1), b3 + hstep, voffB); PG8_STAGE(PG8_SA(1, 0), a3, voffA);
            PG8_WAIT_V(8); PG8_WAIT_L(0); PG8_BAR; PG8_MMA(1, 0, At, B0); PG8_MMA(1, 1, At, B1); PG8_BAR; PG8_SCHED;
            } else {
            PG8_LDB(B0, 0, 0); PG8_SCHED; PG8_LDA(At, 0, 0); PG8_STAGE(PG8_SA(1, 1), a1 + hstep, voffA);
            PG8_WAIT_L(8); PG8_BAR; PG8_WAIT_L(0); PG8_MMA(0, 0, At, B0); PG8_BAR; PG8_SCHED;
            PG8_LDB(B1, 0, 1); PG8_STAGE(PG8_SB(0, 0), b2, voffB);
            PG8_BAR; PG8_WAIT_L(0); PG8_MMA(0, 1, At, B1); PG8_BAR;
            PG8_LDA(At, 0, 1); PG8_STAGE(PG8_SA(0, 0), a2, voffA);
            PG8_BAR; PG8_WAIT_L(0); PG8_MMA(1, 0, At, B0); PG8_BAR; PG8_SCHED;
            PG8_STAGE(PG8_SB(0, 1), b2 + hstep, voffB);
            PG8_WAIT_V(6); PG8_BAR; PG8_MMA(1, 1, At, B1); PG8_BAR;
            PG8_LDB(B0, 1, 0); PG8_SCHED; PG8_LDA(At, 1, 0); PG8_STAGE(PG8_SA(0, 1), a2 + hstep, voffA);
            PG8_WAIT_L(8); PG8_BAR; PG8_WAIT_L(0); PG8_MMA(0, 0, At, B0); PG8_BAR; PG8_SCHED;
            PG8_LDB(B1, 1, 1); PG8_STAGE(PG8_SB(1, 0), b3, voffB);
            PG8_BAR; PG8_WAIT_L(0); PG8_MMA(0, 1, At, B1); PG8_BAR;
            PG8_LDA(At, 1, 1); PG8_STAGE(PG8_SA(1, 0), a3, voffA);
            PG8_BAR; PG8_WAIT_L(0); PG8_MMA(1, 0, At, B0); PG8_BAR; PG8_SCHED;
            PG8_STAGE(PG8_SB(1, 1), b3 + hstep, voffB);
            PG8_WAIT_V(6); PG8_BAR; PG8_MMA(1, 1, At, B1); PG8_BAR;
            }
        }
        if constexpr (ALIGN_EPI) { if (wr == 0) PG8_BAR; }
        if constexpr (!Epi::AFTER_DRAIN) { E(acc, cur, wr, wc, fr, fq); S.done(cur); }
        if (!has_next) break;
#pragma unroll
        for (int a = 0; a < 2; ++a)
#pragma unroll
            for (int b = 0; b < 2; ++b)
#pragma unroll
                for (int m = 0; m < 4; ++m)
#pragma unroll
                    for (int n = 0; n < 2; ++n) acc[a][b][m][n] = (f32x4){0.f, 0.f, 0.f, 0.f};
        cur = nxt; cA = nA; cB = nB; ++ui;
        if constexpr (ALIGN_EPI) { if (wr == 1) PG8_BAR; }
    }
    PG8_WAIT_V(0);
    if constexpr (!ALIGN_EPI) { if (wr == 0) PG8_BAR; }
    PG8_BAR;
    if constexpr (Epi::AFTER_DRAIN) { E.fused(acc, cur, wr, wc, fr, fq, lds, wid, lane); S.done(cur); }
#undef PG8_SA
#undef PG8_SB
#undef PG8_STAGE
#undef PG8_LDA
#undef PG8_LDB
#undef PG8_MMA
#undef PG8_WAIT_V
#undef PG8_WAIT_L
#undef PG8_BAR
#undef PG8_SCHED
}
}

constexpr int DM = 1024, NBATCH = 8, SEQ = 4096, DECB = 128, DECS = 8;
constexpr int MP = NBATCH * SEQ, MS = DECB * DECS, MT = MP + MS;
constexpr int HD = 64, NH = 16, NKV = 4, WIN = 128, KVW = 256;
constexpr int SHW = 3200, INC = 8832;
constexpr int N1A = 2560, N1B = 6400, N1 = N1A + N1B;
constexpr float NORM_EPS = 1e-6f, GN_EPS = 64e-5f;

constexpr size_t O_Y = 0;
constexpr size_t O_PKW = (size_t)MT * DM;
constexpr size_t O_PVW = O_PKW + (size_t)NBATCH * WIN * KVW;
constexpr size_t O_PWKV = O_PVW + (size_t)NBATCH * WIN * KVW;
constexpr size_t O_PSH = O_PWKV + (size_t)NBATCH * NH * HD * HD;
constexpr size_t O_SKW = O_PSH + (size_t)NBATCH * SHW;
constexpr size_t O_SVW = O_SKW + (size_t)DECB * WIN * KVW;
constexpr size_t O_SWKV = O_SVW + (size_t)DECB * WIN * KVW;
constexpr size_t O_SSH = O_SWKV + (size_t)DECB * NH * HD * HD;
constexpr size_t O_END = O_SSH + (size_t)DECB * SHW;
static_assert(O_END == 52864000, "output size");

constexpr size_t MiB = 1u << 20;
constexpr size_t WS_CTL = 0, CTL_ZERO_BYTES = 1 * MiB;
constexpr size_t WS_SS = 512 * 1024;
constexpr size_t WS_W1T = 2 * MiB;
constexpr size_t WS_WAT = 20 * MiB, WS_WBT = 22 * MiB, WS_WOT = 24 * MiB;
constexpr size_t WS_XN = 26 * MiB;
constexpr size_t WS_Q = 92 * MiB;
constexpr size_t WS_K = 158 * MiB;
constexpr size_t WS_V = WS_K + (size_t)MT * KVW * 2;
constexpr size_t WS_GA = 191 * MiB;
constexpr size_t WS_PS = 257 * MiB;
constexpr size_t WS_END = 464 * MiB;
static_assert(WS_W1T + (size_t)N1 * DM * 2 <= WS_WAT && WS_V + (size_t)MT * KVW * 2 <= WS_GA && WS_PS + (size_t)MT * SHW * 2 <= WS_END, "ws map");

constexpr int CW_BAR = 4096;

constexpr int RING_BYTES = 131072;
constexpr int LDSCTL_OFF = RING_BYTES, MISC_OFF = LDSCTL_OFF + 320, SMALL_OFF = LDSCTL_OFF + 1024;
constexpr int LDS_BYTES = 147456;
constexpr int NWAVES = 8, NTHR = 512;

#define GAS __attribute__((address_space(1)))
#define LAS __attribute__((address_space(3)))
typedef unsigned short bf16;
typedef unsigned v4u __attribute__((ext_vector_type(4)));
typedef unsigned v2u __attribute__((ext_vector_type(2)));
typedef float f32x4 __attribute__((ext_vector_type(4)));
typedef float f32x16 __attribute__((ext_vector_type(16)));
typedef short bf16x8 __attribute__((ext_vector_type(8)));
typedef GAS unsigned gu32;
#define RLX_AGENT __ATOMIC_RELAXED, __HIP_MEMORY_SCOPE_AGENT
#define LDS_WAIT() asm volatile("s_waitcnt lgkmcnt(0)" ::: "memory")
#define VM_WAIT() asm volatile("s_waitcnt vmcnt(0)" ::: "memory")
__device__ __forceinline__ unsigned f2bf(float f) { unsigned u = __builtin_bit_cast(unsigned, f); return (u + 0x7fffu + ((u >> 16) & 1u)) >> 16; }
__device__ __forceinline__ unsigned pk2(float lo, float hi) { return f2bf(lo) | (f2bf(hi) << 16); }
__device__ __forceinline__ float bflo(unsigned u) { return __builtin_bit_cast(float, u << 16); }
__device__ __forceinline__ float bfhi(unsigned u) { return __builtin_bit_cast(float, u & 0xffff0000u); }
__device__ __forceinline__ float sigmoidf_(float x) { return __builtin_amdgcn_rcpf(1.0f + __expf(-x)); }

#define XB_TMO      128
#define XB_XCNT(j)  (256  + 64 * (j))
#define XB_XSUB(j)  (1280 + 64 * (j))
#define XB_XGEN(j)  (2304 + 64 * (j))
#define XB_TOP      3328
#define XB_TOPGEN   3392
#define XCD_BAR_WORDS 3456
#define XB_SPIN_CAP (1u << 23)
__device__ __forceinline__ unsigned xb_ld(unsigned* p)              { return __hip_atomic_load(p, __ATOMIC_RELAXED, __HIP_MEMORY_SCOPE_AGENT); }
__device__ __forceinline__ unsigned xb_add(unsigned* p, unsigned v) { return __hip_atomic_fetch_add(p, v, __ATOMIC_RELAXED, __HIP_MEMORY_SCOPE_AGENT); }
__device__ __forceinline__ unsigned xb_xcc_id() { return (unsigned)__builtin_amdgcn_s_getreg((3 << 11) | 20) & 0xFu; }
#define XB_SPIN(cond, bar) do { unsigned _sp = 0; while (cond) { __builtin_amdgcn_s_sleep(1); \
    if ((++_sp & 255u) == 0u) { if (xb_ld(&(bar)[XB_TMO])) break; if (_sp > XB_SPIN_CAP) { atomicAdd(&(bar)[XB_TMO], 1u); break; } } } } while (0)
struct XcdBarrier { unsigned* bar; unsigned x; volatile LAS unsigned* st; };
__device__ __forceinline__ XcdBarrier xcd_barrier_post(unsigned* bar, volatile LAS unsigned* st) {
    XcdBarrier b; b.bar = bar; b.x = xb_xcc_id(); b.st = st;
    if (threadIdx.x == 0) (void)xb_add(&bar[XB_XCNT(b.x)], 1u);
    return b;
}
__device__ __forceinline__ void xcd_barrier_complete(unsigned* bar, unsigned x, unsigned& nloc, unsigned& nx) {
    const unsigned G = gridDim.x * gridDim.y * gridDim.z;
    unsigned sum, cnt, mine, sp = 0u;
    for (;;) {
        sum = 0u; cnt = 0u; mine = 0u;
#pragma unroll
        for (unsigned j = 0; j < 16; ++j) { const unsigned c = xb_ld(&bar[XB_XCNT(j)]); sum += c; cnt += (c > 0u) ? 1u : 0u; mine = (j == x) ? c : mine; }
        if (sum == G) break;
        __builtin_amdgcn_s_sleep(1);
        if ((++sp & 255u) == 0u) { if (xb_ld(&bar[XB_TMO])) break; if (sp > XB_SPIN_CAP) { atomicAdd(&bar[XB_TMO], 1u); break; } }
    }
    nloc = mine > 0u ? mine : 1u; nx = cnt > 0u ? cnt : 1u;
}
__device__ __forceinline__ void xcd_barrier(const XcdBarrier& b) {
    asm volatile("s_waitcnt vmcnt(0)" ::: "memory");
    __syncthreads();
    if (threadIdx.x == 0) {
        unsigned* bar = b.bar;
        __builtin_amdgcn_s_waitcnt(0);
        unsigned nloc = b.st[0], nx = b.st[1];
        if (nloc == 0u) { xcd_barrier_complete(bar, b.x, nloc, nx); b.st[0] = nloc; b.st[1] = nx; }
        const unsigned old = xb_add(&bar[XB_XSUB(b.x)], 1u);
        const unsigned gen = old / nloc;
        if (old + 1u == (gen + 1u) * nloc) {
            __builtin_amdgcn_fence(__ATOMIC_RELEASE, "agent");
            asm volatile("s_waitcnt vmcnt(0)" ::: "memory");
            const unsigned og = xb_add(&bar[XB_TOP], 1u);
            const unsigned tg = og / nx;
            if (og + 1u == (tg + 1u) * nx) xb_add(&bar[XB_TOPGEN], 1u);
            else XB_SPIN(xb_ld(&bar[XB_TOPGEN]) == tg, bar);
            __builtin_amdgcn_fence(__ATOMIC_ACQUIRE, "agent");
            xb_add(&bar[XB_XGEN(b.x)], 1u);
            asm volatile("s_waitcnt vmcnt(0)" ::: "memory");
        } else {
            XB_SPIN(xb_ld(&bar[XB_XGEN(b.x)]) == gen, bar);
            __builtin_amdgcn_fence(__ATOMIC_ACQUIRE, "agent");
            asm volatile("s_waitcnt vmcnt(0)" ::: "memory");
        }
    }
    __syncthreads();
}

struct Args { const float* in[24]; float* out; unsigned char* ws; int ph_lo, ph_hi; };
static_assert(sizeof(Args) == 24 * 8 + 8 + 8 + 8, "no padding");
struct Frame {
    LAS unsigned char* lds;
    int wave, G, vcu;
    float* out; unsigned char* ws;
};
__device__ __forceinline__ int lane_id() { return (int)__builtin_amdgcn_mbcnt_hi(~0u, __builtin_amdgcn_mbcnt_lo(~0u, 0u)); }
enum { I_XP = 0, I_XS, I_CK, I_CV, I_SWKV, I_SSHIFT, I_RELB, I_NORMG, I_WIN, I_SINK, I_MU, I_W0, I_W2, I_A0, I_A2, I_KK, I_KA, I_RK, I_LNG, I_LNB, I_WOA, I_WOB, I_WO, I_FING };

__device__ __forceinline__ float wave_sum(float v) {
#pragma unroll
    for (int o = 1; o < 64; o <<= 1) v += __shfl_xor(v, o);
    return v;
}

__device__ __forceinline__ void p0_transpose_item(const float* W, int ldw, int srccol0, int K, bf16* WT, int dstrow0, LAS float* scr, int kb, int lane) {
    const int k0 = 64 * kb;
    if (srccol0 >= 0) {
#pragma unroll 8
        for (int i = 0; i < 32; ++i) { const int kk = 2 * i + (lane >> 5); scr[kk * 33 + (lane & 31)] = W[(size_t)(k0 + kk) * ldw + srccol0 + (lane & 31)]; }
    }
    LDS_WAIT(); asm volatile("" ::: "memory");
    const int c = lane & 7;
#pragma unroll
    for (int j = 0; j < 4; ++j) { const int n = (lane >> 3) + 8 * j; const LAS float* s = scr + (8 * c) * 33 + n;
        v4u o = (v4u){0u, 0u, 0u, 0u};
        if (srccol0 >= 0) { o.x = pk2(s[0 * 33], s[1 * 33]); o.y = pk2(s[2 * 33], s[3 * 33]); o.z = pk2(s[4 * 33], s[5 * 33]); o.w = pk2(s[6 * 33], s[7 * 33]); }
        *(GAS v4u*)(WT + (size_t)(dstrow0 + n) * K + k0 + 8 * c) = o; }
    LDS_WAIT(); asm volatile("" ::: "memory");
}
__device__ __forceinline__ void rms_row_to_bf16(const float* xrow, const float* g, bf16* orow, int lane) {
    const GAS f32x4* xr = (const GAS f32x4*)xrow + lane; const GAS f32x4* gr = (const GAS f32x4*)g + lane;
    f32x4 v[4]; float s = 0.f;
#pragma unroll
    for (int j = 0; j < 4; ++j) { v[j] = xr[64 * j]; s += (v[j].x * v[j].x + v[j].y * v[j].y) + (v[j].z * v[j].z + v[j].w * v[j].w); }
    const float sc = 1.0f / sqrtf(wave_sum(s) * (1.f / DM) + NORM_EPS);
    GAS v2u* o8 = (GAS v2u*)orow + lane;
#pragma unroll
    for (int j = 0; j < 4; ++j) { const f32x4 gv = gr[64 * j]; v2u o; o.x = pk2(v[j].x * sc * gv.x, v[j].y * sc * gv.y); o.y = pk2(v[j].z * sc * gv.z, v[j].w * sc * gv.w); o8[64 * j] = o; }
}
__device__ __forceinline__ void p0_prologue(const Frame& F, const Args& AR) {
    const int lane = lane_id();
    LAS float* scr = (LAS float*)(F.lds + F.wave * 16384);
    const int gw = F.vcu * NWAVES + F.wave, NGW = F.G * NWAVES;
    constexpr int I_1 = 16 * (N1 / 32), I_S = 16 * 32, NITEMS = I_1 + 3 * I_S;
    bf16* W1T = (bf16*)(F.ws + WS_W1T);
    for (int it = gw; it < NITEMS; it += NGW) {
        int r = it;
        if (r < I_1) { const int kb = r / (N1 / 32), nb = r % (N1 / 32), n0 = 32 * nb;
            const int src = n0 < 5760 ? n0 : (n0 < 5888 ? -1 : n0 - 128);
            p0_transpose_item(AR.in[I_WIN], INC, src, DM, W1T, n0, scr, kb, lane); continue; }
        r -= I_1;
        const int which = r / I_S; r -= which * I_S;
        const float* W = which == 0 ? AR.in[I_WOA] : (which == 1 ? AR.in[I_WOB] : AR.in[I_WO]);
        bf16* WT = (bf16*)(F.ws + (which == 0 ? WS_WAT : (which == 1 ? WS_WBT : WS_WOT)));
        p0_transpose_item(W, DM, 32 * (r % 32), DM, WT, 32 * (r % 32), scr, r / 32, lane);
    }
    bf16* XN = (bf16*)(F.ws + WS_XN);
    for (int m = gw; m < MT; m += NGW) {
        const float* xr = m < MP ? AR.in[I_XP] + (size_t)m * DM : AR.in[I_XS] + (size_t)(m - MP) * DM;
        rms_row_to_bf16(xr, AR.in[I_NORMG], XN + (size_t)m * DM, lane);
    }
}

struct EpiG1 {
    static constexpr bool PERM = true, AFTER_DRAIN = false;
    int part; unsigned char* ws; float* out;
    __device__ __forceinline__ void operator()(const f32x4 (&acc)[2][2][4][2], const pg8::Unit& u, int wr, int wc, int fr, int fq) const {
        bf16* dst; int ld, act = 0, valid = 256, side = 0;
        const int pn = u.pn;
        if (part == 0) {
            if (pn < 4) { dst = (bf16*)(ws + WS_Q) + pn * 256; ld = DM; }
            else if (pn == 4) { dst = (bf16*)(ws + WS_K); ld = KVW; side = 1; }
            else if (pn == 5) { dst = (bf16*)(ws + WS_V); ld = KVW; side = 2; }
            else { dst = (bf16*)(ws + WS_GA) + (pn - 6) * 256; ld = DM; act = 1; }
        } else {
            if (pn < 13) { dst = (bf16*)(ws + WS_PS) + pn * 256; ld = SHW; side = 3; if (pn == 12) valid = 128; }
            else if (pn < 17) { dst = (bf16*)(ws + WS_GA) + (pn - 13) * 256; ld = DM; act = 1; }
            else if (pn < 21) { dst = (bf16*)out + (pn - 17) * 256; ld = DM; act = 2; }
            else { dst = (bf16*)out + (size_t)MT * DM + (pn - 21) * 256; ld = DM; act = 2; }
        }
        const int rt0 = wr * 64 + fr, cit0 = wc * 32 + 8 * fq;
#pragma unroll
        for (int ai = 0; ai < 2; ++ai)
#pragma unroll
            for (int m = 0; m < 4; ++m) { bf16* rowp = dst + (size_t)(u.pm * 256 + rt0 + ai * 128 + m * 16) * ld + cit0;
#pragma unroll
                for (int bj = 0; bj < 2; ++bj) { if (bj * 128 >= valid) continue;
                    f32x4 v0 = acc[ai][bj][m][0], v1 = acc[ai][bj][m][1];
                    if (act) {
#pragma unroll
                        for (int e = 0; e < 4; ++e) { const float s0 = sigmoidf_(v0[e]), s1 = sigmoidf_(v1[e]); v0[e] = act == 1 ? v0[e] * s0 : s0; v1[e] = act == 1 ? v1[e] * s1 : s1; }
                    }
                    pg8::u32x4 w; w.x = pg8::cvt_pk_bf16(v0[0], v0[1]); w.y = pg8::cvt_pk_bf16(v0[2], v0[3]); w.z = pg8::cvt_pk_bf16(v1[0], v1[1]); w.w = pg8::cvt_pk_bf16(v1[2], v1[3]);
                    *(pg8::u32x4*)(rowp + bj * 128) = w; } }
        int r0 = rt0, c0 = cit0;
        if (side) asm volatile("" : "+v"(r0), "+v"(c0));
        if (side == 1 || side == 2) {
            if (u.pm < 128) {
                if ((u.pm & 15) == 15) { float* base = out + (side == 1 ? O_PKW : O_PVW) + (size_t)(u.pm >> 4) * WIN * KVW;
#pragma unroll
                    for (int m = 0; m < 4; ++m) { float* rp = base + (size_t)(r0 + m * 16) * KVW + c0;
#pragma unroll
                        for (int bj = 0; bj < 2; ++bj)
#pragma unroll
                            for (int n = 0; n < 2; ++n) *(f32x4*)(rp + bj * 128 + 4 * n) = acc[1][bj][m][n]; } }
            } else { float* base = out + (side == 1 ? O_SKW : O_SVW);
#pragma unroll
                for (int ai = 0; ai < 2; ++ai)
#pragma unroll
                    for (int m = 0; m < 4; ++m) { const int rs = (u.pm - 128) * 256 + r0 + ai * 128 + m * 16; float* rp = base + ((size_t)(rs >> 3) * WIN + 120 + (rs & 7)) * KVW + c0;
#pragma unroll
                        for (int bj = 0; bj < 2; ++bj)
#pragma unroll
                            for (int n = 0; n < 2; ++n) *(f32x4*)(rp + bj * 128 + 4 * n) = acc[ai][bj][m][n]; }
            }
        } else if (side == 3) {
            if (u.pm < 128) {
                if ((u.pm & 15) == 15 && wr == 1 && fr == 15) { float* rp = out + O_PSH + (size_t)(u.pm >> 4) * SHW + pn * 256 + c0;
#pragma unroll
                    for (int bj = 0; bj < 2; ++bj) { if (bj * 128 >= valid) continue;
#pragma unroll
                        for (int n = 0; n < 2; ++n) *(f32x4*)(rp + bj * 128 + 4 * n) = acc[1][bj][3][n]; } }
            } else if ((fr & 7) == 7) {
#pragma unroll
                for (int ai = 0; ai < 2; ++ai)
#pragma unroll
                    for (int m = 0; m < 4; ++m) { const int rs = (u.pm - 128) * 256 + r0 + ai * 128 + m * 16; float* rp = out + O_SSH + (size_t)(rs >> 3) * SHW + pn * 256 + c0;
#pragma unroll
                        for (int bj = 0; bj < 2; ++bj) { if (bj * 128 >= valid) continue;
#pragma unroll
                            for (int n = 0; n < 2; ++n) *(f32x4*)(rp + bj * 128 + 4 * n) = acc[ai][bj][m][n]; } }
            }
        }
    }
};
struct EpiGate {
    static constexpr bool PERM = true, AFTER_DRAIN = false;
    int mode; const bf16* gate; const bf16* tin; bf16* dst;
    __device__ __forceinline__ void operator()(const f32x4 (&acc)[2][2][4][2], const pg8::Unit& u, int wr, int wc, int fr, int fq) const {
        const int rt0 = u.pm * 256 + wr * 64 + fr, c0 = u.pn * 256 + wc * 32 + 8 * fq;
#pragma unroll
        for (int ai = 0; ai < 2; ++ai)
#pragma unroll
            for (int m = 0; m < 4; ++m) { const size_t ro = (size_t)(rt0 + ai * 128 + m * 16) * DM + c0;
#pragma unroll
                for (int bj = 0; bj < 2; ++bj) {
                    const v4u g = *(const v4u*)(gate + ro + bj * 128);
                    f32x4 v0 = acc[ai][bj][m][0], v1 = acc[ai][bj][m][1];
                    v0[0] *= bflo(g.x); v0[1] *= bfhi(g.x); v0[2] *= bflo(g.y); v0[3] *= bfhi(g.y); v1[0] *= bflo(g.z); v1[1] *= bfhi(g.z); v1[2] *= bflo(g.w); v1[3] *= bfhi(g.w);
                    if (mode == 1) { const v4u t = *(const v4u*)(tin + ro + bj * 128);
                        v0[0] += bflo(t.x); v0[1] += bfhi(t.x); v0[2] += bflo(t.y); v0[3] += bfhi(t.y); v1[0] += bflo(t.z); v1[1] += bfhi(t.z); v1[2] += bflo(t.w); v1[3] += bfhi(t.w); }
                    pg8::u32x4 w; w.x = pg8::cvt_pk_bf16(v0[0], v0[1]); w.y = pg8::cvt_pk_bf16(v0[2], v0[3]); w.z = pg8::cvt_pk_bf16(v1[0], v1[1]); w.w = pg8::cvt_pk_bf16(v1[2], v1[3]);
                    *(pg8::u32x4*)(dst + ro + bj * 128) = w; } }
    }
};
struct EpiOut {
    static constexpr bool PERM = false, AFTER_DRAIN = false;
    const float* xp; const float* xs; float* out; float* ss;
    __device__ __forceinline__ void operator()(const f32x4 (&acc)[2][2][4][2], const pg8::Unit& u, int wr, int wc, int fr, int fq) const {
        const int rt0 = u.pm * 256 + wr * 64 + fr, c0 = u.pn * 256 + wc * 32 + 4 * fq;
#pragma unroll
        for (int ai = 0; ai < 2; ++ai)
#pragma unroll
            for (int m = 0; m < 4; ++m) { const int row = rt0 + ai * 128 + m * 16;
                const float* xr = (row < MP ? xp + (size_t)row * DM : xs + (size_t)(row - MP) * DM) + c0; float* orow = out + (size_t)row * DM + c0; float s = 0.f;
#pragma unroll
                for (int bj = 0; bj < 2; ++bj)
#pragma unroll
                    for (int n = 0; n < 2; ++n) { const f32x4 xv = *(const f32x4*)(xr + bj * 128 + n * 16); const f32x4 o = xv + acc[ai][bj][m][n];
                        *(f32x4*)(orow + bj * 128 + n * 16) = o; s += (o[0] * o[0] + o[1] * o[1]) + (o[2] * o[2] + o[3] * o[3]); }
                s += __shfl_xor(s, 16); s += __shfl_xor(s, 32);
                if (fq == 0) atomicAdd(ss + row, s); }
    }
};

__device__ const unsigned char T5B[132] = {0, 1, 2, 3, 4, 5, 6, 7, 8, 9, 10, 11, 12, 13, 14, 15, 16, 16, 16, 17, 17, 18, 18, 18, 19, 19, 19, 20, 20, 20, 20, 21, 21, 21, 21, 22, 22, 22, 22, 22, 23, 23, 23, 23, 23, 23, 24, 24, 24, 24, 24, 24, 25, 25, 25, 25, 25, 25, 25, 26, 26, 26, 26, 26, 26, 26, 26, 27, 27, 27, 27, 27, 27, 27, 27, 27, 27, 28, 28, 28, 28, 28, 28, 28, 28, 28, 28, 29, 29, 29, 29, 29, 29, 29, 29, 29, 29, 29, 29, 30, 30, 30, 30, 30, 30, 30, 30, 30, 30, 30, 30, 30, 30, 31, 31, 31, 31, 31, 31, 31, 31, 31, 31, 31, 31, 31, 31, 31, 31, 31, 31, 31};
constexpr int AT_KP = 144, AT_VP = 520, AT_VT_OFF = 256 * AT_KP, AT_BT_OFF = AT_VT_OFF + 64 * AT_VP;
__device__ __forceinline__ int crow(int r, int hi) { return (r & 3) + 8 * (r >> 2) + 4 * hi; }

template <int MODE>
__device__ __forceinline__ void attn_task(const Frame& F, const Args& AR, bf16* OB_, int b, int kvh, int n, int g_, int i) {
    LAS unsigned char* KL = F.lds; LAS unsigned char* VT = F.lds + AT_VT_OFF; LAS float* BT = (LAS float*)(F.lds + AT_BT_OFF);
    const int lane = lane_id(), q = lane & 31, hi = lane >> 5;
    int g, mq, dq;
    if (MODE == 0) { g = g_; mq = b * SEQ + n * 128 + 32 * i + q; dq = 128 + q; }
    else { g = q >> 3; mq = MP + b * DECS + (q & 7); dq = 128 + (q & 7); }
    const int h = kvh * 4 + g;
    bf16* QO = (bf16*)(F.ws + WS_Q); const bf16* GA = (const bf16*)(F.ws + WS_GA);
    bf16x8 qf[4];
    { const bf16* qp = QO + (size_t)mq * DM + h * HD + 8 * hi;
#pragma unroll
      for (int s = 0; s < 4; ++s) qf[s] = *(const bf16x8*)(qp + 16 * s); }
    const int kt0 = MODE == 0 ? i : 0;
    f32x16 sc[5];
    const float sink = AR.in[I_SINK][h];
    const LAS float* bt = BT + g * 192 + 32 + dq - 4 * hi;
    float mx = sink;
#pragma unroll
    for (int t = 0; t < 5; ++t) { const LAS unsigned char* kp = KL + (32 * (kt0 + t) + q) * AT_KP + 16 * hi; f32x16 a = {0.f, 0.f, 0.f, 0.f, 0.f, 0.f, 0.f, 0.f, 0.f, 0.f, 0.f, 0.f, 0.f, 0.f, 0.f, 0.f};
#pragma unroll
        for (int s = 0; s < 4; ++s) { const bf16x8 kf = *(const LAS bf16x8*)(kp + 32 * s); a = __builtin_amdgcn_mfma_f32_32x32x16_bf16(kf, qf[s], a, 0, 0, 0); }
        const bool dead = (MODE == 0) && n == 0 && (i + t) < 4;
#pragma unroll
        for (int r = 0; r < 16; ++r) { const int kb0 = 32 * t + (r & 3) + 8 * (r >> 2);
            float sv = a[r] * 0.125f + bt[-kb0]; sv = dead ? -INFINITY : sv; a[r] = sv; mx = fmaxf(mx, sv); }
        sc[t] = a;
        __builtin_amdgcn_sched_barrier(0); }
    mx = fmaxf(mx, __shfl_xor(mx, 32));
    float sum = 0.f;
#pragma unroll
    for (int t = 0; t < 5; ++t)
#pragma unroll
        for (int r = 0; r < 16; ++r) { const float p = __expf(sc[t][r] - mx); sum += p; sc[t][r] = p; }
    sum += __shfl_xor(sum, 32); sum += __expf(sink - mx);
    const float inv = 1.0f / sum;
    f32x16 o[2];
#pragma unroll
    for (int d = 0; d < 2; ++d) o[d] = (f32x16){0.f, 0.f, 0.f, 0.f, 0.f, 0.f, 0.f, 0.f, 0.f, 0.f, 0.f, 0.f, 0.f, 0.f, 0.f, 0.f};
#pragma unroll
    for (int t = 0; t < 5; ++t)
#pragma unroll
        for (int s2 = 0; s2 < 2; ++s2) {
            v4u pw; pw.x = pk2(sc[t][8 * s2 + 0], sc[t][8 * s2 + 1]); pw.y = pk2(sc[t][8 * s2 + 2], sc[t][8 * s2 + 3]); pw.z = pk2(sc[t][8 * s2 + 4], sc[t][8 * s2 + 5]); pw.w = pk2(sc[t][8 * s2 + 6], sc[t][8 * s2 + 7]);
            const bf16x8 pb = __builtin_bit_cast(bf16x8, pw);
#pragma unroll
            for (int d = 0; d < 2; ++d) { const LAS unsigned char* vp = VT + (32 * d + q) * AT_VP + (32 * (kt0 + t) + 16 * s2 + 4 * hi) * 2;
                const v2u lo = *(const LAS v2u*)vp, hi2 = *(const LAS v2u*)(vp + 16);
                v4u aw; aw.x = lo.x; aw.y = lo.y; aw.z = hi2.x; aw.w = hi2.y;
                o[d] = __builtin_amdgcn_mfma_f32_32x32x16_bf16(__builtin_bit_cast(bf16x8, aw), pb, o[d], 0, 0, 0); }
            __builtin_amdgcn_sched_barrier(0); }
    bf16* op = OB_ + (size_t)mq * DM + h * HD; const bf16* gp = GA + (size_t)mq * DM + h * HD;
#pragma unroll
    for (int d = 0; d < 2; ++d)
#pragma unroll
        for (int rq = 0; rq < 4; ++rq) { const int dv0 = 32 * d + 8 * rq + 4 * hi; const v2u gv = *(const v2u*)(gp + dv0);
            v2u w; w.x = pk2(o[d][4 * rq + 0] * inv * bflo(gv.x), o[d][4 * rq + 1] * inv * bfhi(gv.x)); w.y = pk2(o[d][4 * rq + 2] * inv * bflo(gv.y), o[d][4 * rq + 3] * inv * bfhi(gv.y));
            *(v2u*)(op + dv0) = w; }
}

__device__ __forceinline__ void attn_unit(const Frame& F, const Args& AR, int unit, bf16* OB_) {
    LAS unsigned char* KL = F.lds; LAS unsigned char* VT = F.lds + AT_VT_OFF; LAS float* BT = (LAS float*)(F.lds + AT_BT_OFF);
    const bf16* Kb = (const bf16*)(F.ws + WS_K); const bf16* Vb = (const bf16*)(F.ws + WS_V);
    const int tid = F.wave * 64 + lane_id();
    __syncthreads();
    int b, kvh, n = 0;
    const bool sample = unit >= 1024;
    if (!sample) {
        kvh = unit & 3; n = (unit >> 2) & 31; b = unit >> 7;
        const int t0 = (n - 1) * 128;
#pragma unroll
        for (int it = 0; it < 4; ++it) { const int c = it * NTHR + tid, key = c >> 3, part = c & 7, tok = t0 + key; v4u val = (v4u){0u, 0u, 0u, 0u};
            if (tok >= 0) val = *(const v4u*)(Kb + (size_t)(b * SEQ + tok) * KVW + kvh * HD + part * 8);
            *(LAS v4u*)(KL + key * AT_KP + part * 16) = val; }
#pragma unroll
        for (int it = 0; it < 4; ++it) { const int c = it * NTHR + tid, key = c & 255, part = c >> 8, tok = t0 + key; v4u val = (v4u){0u, 0u, 0u, 0u};
            if (tok >= 0) val = *(const v4u*)(Vb + (size_t)(b * SEQ + tok) * KVW + kvh * HD + part * 8);
            LAS bf16* vt = (LAS bf16*)(VT + (part * 8) * AT_VP + key * 2);
            vt[0 * (AT_VP / 2)] = (bf16)val.x; vt[1 * (AT_VP / 2)] = (bf16)(val.x >> 16); vt[2 * (AT_VP / 2)] = (bf16)val.y; vt[3 * (AT_VP / 2)] = (bf16)(val.y >> 16);
            vt[4 * (AT_VP / 2)] = (bf16)val.z; vt[5 * (AT_VP / 2)] = (bf16)(val.z >> 16); vt[6 * (AT_VP / 2)] = (bf16)val.w; vt[7 * (AT_VP / 2)] = (bf16)(val.w >> 16); }
    } else {
        const int su = unit - 1024; kvh = su & 3; b = su >> 2;
        for (int c = tid; c < 160 * 8; c += NTHR) {
            { const int key = c >> 3, part = c & 7; v4u val = (v4u){0u, 0u, 0u, 0u};
              if (key < 128) { const float* src = AR.in[I_CK] + ((size_t)(b * WIN + key) * NKV + kvh) * HD + part * 8; const f32x4 a = *(const f32x4*)src, bb = *(const f32x4*)(src + 4);
                  val.x = pk2(a.x, a.y); val.y = pk2(a.z, a.w); val.z = pk2(bb.x, bb.y); val.w = pk2(bb.z, bb.w);
                  if (key >= 8) { float* d = F.out + O_SKW + ((size_t)(b * WIN + key - 8) * NKV + kvh) * HD + part * 8; *(f32x4*)d = a; *(f32x4*)(d + 4) = bb; } }
              else if (key < 136) val = *(const v4u*)(Kb + (size_t)(MP + b * DECS + key - 128) * KVW + kvh * HD + part * 8);
              *(LAS v4u*)(KL + key * AT_KP + part * 16) = val; }
            { const int key = c % 160, part = c / 160; v4u val = (v4u){0u, 0u, 0u, 0u};
              if (key < 128) { const float* src = AR.in[I_CV] + ((size_t)(b * WIN + key) * NKV + kvh) * HD + part * 8; const f32x4 a = *(const f32x4*)src, bb = *(const f32x4*)(src + 4);
                  val.x = pk2(a.x, a.y); val.y = pk2(a.z, a.w); val.z = pk2(bb.x, bb.y); val.w = pk2(bb.z, bb.w);
                  if (key >= 8) { float* d = F.out + O_SVW + ((size_t)(b * WIN + key - 8) * NKV + kvh) * HD + part * 8; *(f32x4*)d = a; *(f32x4*)(d + 4) = bb; } }
              else if (key < 136) val = *(const v4u*)(Vb + (size_t)(MP + b * DECS + key - 128) * KVW + kvh * HD + part * 8);
              LAS bf16* vt = (LAS bf16*)(VT + (part * 8) * AT_VP + key * 2);
              vt[0 * (AT_VP / 2)] = (bf16)val.x; vt[1 * (AT_VP / 2)] = (bf16)(val.x >> 16); vt[2 * (AT_VP / 2)] = (bf16)val.y; vt[3 * (AT_VP / 2)] = (bf16)(val.y >> 16);
              vt[4 * (AT_VP / 2)] = (bf16)val.z; vt[5 * (AT_VP / 2)] = (bf16)(val.z >> 16); vt[6 * (AT_VP / 2)] = (bf16)val.w; vt[7 * (AT_VP / 2)] = (bf16)(val.w >> 16); }
        }
    }
    for (int idx = tid; idx < 4 * 192; idx += NTHR) { const int g = idx / 192, d = idx - g * 192 - 32; BT[idx] = (d >= 0 && d <= 128) ? AR.in[I_RELB][(int)T5B[d] * NH + kvh * 4 + g] : -INFINITY; }
    __syncthreads();
    if (!sample) { for (int task = F.wave; task < 16; task += NWAVES) attn_task<0>(F, AR, OB_, b, kvh, n, task >> 2, task & 3); }
    else if (F.wave == 0) attn_task<1>(F, AR, OB_, b, kvh, 0, 0, 0);
}

namespace sc {
constexpr int P68 = 136, P36 = 72;
constexpr int W2T = 0, A2T = W2T + 64 * P68, TW = A2T + 64 * P68, AL = TW + 32 * P68, AT = AL + 32 * P68, RT = AT + 32 * P68, BT = RT + 32 * P68, KT = BT + 32 * P68, W1R = KT + 32 * P68;
constexpr int ATT = W1R + 32 * P68, BHT = ATT + 64 * P36, KHT = BHT + 64 * P36, VTT = KHT + 64 * P36;
constexpr int MAK = VTT + 64 * P36, MRK = MAK + 32 * P36, MRB = MRK + 32 * P36, TRM = MRB + 32 * P36, PRM = TRM + 32 * P36, ARM = PRM + 32 * P36;
constexpr int UW = ARM + 32 * P36, UA = UW + 32 * 65 * 4, YB = UA  , GC = UA + 32 * 65 * 4, PAR = GC + 256, RAWP = PAR + 12 * 256, END = RAWP + 33 * 640;
static_assert(END <= RING_BYTES && (UW % 16) == 0 && (GC % 16) == 0 && (MAK % 8) == 0, "scan LDS map");
}
typedef float f32x2_t __attribute__((ext_vector_type(2))); typedef __bf16 bf16x2_t __attribute__((ext_vector_type(2)));
__device__ __forceinline__ unsigned cvtpk(float lo, float hi) { f32x2_t v = {lo, hi}; bf16x2_t b = __builtin_convertvector(v, bf16x2_t); return __builtin_bit_cast(unsigned, b); }
__device__ __forceinline__ bf16x8 frag_nat(LAS const unsigned char* base, int pitch, int row, int col0) {
    LAS const unsigned char* p = base + row * pitch + col0 * 2; const v2u a = *(LAS const v2u*)p, b = *(LAS const v2u*)(p + 8);
    v4u w; w.x = a.x; w.y = a.y; w.z = b.x; w.w = b.y; return __builtin_bit_cast(bf16x8, w); }
__device__ __forceinline__ bf16x8 frag_perm(LAS const unsigned char* base, int pitch, int row, int c0, int hi) {
    LAS const unsigned char* p = base + row * pitch + (c0 + 4 * hi) * 2; const v2u a = *(LAS const v2u*)p, b = *(LAS const v2u*)(p + 16);
    v4u w; w.x = a.x; w.y = a.y; w.z = b.x; w.w = b.y; return __builtin_bit_cast(bf16x8, w); }
__device__ __forceinline__ bf16x8 pk8(const f32x16& x, int s) {
    v4u w; w.x = cvtpk(x[8 * s + 0], x[8 * s + 1]); w.y = cvtpk(x[8 * s + 2], x[8 * s + 3]); w.z = cvtpk(x[8 * s + 4], x[8 * s + 5]); w.w = cvtpk(x[8 * s + 6], x[8 * s + 7]); return __builtin_bit_cast(bf16x8, w); }
__device__ __forceinline__ void store_rm(LAS unsigned char* base, int pitch, const f32x16& x, int q, int hi) {
#pragma unroll
    for (int r = 0; r < 16; r += 2) { const unsigned w = cvtpk(x[r], x[r + 1]);
        *(LAS bf16*)(base + crow(r, hi) * pitch + 2 * q) = (bf16)w; *(LAS bf16*)(base + crow(r + 1, hi) * pitch + 2 * q) = (bf16)(w >> 16); }
}
#define MFMA32(a, b, c) __builtin_amdgcn_mfma_f32_32x32x16_bf16((a), (b), (c), 0, 0, 0)
#define ZERO16 ((f32x16){0.f, 0.f, 0.f, 0.f, 0.f, 0.f, 0.f, 0.f, 0.f, 0.f, 0.f, 0.f, 0.f, 0.f, 0.f, 0.f})
#define DPP_ADD(x, ctrl) ((x) + __builtin_bit_cast(float, __builtin_amdgcn_update_dpp(0, __builtin_bit_cast(int, (x)), (ctrl), 0xF, 0xF, true)))
__device__ __forceinline__ float reduce16(float x) { x = DPP_ADD(x, 0xB1); x = DPP_ADD(x, 0x4E); x = DPP_ADD(x, 0x141); x = DPP_ADD(x, 0x140); return x; }

__device__ __forceinline__ float tanh_fast(float x) { return 1.0f - 2.0f * __builtin_amdgcn_rcpf(__expf(2.0f * x) + 1.0f); }
__device__ __forceinline__ void scan_unit(const Frame& F, const Args& AR, int unit, int& cur_h, bf16* OB_) {
    LAS unsigned char* L = F.lds;
    const int lane = lane_id(), wave = F.wave, tid = wave * 64 + lane, q = lane & 31, hi = lane >> 5;
    const bool sample = unit >= 128;
    int b, h;
    if (!sample) { b = unit >> 4; h = unit & 15; } else { const int su = unit - 128; h = su >> 7; b = su & 127; }
    const size_t m0 = sample ? (size_t)MP + (size_t)b * DECS : (size_t)b * SEQ;
    const int ntok = sample ? DECS : 32, nch = sample ? 1 : SEQ / 32;
    const int tok = tid >> 4, cg = tid & 15, c0 = cg * 4, ch0 = h * HD + c0;
    const bf16* PS = (const bf16*)(F.ws + WS_PS); bf16* GB = (bf16*)(F.ws + WS_GA);
    __syncthreads();
    if (h != cur_h) {
        cur_h = h;
        const int j = tid >> 3, cb = (tid & 7) * 8;
        const float* p = AR.in[I_W2] + (size_t)j * DM + h * HD + cb; const f32x4 a0 = *(const f32x4*)p, a1 = *(const f32x4*)(p + 4);
        const float* p2 = AR.in[I_A2] + (size_t)j * DM + h * HD + cb; const f32x4 b0 = *(const f32x4*)p2, b1 = *(const f32x4*)(p2 + 4);
        const float wv[8] = {a0.x, a0.y, a0.z, a0.w, a1.x, a1.y, a1.z, a1.w}, av[8] = {b0.x, b0.y, b0.z, b0.w, b1.x, b1.y, b1.z, b1.w};
#pragma unroll
        for (int i = 0; i < 8; ++i) { *(LAS bf16*)(L + sc::W2T + (cb + i) * sc::P68 + 2 * j) = (bf16)cvtpk(wv[i], 0.f); *(LAS bf16*)(L + sc::A2T + (cb + i) * sc::P68 + 2 * j) = (bf16)cvtpk(av[i], 0.f); }
    }
    const int vh = wave - 4;
    f32x16 ST[2] = {ZERO16, ZERO16};
    if ((wave == 4 || wave == 5) && sample) {
        const float* sp = AR.in[I_SWKV] + ((size_t)(b * NH + h) * HD + 32 * vh + q) * HD;
#pragma unroll
        for (int kt = 0; kt < 2; ++kt)
#pragma unroll
            for (int g = 0; g < 4; ++g) { const f32x4 x = *(const f32x4*)(sp + 32 * kt + 8 * g + 4 * hi); ST[kt][4 * g + 0] = x.x; ST[kt][4 * g + 1] = x.y; ST[kt][4 * g + 2] = x.z; ST[kt][4 * g + 3] = x.w; }
    }
    for (int idx = tid; idx < 12 * 64; idx += NTHR) { const int arr = idx >> 6, c = idx & 63; const float* src;
        switch (arr) { case 0: src = AR.in[I_W0] + h * HD; break; case 1: src = AR.in[I_A0] + h * HD; break; case 2: src = AR.in[I_KK] + h * HD; break; case 3: src = AR.in[I_KA] + h * HD; break;
            case 4: src = AR.in[I_RK] + h * HD; break; case 5: src = AR.in[I_LNG] + h * HD; break; case 6: src = AR.in[I_LNB] + h * HD; break;
            case 7: src = AR.in[I_MU] + h * HD; break; case 8: src = AR.in[I_MU] + 1024 + h * HD; break; case 9: src = AR.in[I_MU] + 2048 + h * HD; break; case 10: src = AR.in[I_MU] + 3072; break; default: src = AR.in[I_MU] + 3136; break; }
        ((LAS float*)(L + sc::PAR))[idx] = src[c]; }
    if (tid < 80) { const int grp = tid >> 4, cq = (tid & 15) * 4; const int col = grp < 3 ? grp * 1024 + h * HD + cq : (grp == 3 ? 3072 + cq : 3136 + cq); v2u w = (v2u){0u, 0u};
        if (sample) { const f32x4 a = *(const f32x4*)(AR.in[I_SSHIFT] + (size_t)b * SHW + col); w.x = cvtpk(a.x, a.y); w.y = cvtpk(a.z, a.w); }
        *(LAS v2u*)(L + sc::RAWP + grp * 128 + cq * 2) = w; }
    v2u pf[5], pfg;
    { const size_t row = m0 + (tok < ntok ? tok : 0); const bf16* P = PS + row * SHW;
#pragma unroll
      for (int grp = 0; grp < 5; ++grp) pf[grp] = *(const v2u*)(P + (grp < 3 ? grp * 1024 + ch0 : (grp == 3 ? 3072 + c0 : 3136 + c0)));
      pfg = *(const v2u*)(GB + row * DM + ch0); }
    for (int chn = 0; chn < nch; ++chn) {
        const int t0 = chn * 32; const bool act = tok < ntok;
        int tk = tok, cc = c0, qv = q, hv = hi;
        asm volatile("" : "+v"(tk), "+v"(cc), "+v"(qv), "+v"(hv));
        float zr[4], zk[4], zv[4], gt[4];
        v2u curp[5];
        {
            if (tok == 31 && chn > 0) {
#pragma unroll
                for (int grp = 0; grp < 5; ++grp) *(LAS v2u*)(L + sc::RAWP + grp * 128 + cc * 2) = *(LAS const v2u*)(L + sc::RAWP + 32 * 640 + grp * 128 + cc * 2); }
#pragma unroll
            for (int grp = 0; grp < 5; ++grp) { curp[grp] = pf[grp]; *(LAS v2u*)(L + sc::RAWP + (tk + 1) * 640 + grp * 128 + cc * 2) = pf[grp]; }
            gt[0] = bflo(pfg.x); gt[1] = bfhi(pfg.x); gt[2] = bflo(pfg.y); gt[3] = bfhi(pfg.y);
            if (chn + 1 < nch) { const size_t row = m0 + t0 + 32 + tok; const bf16* P = PS + row * SHW;
#pragma unroll
                for (int grp = 0; grp < 5; ++grp) pf[grp] = *(const v2u*)(P + (grp < 3 ? grp * 1024 + ch0 : (grp == 3 ? 3072 + c0 : 3136 + c0)));
                pfg = *(const v2u*)(GB + row * DM + ch0); }
        }
        __syncthreads();
        {
            float zz[5][4];
#pragma unroll
            for (int grp = 0; grp < 5; ++grp) {
                const v2u cu = curp[grp], pu = *(LAS const v2u*)(L + sc::RAWP + tk * 640 + grp * 128 + cc * 2);
                const float cur[4] = {bflo(cu.x), bfhi(cu.x), bflo(cu.y), bfhi(cu.y)}, prv[4] = {bflo(pu.x), bfhi(pu.x), bflo(pu.y), bfhi(pu.y)};
                const f32x4 mu = *(LAS const f32x4*)(L + sc::PAR + (7 + grp) * 256 + cc * 4);
#pragma unroll
                for (int i = 0; i < 4; ++i) zz[grp][i] = act ? cur[i] + (prv[i] - cur[i]) * mu[i] : 0.f;
            }
#pragma unroll
            for (int i = 0; i < 4; ++i) { zr[i] = zz[0][i]; zk[i] = zz[1][i]; zv[i] = zz[2][i]; }
            v2u w; w.x = cvtpk(tanh_fast(zz[3][0]), tanh_fast(zz[3][1])); w.y = cvtpk(tanh_fast(zz[3][2]), tanh_fast(zz[3][3])); *(LAS v2u*)(L + sc::TW + tk * sc::P68 + cc * 2) = w;
            w.x = cvtpk(zz[4][0], zz[4][1]); w.y = cvtpk(zz[4][2], zz[4][3]); *(LAS v2u*)(L + sc::AL + tk * sc::P68 + cc * 2) = w;
        }
        __syncthreads();
        if (wave < 4) {
            const int which = wave >> 1, ct = wave & 1; f32x16 acc = ZERO16;
            LAS const unsigned char* Aop = L + (which ? sc::AL : sc::TW); LAS const unsigned char* Bop = L + (which ? sc::A2T : sc::W2T);
#pragma unroll
            for (int s = 0; s < 4; ++s) acc = MFMA32(frag_nat(Aop, sc::P68, qv, 16 * s + 8 * hv), frag_nat(Bop, sc::P68, 32 * ct + qv, 16 * s + 8 * hv), acc);
            LAS float* o = (LAS float*)(L + (which ? sc::UA : sc::UW)) + 32 * ct + qv;
#pragma unroll
            for (int r = 0; r < 16; ++r) o[crow(r, hv) * 65] = acc[r];
        }
        __syncthreads();
        float lw[4], asg[4];
        {
            LAS float* uwp = (LAS float*)(L + sc::UW) + tk * 65 + cc; LAS const float* uap = (LAS const float*)(L + sc::UA) + tk * 65 + cc;
            const f32x4 w0 = *(LAS const f32x4*)(L + sc::PAR + 0 * 256 + cc * 4), a0 = *(LAS const f32x4*)(L + sc::PAR + 1 * 256 + cc * 4);
#pragma unroll
            for (int i = 0; i < 4; ++i) { lw[i] = act ? -0.6065306597126334f * sigmoidf_(uwp[i] + w0[i]) : 0.f; asg[i] = sigmoidf_(uap[i] + a0[i]); uwp[i] = lw[i]; }
        }
        __syncthreads();
        {
            const int c = tid >> 3, part = tid & 7; LAS float* p = (LAS float*)(L + sc::UW) + (4 * part) * 65 + c;
            float x0 = p[0], x1 = x0 + p[65], x2 = x1 + p[130], x3 = x2 + p[195];
            float inc = x3;
#define SHR_ADD(d) { const float y = __builtin_bit_cast(float, __builtin_amdgcn_update_dpp(0, __builtin_bit_cast(int, inc), 0x110 + (d), 0xF, 0xF, true)); if (part >= (d)) inc += y; }
            SHR_ADD(1) SHR_ADD(2) SHR_ADD(4)
#undef SHR_ADD
            const float ex = inc - x3;
            p[0] = x0 + ex; p[65] = x1 + ex; p[130] = x2 + ex; p[195] = x3 + ex;
        }
        __syncthreads();
        float rk;
        {
            LAS const float* Lp_ = (LAS const float*)(L + sc::UW) + tk * 65 + cc; LAS const float* LCp = (LAS const float*)(L + sc::UW) + 31 * 65 + cc;
            const f32x4 kkw = *(LAS const f32x4*)(L + sc::PAR + 2 * 256 + cc * 4), kaw = *(LAS const f32x4*)(L + sc::PAR + 3 * 256 + cc * 4), rkw = *(LAS const f32x4*)(L + sc::PAR + 4 * 256 + cc * 4);
            float kkv[4], ss = 0.f;
#pragma unroll
            for (int i = 0; i < 4; ++i) { kkv[i] = zk[i] * kkw[i]; ss += kkv[i] * kkv[i]; }
            ss = reduce16(ss);
            const float invn = 1.0f / fmaxf(sqrtf(ss), 1e-12f);
            float at[4], rt[4], bt[4], kt[4], bh[4], kh[4]; rk = 0.f;
#pragma unroll
            for (int i = 0; i < 4; ++i) { const float Lv = Lp_[i], LC = LCp[i];
                const float e2 = __expf(Lv), e1 = __expf(Lv - lw[i]), e3 = __expf(-Lv), e4 = __expf(LC - Lv);
                const float kn = kkv[i] * invn, kp = zk[i] * (1.0f + (asg[i] - 1.0f) * kaw[i]), bb = kn * asg[i];
                at[i] = -kn * e1; rt[i] = zr[i] * e2; bt[i] = bb * e3; kt[i] = kp * e3; bh[i] = bb * e4; kh[i] = kp * e4; rk += zr[i] * kp * rkw[i];
                if (tok == 31) ((LAS float*)(L + sc::GC))[cc + i] = __expf(LC); }
            rk = reduce16(rk);
            v2u w; w.x = cvtpk(at[0], at[1]); w.y = cvtpk(at[2], at[3]); *(LAS v2u*)(L + sc::AT + tk * sc::P68 + cc * 2) = w;
#pragma unroll
            for (int i = 0; i < 4; ++i) *(LAS bf16*)(L + sc::ATT + (cc + i) * sc::P36 + tk * 2) = (bf16)((i & 1) ? ((i & 2) ? w.y : w.x) >> 16 : ((i & 2) ? w.y : w.x));
            w.x = cvtpk(rt[0], rt[1]); w.y = cvtpk(rt[2], rt[3]); *(LAS v2u*)(L + sc::RT + tk * sc::P68 + cc * 2) = w;
            w.x = cvtpk(bt[0], bt[1]); w.y = cvtpk(bt[2], bt[3]); *(LAS v2u*)(L + sc::BT + tk * sc::P68 + cc * 2) = w;
            w.x = cvtpk(kt[0], kt[1]); w.y = cvtpk(kt[2], kt[3]); *(LAS v2u*)(L + sc::KT + tk * sc::P68 + cc * 2) = w;
            w.x = cvtpk(bh[0], bh[1]); w.y = cvtpk(bh[2], bh[3]);
#pragma unroll
            for (int i = 0; i < 4; ++i) *(LAS bf16*)(L + sc::BHT + (cc + i) * sc::P36 + tk * 2) = (bf16)((i & 1) ? ((i & 2) ? w.y : w.x) >> 16 : ((i & 2) ? w.y : w.x));
            w.x = cvtpk(kh[0], kh[1]); w.y = cvtpk(kh[2], kh[3]);
#pragma unroll
            for (int i = 0; i < 4; ++i) *(LAS bf16*)(L + sc::KHT + (cc + i) * sc::P36 + tk * 2) = (bf16)((i & 1) ? ((i & 2) ? w.y : w.x) >> 16 : ((i & 2) ? w.y : w.x));
            w.x = cvtpk(zv[0], zv[1]); w.y = cvtpk(zv[2], zv[3]);
#pragma unroll
            for (int i = 0; i < 4; ++i) *(LAS bf16*)(L + sc::VTT + (cc + i) * sc::P36 + tk * 2) = (bf16)((i & 1) ? ((i & 2) ? w.y : w.x) >> 16 : ((i & 2) ? w.y : w.x));
        }
        __syncthreads();
        f32x16 Pm = ZERO16;
        if (wave < 4) {
            LAS const unsigned char* Aop = L + ((wave < 2) ? sc::AT : sc::RT); LAS const unsigned char* Bop = L + ((wave == 0 || wave == 3) ? sc::BT : sc::KT);
#pragma unroll
            for (int s = 0; s < 4; ++s) Pm = MFMA32(frag_nat(Aop, sc::P68, qv, 16 * s + 8 * hv), frag_nat(Bop, sc::P68, qv, 16 * s + 8 * hv), Pm);
#pragma unroll
            for (int r = 0; r < 16; ++r) { const int t = crow(r, hv); const bool keep = (wave < 2) ? (qv < t) : (qv <= t); Pm[r] = keep ? Pm[r] : 0.f; }
            if (wave > 0) store_rm(L + (wave == 1 ? sc::MAK : (wave == 2 ? sc::MRK : sc::MRB)), sc::P36, Pm, qv, hv);
        }
        __syncthreads();
        f32x16 Xa = ZERO16, Y0 = ZERO16, H0[2] = {ZERO16, ZERO16};
        if (wave == 0) {
            f32x16 Am = Pm;
#pragma unroll
            for (int r = 0; r < 16; ++r) Am[r] += (crow(r, hv) == qv) ? 1.0f : 0.0f;
#pragma unroll
            for (int lv = 0; lv < 4; ++lv) {
                store_rm(L + sc::PRM, sc::P36, Pm, qv, hv); store_rm(L + sc::ARM, sc::P36, Am, qv, hv);
                const bf16x8 p0 = pk8(Pm, 0), p1 = pk8(Pm, 1);
                f32x16 Pn = MFMA32(frag_perm(L + sc::PRM, sc::P36, qv, 0, hv), p0, ZERO16); Pn = MFMA32(frag_perm(L + sc::PRM, sc::P36, qv, 16, hv), p1, Pn);
                const bf16x8 n0 = pk8(Pn, 0), n1 = pk8(Pn, 1);
                Am = MFMA32(frag_perm(L + sc::ARM, sc::P36, qv, 0, hv), n0, Am); Am = MFMA32(frag_perm(L + sc::ARM, sc::P36, qv, 16, hv), n1, Am);
                Pm = Pn;
            }
            store_rm(L + sc::TRM, sc::P36, Am, qv, hv);
#pragma unroll
            for (int nt = 0; nt < 2; ++nt) { f32x16 w1 = ZERO16;
#pragma unroll
                for (int s = 0; s < 2; ++s) w1 = MFMA32(frag_nat(L + sc::TRM, sc::P36, qv, 16 * s + 8 * hv), frag_nat(L + sc::ATT, sc::P36, 32 * nt + qv, 16 * s + 8 * hv), w1);
                store_rm(L + sc::W1R + 64 * nt, sc::P68, w1, qv, hv); }
        } else if (wave == 4 || wave == 5) {
            const bf16x8 vf0 = frag_nat(L + sc::VTT, sc::P36, 32 * vh + qv, 8 * hv), vf1 = frag_nat(L + sc::VTT, sc::P36, 32 * vh + qv, 16 + 8 * hv);
            Xa = MFMA32(frag_nat(L + sc::MAK, sc::P36, qv, 8 * hv), vf0, Xa); Xa = MFMA32(frag_nat(L + sc::MAK, sc::P36, qv, 16 + 8 * hv), vf1, Xa);
            Y0 = MFMA32(frag_nat(L + sc::MRK, sc::P36, qv, 8 * hv), vf0, Y0); Y0 = MFMA32(frag_nat(L + sc::MRK, sc::P36, qv, 16 + 8 * hv), vf1, Y0);
#pragma unroll
            for (int kt = 0; kt < 2; ++kt) { H0[kt] = MFMA32(frag_nat(L + sc::KHT, sc::P36, 32 * kt + qv, 8 * hv), vf0, H0[kt]); H0[kt] = MFMA32(frag_nat(L + sc::KHT, sc::P36, 32 * kt + qv, 16 + 8 * hv), vf1, H0[kt]); }
        }
        __syncthreads();
        if (wave == 4 || wave == 5) {
            f32x16 U = MFMA32(frag_perm(L + sc::TRM, sc::P36, qv, 0, hv), pk8(Xa, 0), ZERO16); U = MFMA32(frag_perm(L + sc::TRM, sc::P36, qv, 16, hv), pk8(Xa, 1), U);
            f32x16 Y = Y0;
#pragma unroll
            for (int kt = 0; kt < 2; ++kt)
#pragma unroll
                for (int s = 0; s < 2; ++s) { const bf16x8 sb = pk8(ST[kt], s);
                    U = MFMA32(frag_perm(L + sc::W1R, sc::P68, qv, 32 * kt + 16 * s, hv), sb, U);
                    Y = MFMA32(frag_perm(L + sc::RT, sc::P68, qv, 32 * kt + 16 * s, hv), sb, Y); }
            const bf16x8 u0 = pk8(U, 0), u1 = pk8(U, 1);
            Y = MFMA32(frag_perm(L + sc::MRB, sc::P36, qv, 0, hv), u0, Y); Y = MFMA32(frag_perm(L + sc::MRB, sc::P36, qv, 16, hv), u1, Y);
#pragma unroll
            for (int kt = 0; kt < 2; ++kt) { f32x16 acc;
#pragma unroll
                for (int g = 0; g < 4; ++g) { const f32x4 gc = *(LAS const f32x4*)(L + sc::GC + (32 * kt + 8 * g + 4 * hv) * 4);
                    acc[4 * g + 0] = gc.x * ST[kt][4 * g + 0] + H0[kt][4 * g + 0]; acc[4 * g + 1] = gc.y * ST[kt][4 * g + 1] + H0[kt][4 * g + 1];
                    acc[4 * g + 2] = gc.z * ST[kt][4 * g + 2] + H0[kt][4 * g + 2]; acc[4 * g + 3] = gc.w * ST[kt][4 * g + 3] + H0[kt][4 * g + 3]; }
                acc = MFMA32(frag_perm(L + sc::BHT, sc::P36, 32 * kt + qv, 0, hv), u0, acc); acc = MFMA32(frag_perm(L + sc::BHT, sc::P36, 32 * kt + qv, 16, hv), u1, acc);
                ST[kt] = acc; }
            LAS float* yo = (LAS float*)(L + sc::YB) + 32 * vh + qv;
#pragma unroll
            for (int r = 0; r < 16; ++r) yo[crow(r, hv) * 65] = Y[r];
        }
        __syncthreads();
        if (act) {
            LAS const float* yp = (LAS const float*)(L + sc::YB) + tk * 65 + cc;
            float y[4] = {yp[0], yp[1], yp[2], yp[3]};
            const float mean = reduce16((y[0] + y[1]) + (y[2] + y[3])) * (1.0f / 64.0f);
#pragma unroll
            for (int i = 0; i < 4; ++i) y[i] -= mean;
            const float var = reduce16((y[0] * y[0] + y[1] * y[1]) + (y[2] * y[2] + y[3] * y[3])) * (1.0f / 64.0f);
            const float rstd = 1.0f / sqrtf(var + GN_EPS);
            const f32x4 lg = *(LAS const f32x4*)(L + sc::PAR + 5 * 256 + cc * 4), lb = *(LAS const f32x4*)(L + sc::PAR + 6 * 256 + cc * 4);
            float o[4];
#pragma unroll
            for (int i = 0; i < 4; ++i) o[i] = (y[i] * rstd * lg[i] + lb[i] + rk * zv[i]) * gt[i];
            v2u w; w.x = cvtpk(o[0], o[1]); w.y = cvtpk(o[2], o[3]);
            *(v2u*)(OB_ + (m0 + t0 + tok) * DM + ch0) = w;
        }
    }
    if (wave == 4 || wave == 5) {
        float* dp = F.out + (sample ? O_SWKV : O_PWKV) + ((size_t)(b * NH + h) * HD + 32 * vh + q) * HD;
#pragma unroll
        for (int kt = 0; kt < 2; ++kt)
#pragma unroll
            for (int g = 0; g < 4; ++g) *(f32x4*)(dp + 32 * kt + 8 * g + 4 * hi) = (f32x4){ST[kt][4 * g + 0], ST[kt][4 * g + 1], ST[kt][4 * g + 2], ST[kt][4 * g + 3]};
    }
}

__device__ __forceinline__ void final_norm(const Frame& F, const Args& AR, float* dst) {
    const int gw = F.vcu * NWAVES + F.wave, NGW = F.G * NWAVES;
    const float* ss = (const float*)(F.ws + WS_SS); const int lane = lane_id(); const GAS f32x4* gr = (const GAS f32x4*)AR.in[I_FING] + lane;
    for (int m = gw; m < MT; m += NGW) {
        const float sc = 1.0f / sqrtf(ss[m] * (1.f / DM) + NORM_EPS);
        GAS f32x4* xr = (GAS f32x4*)(F.out + (size_t)m * DM) + lane;
        GAS f32x4* yr = (GAS f32x4*)(dst + (size_t)m * DM) + lane;
#pragma unroll
        for (int j = 0; j < 4; ++j) { const f32x4 v = xr[64 * j], g = gr[64 * j]; yr[64 * j] = v * sc * g; }
    }
}

#ifndef MK_PER_PHASE
#define MK_PER_PHASE 0
#endif
constexpr int N_PHASES = 9;
__global__ void __launch_bounds__(NTHR, 2) hybrid_fwd(Args args) {
    extern __shared__ __attribute__((aligned(16))) unsigned char lds[];
    Frame F;
    F.lds = (LAS unsigned char*)lds;
    F.wave = __builtin_amdgcn_readfirstlane(threadIdx.x >> 6);
    F.G = gridDim.x; { const int bx = blockIdx.x; F.vcu = (F.G % 8 == 0) ? (bx % 8) * (F.G / 8) + bx / 8 : bx; }
    F.out = args.out; F.ws = args.ws;
    volatile LAS unsigned* MISC = (volatile LAS unsigned*)(F.lds + MISC_OFF);
    for (int u = threadIdx.x; u < (LDS_BYTES - LDSCTL_OFF) / 4; u += NTHR) ((LAS unsigned*)(F.lds + LDSCTL_OFF))[u] = 0u;
    __syncthreads();
    XcdBarrier bar; bar.bar = (unsigned*)(F.ws + WS_CTL) + CW_BAR; bar.x = 0; bar.st = nullptr;
    if (!MK_PER_PHASE) bar = xcd_barrier_post((unsigned*)(F.ws + WS_CTL) + CW_BAR, MISC + 8);
    const int lo = args.ph_lo, hi = args.ph_hi;
#ifndef DUP
#define DUP 0
#endif
#define REP(k) for (int rep_ = ((DUP >> (k)) & 1) ? 0 : 1; rep_ < 2; ++rep_)
#ifndef PHMASK
#define PHMASK 0x1ff
#endif
#define IN(k) ((((PHMASK) >> (k)) & 1) && lo <= (k) && (k) < hi)
#define SEAM(k) do { if (IN(k) && IN((k) + 1)) xcd_barrier(bar); } while (0)

    if (IN(0)) { REP(0) p0_prologue(F, args); }
    SEAM(0);
    if (IN(1)) {
        pg8::Gemm g{(const bf16*)(F.ws + WS_XN), (const bf16*)(F.ws + WS_W1T), MT, N1A, DM}; pg8::StaticOrder S; S.init(MT, N1A, F.G, (int)blockIdx.x);
        EpiG1 E{0, F.ws, F.out};
        REP(1) pg8::gemm_phase<EpiG1, pg8::StaticOrder, true, true>(F.lds, g, S, E);
    }
    SEAM(1);
    if (IN(2)) { REP(2) { bf16* ob = (bf16*)(F.ws + (rep_ ? WS_Q : WS_PS)); for (int u = F.vcu; u < 1024 + 512; u += F.G) attn_unit(F, args, u, ob); } }
    SEAM(2);
    if (IN(3)) {
        pg8::Gemm g{(const bf16*)(F.ws + WS_XN), (const bf16*)(F.ws + WS_W1T) + (size_t)N1A * DM, MT, N1B, DM}; pg8::StaticOrder S; S.init(MT, N1B, F.G, (int)blockIdx.x);
        EpiG1 E{1, F.ws, F.out};
        REP(3) pg8::gemm_phase<EpiG1, pg8::StaticOrder, true, true>(F.lds, g, S, E);
    }
    SEAM(3);
    if (IN(4)) { int cur_h = -1; const int bx = (int)blockIdx.x;
        int u0, cnt, stride;
        if (F.G >= 256) { if (bx < 128) { u0 = bx; cnt = 1; stride = 1; } else if (bx < 256) { u0 = 128 + (bx - 128) * 16; cnt = 16; stride = 1; } else { u0 = 0; cnt = 0; stride = 1; } }
        else { u0 = bx; stride = F.G; cnt = (128 + 2048 - bx + F.G - 1) / F.G; }
        REP(4) { bf16* ob = (bf16*)(F.ws + (rep_ ? WS_GA : WS_XN)); for (int j = 0; j < cnt; ++j) scan_unit(F, args, u0 + j * stride, cur_h, ob); } }
    SEAM(4);
    if (IN(5)) {
        pg8::Gemm g{(const bf16*)(F.ws + WS_Q), (const bf16*)(F.ws + WS_WAT), MT, DM, DM}; pg8::StaticOrder S; S.init(MT, DM, F.G, (int)blockIdx.x);
        EpiGate E{0, (const bf16*)F.out, nullptr, (bf16*)(F.ws + WS_PS)};
        REP(5) pg8::gemm_phase<EpiGate, pg8::StaticOrder, true, true>(F.lds, g, S, E);
    }
    SEAM(5);
    if (IN(6)) {
        pg8::Gemm g{(const bf16*)(F.ws + WS_GA), (const bf16*)(F.ws + WS_WBT), MT, DM, DM}; pg8::StaticOrder S; S.init(MT, DM, F.G, (int)blockIdx.x);
        EpiGate E{1, (const bf16*)F.out + (size_t)MT * DM, (const bf16*)(F.ws + WS_PS), (bf16*)(F.ws + WS_XN)};
        REP(6) pg8::gemm_phase<EpiGate, pg8::StaticOrder, true, true>(F.lds, g, S, E);
    }
    SEAM(6);
    if (IN(7)) {
        pg8::Gemm g{(const bf16*)(F.ws + WS_XN), (const bf16*)(F.ws + WS_WOT), MT, DM, DM}; pg8::StaticOrder S; S.init(MT, DM, F.G, (int)blockIdx.x);
        REP(7) { EpiOut E{args.in[I_XP], args.in[I_XS], F.out, (float*)(F.ws + WS_SS + (rep_ ? 0 : 192 * 1024))};
        pg8::gemm_phase<EpiOut, pg8::StaticOrder, true, true>(F.lds, g, S, E); }
    }
    SEAM(7);
    if (IN(8)) { REP(8) final_norm(F, args, rep_ ? F.out : (float*)(F.ws + WS_PS)); }
#undef IN
#undef SEAM
}

extern "C" void kernel_launch(void* const* d_in, const int* in_sizes, int n_in, void* d_out, int out_size, void* d_ws, size_t ws_size, hipStream_t stream) {
    static int grid = 0;
    if (grid == 0) {
        if (n_in != 24 || (size_t)out_size != O_END || ws_size < WS_END) { fprintf(stderr, "kernel_launch: unexpected sizes: n_in %d out %d ws %zu (need %zu)\n", n_in, out_size, ws_size, (size_t)WS_END); grid = -1; return; }
        int dev = 0, cus = 0;
        if (hipGetDevice(&dev) != hipSuccess || hipDeviceGetAttribute(&cus, hipDeviceAttributeMultiprocessorCount, dev) != hipSuccess) { grid = -1; return; }
        if (hipFuncSetAttribute((const void*)hybrid_fwd, hipFuncAttributeMaxDynamicSharedMemorySize, LDS_BYTES) != hipSuccess) { fprintf(stderr, "kernel_launch: hipFuncSetAttribute failed\n"); grid = -1; return; }
        int per_cu = 0;
        if (hipOccupancyMaxActiveBlocksPerMultiprocessor(&per_cu, (const void*)hybrid_fwd, NTHR, LDS_BYTES) != hipSuccess || per_cu < 1) fprintf(stderr, "kernel_launch: occupancy query says %d\n", per_cu);
        (void)hipGetLastError();
        grid = cus;
    }
    if (grid < 0) return;
    (void)hipMemsetAsync((char*)d_ws + WS_CTL, 0, CTL_ZERO_BYTES, stream);
    Args a{};
    for (int i = 0; i < 24; ++i) a.in[i] = (const float*)d_in[i];
    a.out = (float*)d_out; a.ws = (unsigned char*)d_ws;
#if MK_PER_PHASE
    for (int p = 0; p < N_PHASES; ++p) { a.ph_lo = p; a.ph_hi = p + 1; hipLaunchKernelGGL(hybrid_fwd, dim3(grid), dim3(NTHR), LDS_BYTES, stream, a); }
#else
    a.ph_lo = 0; a.ph_hi = N_PHASES; hipLaunchKernelGGL(hybrid_fwd, dim3(grid), dim3(NTHR), LDS_BYTES, stream, a);
#endif
}
```

```cpp
#include <hip/hip_runtime.h>
#include <cstdio>
#include <cstdint>
#include <cmath>
namespace pg8 {
#define PG8_LAS __attribute__((address_space(3)))
typedef unsigned short bf16_t;
typedef short bf16x8 __attribute__((ext_vector_type(8)));
typedef float f32x4 __attribute__((ext_vector_type(4)));
typedef unsigned u32x4 __attribute__((ext_vector_type(4)));
constexpr int BM = 256, BK = 64, HALF = 128, HTB = HALF * BK * 2  , STAGE_BYTES = 8 * HTB, NXCD = 8, WGM = 8;

__host__ __device__ __forceinline__ int lds_byte(int r, int c) { const int st = (r >> 4) * 2 + (c >> 5), rr = r & 15, cc = c & 31, ob = rr * 64 + cc * 2; return st * 1024 + (ob ^ (((ob >> 9) & 1) << 5)); }
__host__ __device__ __forceinline__ void stage_rc(int b, int& R, int& C) { const int st = b / 1024, sb = b % 1024, swz = sb ^ (((sb >> 9) & 1) << 5); R = (st >> 1) * 16 + swz / 64; C = (st & 1) * 32 + (swz % 64) / 2; }
__host__ __device__ __forceinline__ int perm32(int rho) { const int n = rho >> 4, i = rho & 15; return 8 * (i >> 2) + 4 * n + (i & 3); }

struct Unit { int pm, pn; };
struct Gemm { const bf16_t* A; const bf16_t* Bt; int M, N, K; };

struct StaticOrder {
    int nM, nN, nwg, G, c;
    __host__ __device__ void init(int M, int N, int G_, int c_) { nM = M / BM; nN = N / BM; nwg = nM * nN; G = G_; c = c_; }
    __host__ __device__ bool next(int i, Unit& u) const {
        const long L = (long)i * G + c; if (L >= nwg) return false;
        int wgid = (int)L; { const int q = nwg / NXCD, r = nwg % NXCD, xcd = wgid % NXCD, off = wgid / NXCD; wgid = (xcd < r ? xcd * (q + 1) : r * (q + 1) + (xcd - r) * q) + off; }
        const int nig = WGM * nN, gid = wgid / nig, fm = gid * WGM, gsz = (nM - fm) < WGM ? (nM - fm) : WGM;
        u.pm = fm + ((wgid % nig) % gsz); u.pn = (wgid % nig) / gsz; return true;
    }
    __device__ __forceinline__ void a_ready(const Unit&) const {}
    __device__ __forceinline__ void done(const Unit&) const {}
};

__device__ __forceinline__ unsigned cvt_pk_bf16(float lo, float hi) { unsigned r; asm volatile("v_cvt_pk_bf16_f32 %0, %1, %2" : "=v"(r) : "v"(lo), "v"(hi)); return r; }
typedef float f32x2 __attribute__((ext_vector_type(2)));
template <class Epi, class Sched, bool ALIGN_EPI = false, bool SP2 = false>
__device__ __forceinline__ void gemm_phase(PG8_LAS unsigned char* lds, const Gemm g, const Sched& S, const Epi& E) {
    const int tid = threadIdx.x, wid = __builtin_amdgcn_readfirstlane(tid >> 6), lane = tid & 63, wr = wid >> 2, wc = wid & 3, fr = lane & 15, fq = lane >> 4;
    const int K = g.K, nt = K / BK;
    unsigned voffA[2], voffB[2];
#pragma unroll
    for (int i = 0; i < 2; ++i) { int R, C; stage_rc(tid * 16 + i * 8192, R, C); const int Rb = Epi::PERM ? ((R & ~31) + perm32(R & 31)) : R;
        voffA[i] = (unsigned)(R * K + C) * 2u; voffB[i] = (unsigned)(Rb * K + C) * 2u; }
    const size_t kstep = (size_t)(BK * 2);
    const size_t hstep = (size_t)HALF * K * 2;
    const size_t tstep = 2 * hstep;
    const unsigned ldsw = (unsigned)wid * 1024u;
    const int aoff = lds_byte(wr * 64 + fr, fq * 8), boff = lds_byte(wc * 32 + fr, fq * 8);
#define PG8_SA(b, h) (((b) * 2 + (h)) * HTB)
#define PG8_SB(b, h) ((4 + (b) * 2 + (h)) * HTB)
#define PG8_STAGE(bufoff, gbase, voff) do { _Pragma("unroll") for (int _i = 0; _i < 2; ++_i) \
        __builtin_amdgcn_global_load_lds((const unsigned*)((const char*)(gbase) + (voff)[_i]), (PG8_LAS unsigned*)(lds + (bufoff) + ldsw + _i * 8192), 16, 0, 0); } while (0)
#define PG8_LDA(dst, b, h) do { _Pragma("unroll") for (int m = 0; m < 4; ++m) _Pragma("unroll") for (int k = 0; k < 2; ++k) dst[m][k] = *(const PG8_LAS bf16x8*)(lds + PG8_SA(b, h) + aoff + m * 2048 + k * 1024); } while (0)
#define PG8_LDB(dst, b, h) do { _Pragma("unroll") for (int n = 0; n < 2; ++n) _Pragma("unroll") for (int k = 0; k < 2; ++k) dst[n][k] = *(const PG8_LAS bf16x8*)(lds + PG8_SB(b, h) + boff + n * 2048 + k * 1024); } while (0)
#define PG8_MMA(ai, bj, At, Bt) do { __builtin_amdgcn_s_setprio(1); _Pragma("unroll") for (int m = 0; m < 4; ++m) _Pragma("unroll") for (int n = 0; n < 2; ++n) _Pragma("unroll") for (int k = 0; k < 2; ++k) \
        acc[ai][bj][m][n] = __builtin_amdgcn_mfma_f32_16x16x32_bf16(Bt[n][k], At[m][k], acc[ai][bj][m][n], 0, 0, 0); __builtin_amdgcn_s_setprio(0); } while (0)
#define PG8_WAIT_V(n) asm volatile("s_waitcnt vmcnt(" #n ")" ::: "memory")
#define PG8_WAIT_L(n) asm volatile("s_waitcnt lgkmcnt(" #n ")" ::: "memory")
#define PG8_BAR __builtin_amdgcn_s_barrier()
#define PG8_SCHED __builtin_amdgcn_sched_barrier(0)
    Unit cur, nxt; int ui = 0;
    if (!S.next(0, cur)) return;
    f32x4 acc[2][2][4][2];
#pragma unroll
    for (int a = 0; a < 2; ++a)
#pragma unroll
        for (int b = 0; b < 2; ++b)
#pragma unroll
            for (int m = 0; m < 4; ++m)
#pragma unroll
                for (int n = 0; n < 2; ++n) acc[a][b][m][n] = (f32x4){0.f, 0.f, 0.f, 0.f};
    bf16x8 At[4][2], B0[2][2], B1[2][2];
    const char* cA = (const char*)g.A + (size_t)cur.pm * tstep; const char* cB = (const char*)g.Bt + (size_t)cur.pn * tstep;
    S.a_ready(cur);
    if constexpr (SP2) {
        PG8_STAGE(PG8_SB(0, 0), cB, voffB); PG8_STAGE(PG8_SB(0, 1), cB + hstep, voffB); PG8_STAGE(PG8_SA(0, 0), cA, voffA); PG8_STAGE(PG8_SA(0, 1), cA + hstep, voffA);
        if (wr == 1) PG8_BAR;
        PG8_WAIT_V(2); PG8_BAR;
        PG8_STAGE(PG8_SB(1, 0), cB + kstep, voffB); PG8_STAGE(PG8_SA(1, 0), cA + kstep, voffA); PG8_STAGE(PG8_SB(1, 1), cB + hstep + kstep, voffB);
        PG8_WAIT_V(6); PG8_BAR;
    } else {
        PG8_STAGE(PG8_SB(0, 0), cB, voffB); PG8_STAGE(PG8_SA(0, 0), cA, voffA); PG8_STAGE(PG8_SB(0, 1), cB + hstep, voffB); PG8_STAGE(PG8_SA(0, 1), cA + hstep, voffA);
        if (wr == 1) PG8_BAR;
        PG8_WAIT_V(4); PG8_BAR;
        PG8_STAGE(PG8_SB(1, 0), cB + kstep, voffB); PG8_STAGE(PG8_SA(1, 0), cA + kstep, voffA); PG8_STAGE(PG8_SB(1, 1), cB + hstep + kstep, voffB);
        PG8_WAIT_V(6); PG8_BAR;
    }
    for (;;) {
        const bool has_next = S.next(ui + 1, nxt);
        const char* nA = has_next ? (const char*)g.A + (size_t)nxt.pm * tstep : cA; const char* nB = has_next ? (const char*)g.Bt + (size_t)nxt.pn * tstep : cB;
        for (int t = 0; t < nt; t += 2) {
            const bool last = (t == nt - 2);
            const char* a1 = cA + (size_t)(t + 1) * kstep;
            const char* a2 = last ? nA : cA + (size_t)(t + 2) * kstep; const char* b2 = last ? nB : cB + (size_t)(t + 2) * kstep;
            const char* a3 = a2 + kstep; const char* b3 = b2 + kstep;
            if (last && has_next) S.a_ready(nxt);
            if constexpr (SP2) {
            PG8_LDB(B0, 0, 0); PG8_LDB(B1, 0, 1); PG8_SCHED; PG8_LDA(At, 0, 0); PG8_STAGE(PG8_SA(1, 1), a1 + hstep, voffA);
            PG8_WAIT_V(8); PG8_WAIT_L(0); PG8_BAR; PG8_MMA(0, 0, At, B0); PG8_MMA(0, 1, At, B1); PG8_BAR; PG8_SCHED;
            PG8_LDA(At, 0, 1); PG8_STAGE(PG8_SB(0, 0), b2, voffB); PG8_STAGE(PG8_SB(0, 1), b2 + hstep, voffB); PG8_STAGE(PG8_SA(0, 0), a2, voffA);
            PG8_WAIT_V(8); PG8_WAIT_L(0); PG8_BAR; PG8_MMA(1, 0, At, B0); PG8_MMA(1, 1, At, B1); PG8_BAR; PG8_SCHED;
            PG8_LDB(B0, 1, 0); PG8_LDB(B1, 1, 1); PG8_SCHED; PG8_LDA(At, 1, 0); PG8_STAGE(PG8_SA(0, 1), a2 + hstep, voffA);
            PG8_WAIT_V(8); PG8_WAIT_L(0); PG8_BAR; PG8_MMA(0, 0, At, B0); PG8_MMA(0, 1, At, B1); PG8_BAR; PG8_SCHED;
            PG8_LDA(At, 1, 1); PG8_STAGE(PG8_SB(1, 0), b3, voffB); PG8_STAGE(PG8_SB(1, 1), b3 + hstep, voffB); PG8_STAGE(PG8_SA(1, 0), a3, voffA);
            PG8_WAIT_V(8); PG8_WAIT_L(0); PG8_BAR; PG8_MMA(1, 0, At, B0); PG8_MMA(1, 1, At, B1); PG8_BAR; PG8_SCHED;
            } else {
            PG8_LDB(B0, 0, 0); PG8_SCHED; PG8_LDA(At, 0, 0); PG8_STAGE(PG8_SA(1, 1), a1 + hstep, voffA);
            PG8_WAIT_L(8); PG8_BAR; PG8_WAIT_L(0); PG8_MMA(0, 0, At, B0); PG8_BAR; PG8_SCHED;
            PG8_LDB(B1, 0, 1); PG8_STAGE(PG8_SB(0, 0), b2, voffB);
            PG8_BAR; PG8_WAIT_L(0); PG8_MMA(0, 1, At, B1); PG8_BAR;
            PG8_LDA(At, 0, 1); PG8_STAGE(PG8_SA(0, 0), a2, voffA);
            PG8_BAR; PG8_WAIT_L(0); PG8_MMA(1, 0, At, B0); PG8_BAR; PG8_SCHED;
            PG8_STAGE(PG8_SB(0, 1), b2 + hstep, voffB);
            PG8_WAIT_V(6); PG8_BAR; PG8_MMA(1, 1, At, B1); PG8_BAR;
            PG8_LDB(B0, 1, 0); PG8_SCHED; PG8_LDA(At, 1, 0); PG8_STAGE(PG8_SA(0, 1), a2 + hstep, voffA);
            PG8_WAIT_L(8); PG8_BAR; PG8_WAIT_L(0); PG8_MMA(0, 0, At, B0); PG8_BAR; PG8_SCHED;
            PG8_LDB(B1, 1, 1); PG8_STAGE(PG8_SB(1, 0), b3, voffB);
            PG8_BAR; PG8_WAIT_L(0); PG8_MMA(0, 1, At, B1); PG8_BAR;
            PG8_LDA(At, 1, 1); PG8_STAGE(PG8_SA(1, 0), a3, voffA);
            PG8_BAR; PG8_WAIT_L(0); PG8_MMA(1, 0, At, B0); PG8_BAR; PG8_SCHED;
            PG8_STAGE(PG8_SB(1, 1), b3 + hstep, voffB);
            PG8_WAIT_V(6); PG8_BAR; PG8_MMA(1, 1, At, B1); PG8_BAR;
            }
        }
        if constexpr (ALIGN_EPI) { if (wr == 0) PG8_BAR; }
        if constexpr (!Epi::AFTER_DRAIN) { E(acc, cur, wr, wc, fr, fq); S.done(cur); }
        if (!has_next) break;
#pragma unroll
        for (int a = 0; a < 2; ++a)
#pragma unroll
            for (int b = 0; b < 2; ++b)
#pragma unroll
                for (int m = 0; m < 4; ++m)
#pragma unroll
                    for (int n = 0; n < 2; ++n) acc[a][b][m][n] = (f32x4){0.f, 0.f, 0.f, 0.f};
        cur = nxt; cA = nA; cB = nB; ++ui;
        if constexpr (ALIGN_EPI) { if (wr == 1) PG8_BAR; }
    }
    PG8_WAIT_V(0);
    if constexpr (!ALIGN_EPI) { if (wr == 0) PG8_BAR; }
    PG8_BAR;
    if constexpr (Epi::AFTER_DRAIN) { E.fused(acc, cur, wr, wc, fr, fq, lds, wid, lane); S.done(cur); }
#undef PG8_SA
#undef PG8_SB
#undef PG8_STAGE
#undef PG8_LDA
#undef PG8_LDB
#undef PG8_MMA
#undef PG8_WAIT_V
#undef PG8_WAIT_L
#undef PG8_BAR
#undef PG8_SCHED
}
}

constexpr int DM = 1024, NBATCH = 8, SEQ = 4096, DECB = 128, DECS = 8;
constexpr int MP = NBATCH * SEQ, MS = DECB * DECS, MT = MP + MS;
constexpr int HD = 64, NH = 16, NKV = 4, WIN = 128, KVW = 256;
constexpr int SHW = 3200, INC = 8832;
constexpr int N1A = 2560, N1B = 6400, N1 = N1A + N1B;
constexpr float NORM_EPS = 1e-6f, GN_EPS = 64e-5f;

constexpr size_t O_Y = 0;
constexpr size_t O_PKW = (size_t)MT * DM;
constexpr size_t O_PVW = O_PKW + (size_t)NBATCH * WIN * KVW;
constexpr size_t O_PWKV = O_PVW + (size_t)NBATCH * WIN * KVW;
constexpr size_t O_PSH = O_PWKV + (size_t)NBATCH * NH * HD * HD;
constexpr size_t O_SKW = O_PSH + (size_t)NBATCH * SHW;
constexpr size_t O_SVW = O_SKW + (size_t)DECB * WIN * KVW;
constexpr size_t O_SWKV = O_SVW + (size_t)DECB * WIN * KVW;
constexpr size_t O_SSH = O_SWKV + (size_t)DECB * NH * HD * HD;
constexpr size_t O_END = O_SSH + (size_t)DECB * SHW;
static_assert(O_END == 52864000, "output size");

constexpr size_t MiB = 1u << 20;
constexpr size_t WS_CTL = 0, CTL_ZERO_BYTES = 1 * MiB;
constexpr size_t WS_SS = 512 * 1024;
constexpr size_t WS_ZROW = 900 * 1024;
constexpr size_t WS_SROW = 1 * MiB;
constexpr size_t WS_W1T = 2 * MiB;
constexpr size_t WS_WAT = 20 * MiB, WS_WBT = 22 * MiB, WS_WOT = 24 * MiB;
constexpr size_t WS_XN = 26 * MiB;
constexpr size_t WS_Q = 92 * MiB;
constexpr size_t WS_K = 158 * MiB;
constexpr size_t WS_V = WS_K + (size_t)MT * KVW * 2;
constexpr size_t WS_GA = 191 * MiB;
constexpr size_t WS_PS = 257 * MiB;
constexpr size_t WS_END = 464 * MiB;
static_assert(WS_W1T + (size_t)N1 * DM * 2 <= WS_WAT && WS_V + (size_t)MT * KVW * 2 <= WS_GA && WS_PS + (size_t)MT * SHW * 2 <= WS_END, "ws map");

constexpr int CW_BAR = 4096;

constexpr int RING_BYTES = 131072;
constexpr int LDSCTL_OFF = RING_BYTES, MISC_OFF = LDSCTL_OFF + 320, SMALL_OFF = LDSCTL_OFF + 1024;
constexpr int LDS_BYTES = 163840;
constexpr int NWAVES = 8, NTHR = 512;

#define GAS __attribute__((address_space(1)))
#define LAS __attribute__((address_space(3)))
typedef unsigned short bf16;
typedef unsigned v4u __attribute__((ext_vector_type(4)));
typedef unsigned v2u __attribute__((ext_vector_type(2)));
typedef float f32x4 __attribute__((ext_vector_type(4)));
typedef float f32x16 __attribute__((ext_vector_type(16)));
typedef short bf16x8 __attribute__((ext_vector_type(8)));
typedef GAS unsigned gu32;
#define RLX_AGENT __ATOMIC_RELAXED, __HIP_MEMORY_SCOPE_AGENT
#define LDS_WAIT() asm volatile("s_waitcnt lgkmcnt(0)" ::: "memory")
#define VM_WAIT() asm volatile("s_waitcnt vmcnt(0)" ::: "memory")
__device__ __forceinline__ unsigned f2bf(float f) { unsigned u = __builtin_bit_cast(unsigned, f); return (u + 0x7fffu + ((u >> 16) & 1u)) >> 16; }
__device__ __forceinline__ unsigned pk2(float lo, float hi) { return f2bf(lo) | (f2bf(hi) << 16); }
__device__ __forceinline__ float bflo(unsigned u) { return __builtin_bit_cast(float, u << 16); }
__device__ __forceinline__ float bfhi(unsigned u) { return __builtin_bit_cast(float, u & 0xffff0000u); }
__device__ __forceinline__ float sigmoidf_(float x) { return __builtin_amdgcn_rcpf(1.0f + __expf(-x)); }

#define XB_TMO      128
#define XB_XCNT(j)  (256  + 64 * (j))
#define XB_XSUB(j)  (1280 + 64 * (j))
#define XB_XGEN(j)  (2304 + 64 * (j))
#define XB_TOP      3328
#define XB_TOPGEN   3392
#define XCD_BAR_WORDS 3456
#define XB_SPIN_CAP (1u << 23)
__device__ __forceinline__ unsigned xb_ld(unsigned* p)              { return __hip_atomic_load(p, __ATOMIC_RELAXED, __HIP_MEMORY_SCOPE_AGENT); }
__device__ __forceinline__ unsigned xb_add(unsigned* p, unsigned v) { return __hip_atomic_fetch_add(p, v, __ATOMIC_RELAXED, __HIP_MEMORY_SCOPE_AGENT); }
__device__ __forceinline__ unsigned xb_xcc_id() { return (unsigned)__builtin_amdgcn_s_getreg((3 << 11) | 20) & 0xFu; }
#define XB_SPIN(cond, bar) do { unsigned _sp = 0; while (cond) { __builtin_amdgcn_s_sleep(1); \
    if ((++_sp & 255u) == 0u) { if (xb_ld(&(bar)[XB_TMO])) break; if (_sp > XB_SPIN_CAP) { atomicAdd(&(bar)[XB_TMO], 1u); break; } } } } while (0)
struct XcdBarrier { unsigned* bar; unsigned x; volatile LAS unsigned* st; };
__device__ __forceinline__ XcdBarrier xcd_barrier_post(unsigned* bar, volatile LAS unsigned* st) {
    XcdBarrier b; b.bar = bar; b.x = xb_xcc_id(); b.st = st;
    if (threadIdx.x == 0) (void)xb_add(&bar[XB_XCNT(b.x)], 1u);
    return b;
}
__device__ __forceinline__ void xcd_barrier_complete(unsigned* bar, unsigned x, unsigned& nloc, unsigned& nx) {
    const unsigned G = gridDim.x * gridDim.y * gridDim.z;
    unsigned sum, cnt, mine, sp = 0u;
    for (;;) {
        sum = 0u; cnt = 0u; mine = 0u;
#pragma unroll
        for (unsigned j = 0; j < 16; ++j) { const unsigned c = xb_ld(&bar[XB_XCNT(j)]); sum += c; cnt += (c > 0u) ? 1u : 0u; mine = (j == x) ? c : mine; }
        if (sum == G) break;
        __builtin_amdgcn_s_sleep(1);
        if ((++sp & 255u) == 0u) { if (xb_ld(&bar[XB_TMO])) break; if (sp > XB_SPIN_CAP) { atomicAdd(&bar[XB_TMO], 1u); break; } }
    }
    nloc = mine > 0u ? mine : 1u; nx = cnt > 0u ? cnt : 1u;
}
__device__ __forceinline__ void xcd_barrier(const XcdBarrier& b) {
    asm volatile("s_waitcnt vmcnt(0)" ::: "memory");
    __syncthreads();
    if (threadIdx.x == 0) {
        unsigned* bar = b.bar;
        __builtin_amdgcn_s_waitcnt(0);
        unsigned nloc = b.st[0], nx = b.st[1];
        if (nloc == 0u) { xcd_barrier_complete(bar, b.x, nloc, nx); b.st[0] = nloc; b.st[1] = nx; }
        const unsigned old = xb_add(&bar[XB_XSUB(b.x)], 1u);
        const unsigned gen = old / nloc;
        if (old + 1u == (gen + 1u) * nloc) {
            __builtin_amdgcn_fence(__ATOMIC_RELEASE, "agent");
            asm volatile("s_waitcnt vmcnt(0)" ::: "memory");
            const unsigned og = xb_add(&bar[XB_TOP], 1u);
            const unsigned tg = og / nx;
            if (og + 1u == (tg + 1u) * nx) xb_add(&bar[XB_TOPGEN], 1u);
            else XB_SPIN(xb_ld(&bar[XB_TOPGEN]) == tg, bar);
            __builtin_amdgcn_fence(__ATOMIC_ACQUIRE, "agent");
            xb_add(&bar[XB_XGEN(b.x)], 1u);
            asm volatile("s_waitcnt vmcnt(0)" ::: "memory");
        } else {
            XB_SPIN(xb_ld(&bar[XB_XGEN(b.x)]) == gen, bar);
            __builtin_amdgcn_fence(__ATOMIC_ACQUIRE, "agent");
            asm volatile("s_waitcnt vmcnt(0)" ::: "memory");
        }
    }
    __syncthreads();
}

struct Args { const float* in[24]; float* out; unsigned char* ws; int ph_lo, ph_hi; };
static_assert(sizeof(Args) == 24 * 8 + 8 + 8 + 8, "no padding");
struct Frame {
    LAS unsigned char* lds;
    int wave, G, vcu;
    float* out; unsigned char* ws;
};
__device__ __forceinline__ int lane_id() { return (int)__builtin_amdgcn_mbcnt_hi(~0u, __builtin_amdgcn_mbcnt_lo(~0u, 0u)); }
enum { I_XP = 0, I_XS, I_CK, I_CV, I_SWKV, I_SSHIFT, I_RELB, I_NORMG, I_WIN, I_SINK, I_MU, I_W0, I_W2, I_A0, I_A2, I_KK, I_KA, I_RK, I_LNG, I_LNB, I_WOA, I_WOB, I_WO, I_FING };

__device__ __forceinline__ float wave_sum(float v) {
#pragma unroll
    for (int o = 1; o < 64; o <<= 1) v += __shfl_xor(v, o);
    return v;
}

__device__ __forceinline__ void p0_transpose_item(const float* W, int ldw, int srccol0, int K, bf16* WT, int dstrow0, LAS float* scr, int kb, int lane) {
    const int k0 = 64 * kb;
    if (srccol0 >= 0) {
#pragma unroll 8
        for (int i = 0; i < 32; ++i) { const int kk = 2 * i + (lane >> 5); scr[kk * 33 + (lane & 31)] = W[(size_t)(k0 + kk) * ldw + srccol0 + (lane & 31)]; }
    }
    LDS_WAIT(); asm volatile("" ::: "memory");
    const int c = lane & 7;
#pragma unroll
    for (int j = 0; j < 4; ++j) { const int n = (lane >> 3) + 8 * j; const LAS float* s = scr + (8 * c) * 33 + n;
        v4u o = (v4u){0u, 0u, 0u, 0u};
        if (srccol0 >= 0) { o.x = pk2(s[0 * 33], s[1 * 33]); o.y = pk2(s[2 * 33], s[3 * 33]); o.z = pk2(s[4 * 33], s[5 * 33]); o.w = pk2(s[6 * 33], s[7 * 33]); }
        *(GAS v4u*)(WT + (size_t)(dstrow0 + n) * K + k0 + 8 * c) = o; }
    LDS_WAIT(); asm volatile("" ::: "memory");
}
__device__ __forceinline__ void rms_row_to_bf16(const float* xrow, const float* g, bf16* orow, int lane) {
    const GAS f32x4* xr = (const GAS f32x4*)xrow + lane; const GAS f32x4* gr = (const GAS f32x4*)g + lane;
    f32x4 v[4]; float s = 0.f;
#pragma unroll
    for (int j = 0; j < 4; ++j) { v[j] = xr[64 * j]; s += (v[j].x * v[j].x + v[j].y * v[j].y) + (v[j].z * v[j].z + v[j].w * v[j].w); }
    const float sc = 1.0f / sqrtf(wave_sum(s) * (1.f / DM) + NORM_EPS);
    GAS v2u* o8 = (GAS v2u*)orow + lane;
#pragma unroll
    for (int j = 0; j < 4; ++j) { const f32x4 gv = gr[64 * j]; v2u o; o.x = pk2(v[j].x * sc * gv.x, v[j].y * sc * gv.y); o.y = pk2(v[j].z * sc * gv.z, v[j].w * sc * gv.w); o8[64 * j] = o; }
}
__device__ __forceinline__ void p0_prologue(const Frame& F, const Args& AR) {
    const int lane = lane_id();
    LAS float* scr = (LAS float*)(F.lds + F.wave * 16384);
    const int gw = F.vcu * NWAVES + F.wave, NGW = F.G * NWAVES;
    constexpr int I_1 = 16 * (N1 / 32), I_S = 16 * 32, NITEMS = I_1 + 3 * I_S;
    bf16* W1T = (bf16*)(F.ws + WS_W1T);
    for (int it = gw; it < NITEMS; it += NGW) {
        int r = it;
        if (r < I_1) { const int kb = r / (N1 / 32), nb = r % (N1 / 32), n0 = 32 * nb;
            const int src = n0 < 5760 ? n0 : (n0 < 5888 ? -1 : n0 - 128);
            p0_transpose_item(AR.in[I_WIN], INC, src, DM, W1T, n0, scr, kb, lane); continue; }
        r -= I_1;
        const int which = r / I_S; r -= which * I_S;
        const float* W = which == 0 ? AR.in[I_WOA] : (which == 1 ? AR.in[I_WOB] : AR.in[I_WO]);
        bf16* WT = (bf16*)(F.ws + (which == 0 ? WS_WAT : (which == 1 ? WS_WBT : WS_WOT)));
        p0_transpose_item(W, DM, 32 * (r % 32), DM, WT, 32 * (r % 32), scr, r / 32, lane);
    }
    { bf16* SR = (bf16*)(F.ws + WS_SROW); const float* ss = AR.in[I_SSHIFT];
      for (int i = gw * 64 + lane; i < DECB * SHW / 4; i += NGW * 64) { const f32x4 v = *(const f32x4*)(ss + (size_t)i * 4); v2u w; w.x = pk2(v.x, v.y); w.y = pk2(v.z, v.w); *(v2u*)(SR + (size_t)i * 4) = w; } }
    bf16* XN = (bf16*)(F.ws + WS_XN);
    for (int m = gw; m < MT; m += NGW) {
        const float* xr = m < MP ? AR.in[I_XP] + (size_t)m * DM : AR.in[I_XS] + (size_t)(m - MP) * DM;
        rms_row_to_bf16(xr, AR.in[I_NORMG], XN + (size_t)m * DM, lane);
    }
}

struct EpiG1 {
    static constexpr bool PERM = true, AFTER_DRAIN = false;
    int part; unsigned char* ws; float* out;
    __device__ __forceinline__ void operator()(const f32x4 (&acc)[2][2][4][2], const pg8::Unit& u, int wr, int wc, int fr, int fq) const {
        bf16* dst; int ld, act = 0, valid = 256, side = 0;
        const int pn = u.pn;
        if (part == 0) {
            if (pn < 4) { dst = (bf16*)(ws + WS_Q) + pn * 256; ld = DM; }
            else if (pn == 4) { dst = (bf16*)(ws + WS_K); ld = KVW; side = 1; }
            else if (pn == 5) { dst = (bf16*)(ws + WS_V); ld = KVW; side = 2; }
            else { dst = (bf16*)(ws + WS_GA) + (pn - 6) * 256; ld = DM; act = 1; }
        } else {
            if (pn < 13) { dst = (bf16*)(ws + WS_PS) + pn * 256; ld = SHW; side = 3; if (pn == 12) valid = 128; }
            else if (pn < 17) { dst = (bf16*)(ws + WS_GA) + (pn - 13) * 256; ld = DM; act = 1; }
            else if (pn < 21) { dst = (bf16*)out + (pn - 17) * 256; ld = DM; act = 2; }
            else { dst = (bf16*)out + (size_t)MT * DM + (pn - 21) * 256; ld = DM; act = 2; }
        }
        const int rt0 = wr * 64 + fr, cit0 = wc * 32 + 8 * fq;
#pragma unroll
        for (int ai = 0; ai < 2; ++ai)
#pragma unroll
            for (int m = 0; m < 4; ++m) { bf16* rowp = dst + (size_t)(u.pm * 256 + rt0 + ai * 128 + m * 16) * ld + cit0;
#pragma unroll
                for (int bj = 0; bj < 2; ++bj) { if (bj * 128 >= valid) continue;
                    f32x4 v0 = acc[ai][bj][m][0], v1 = acc[ai][bj][m][1];
                    if (act) {
#pragma unroll
                        for (int e = 0; e < 4; ++e) { const float s0 = sigmoidf_(v0[e]), s1 = sigmoidf_(v1[e]); v0[e] = act == 1 ? v0[e] * s0 : s0; v1[e] = act == 1 ? v1[e] * s1 : s1; }
                    }
                    pg8::u32x4 w; w.x = pg8::cvt_pk_bf16(v0[0], v0[1]); w.y = pg8::cvt_pk_bf16(v0[2], v0[3]); w.z = pg8::cvt_pk_bf16(v1[0], v1[1]); w.w = pg8::cvt_pk_bf16(v1[2], v1[3]);
                    *(pg8::u32x4*)(rowp + bj * 128) = w; } }
        int r0 = rt0, c0 = cit0;
        if (side) asm volatile("" : "+v"(r0), "+v"(c0));
        if (side == 1 || side == 2) {
            if (u.pm < 128) {
                if ((u.pm & 15) == 15) { float* base = out + (side == 1 ? O_PKW : O_PVW) + (size_t)(u.pm >> 4) * WIN * KVW;
#pragma unroll
                    for (int m = 0; m < 4; ++m) { float* rp = base + (size_t)(r0 + m * 16) * KVW + c0;
#pragma unroll
                        for (int bj = 0; bj < 2; ++bj)
#pragma unroll
                            for (int n = 0; n < 2; ++n) *(f32x4*)(rp + bj * 128 + 4 * n) = acc[1][bj][m][n]; } }
            } else { float* base = out + (side == 1 ? O_SKW : O_SVW);
#pragma unroll
                for (int ai = 0; ai < 2; ++ai)
#pragma unroll
                    for (int m = 0; m < 4; ++m) { const int rs = (u.pm - 128) * 256 + r0 + ai * 128 + m * 16; float* rp = base + ((size_t)(rs >> 3) * WIN + 120 + (rs & 7)) * KVW + c0;
#pragma unroll
                        for (int bj = 0; bj < 2; ++bj)
#pragma unroll
                            for (int n = 0; n < 2; ++n) *(f32x4*)(rp + bj * 128 + 4 * n) = acc[ai][bj][m][n]; }
            }
        } else if (side == 3) {
            if (u.pm < 128) {
                if ((u.pm & 15) == 15 && wr == 1 && fr == 15) { float* rp = out + O_PSH + (size_t)(u.pm >> 4) * SHW + pn * 256 + c0;
#pragma unroll
                    for (int bj = 0; bj < 2; ++bj) { if (bj * 128 >= valid) continue;
#pragma unroll
                        for (int n = 0; n < 2; ++n) *(f32x4*)(rp + bj * 128 + 4 * n) = acc[1][bj][3][n]; } }
            } else if ((fr & 7) == 7) {
#pragma unroll
                for (int ai = 0; ai < 2; ++ai)
#pragma unroll
                    for (int m = 0; m < 4; ++m) { const int rs = (u.pm - 128) * 256 + r0 + ai * 128 + m * 16; float* rp = out + O_SSH + (size_t)(rs >> 3) * SHW + pn * 256 + c0;
#pragma unroll
                        for (int bj = 0; bj < 2; ++bj) { if (bj * 128 >= valid) continue;
#pragma unroll
                            for (int n = 0; n < 2; ++n) *(f32x4*)(rp + bj * 128 + 4 * n) = acc[ai][bj][m][n]; } }
            }
        }
    }
};
struct EpiGate {
    static constexpr bool PERM = true, AFTER_DRAIN = false;
    int mode; const bf16* gate; const bf16* tin; bf16* dst;
    __device__ __forceinline__ void operator()(const f32x4 (&acc)[2][2][4][2], const pg8::Unit& u, int wr, int wc, int fr, int fq) const {
        const int rt0 = u.pm * 256 + wr * 64 + fr, c0 = u.pn * 256 + wc * 32 + 8 * fq;
#pragma unroll
        for (int ai = 0; ai < 2; ++ai)
#pragma unroll
            for (int m = 0; m < 4; ++m) { const size_t ro = (size_t)(rt0 + ai * 128 + m * 16) * DM + c0;
#pragma unroll
                for (int bj = 0; bj < 2; ++bj) {
                    const v4u g = *(const v4u*)(gate + ro + bj * 128);
                    f32x4 v0 = acc[ai][bj][m][0], v1 = acc[ai][bj][m][1];
                    v0[0] *= bflo(g.x); v0[1] *= bfhi(g.x); v0[2] *= bflo(g.y); v0[3] *= bfhi(g.y); v1[0] *= bflo(g.z); v1[1] *= bfhi(g.z); v1[2] *= bflo(g.w); v1[3] *= bfhi(g.w);
                    if (mode == 1) { const v4u t = *(const v4u*)(tin + ro + bj * 128);
                        v0[0] += bflo(t.x); v0[1] += bfhi(t.x); v0[2] += bflo(t.y); v0[3] += bfhi(t.y); v1[0] += bflo(t.z); v1[1] += bfhi(t.z); v1[2] += bflo(t.w); v1[3] += bfhi(t.w); }
                    pg8::u32x4 w; w.x = pg8::cvt_pk_bf16(v0[0], v0[1]); w.y = pg8::cvt_pk_bf16(v0[2], v0[3]); w.z = pg8::cvt_pk_bf16(v1[0], v1[1]); w.w = pg8::cvt_pk_bf16(v1[2], v1[3]);
                    *(pg8::u32x4*)(dst + ro + bj * 128) = w; } }
    }
};
struct EpiOut {
    static constexpr bool PERM = false, AFTER_DRAIN = false;
    const float* xp; const float* xs; float* out; float* ss;
    __device__ __forceinline__ void operator()(const f32x4 (&acc)[2][2][4][2], const pg8::Unit& u, int wr, int wc, int fr, int fq) const {
        const int rt0 = u.pm * 256 + wr * 64 + fr, c0 = u.pn * 256 + wc * 32 + 4 * fq;
#pragma unroll
        for (int ai = 0; ai < 2; ++ai)
#pragma unroll
            for (int m = 0; m < 4; ++m) { const int row = rt0 + ai * 128 + m * 16;
                const float* xr = (row < MP ? xp + (size_t)row * DM : xs + (size_t)(row - MP) * DM) + c0; float* orow = out + (size_t)row * DM + c0; float s = 0.f;
#pragma unroll
                for (int bj = 0; bj < 2; ++bj)
#pragma unroll
                    for (int n = 0; n < 2; ++n) { const f32x4 xv = *(const f32x4*)(xr + bj * 128 + n * 16); const f32x4 o = xv + acc[ai][bj][m][n];
                        *(f32x4*)(orow + bj * 128 + n * 16) = o; s += (o[0] * o[0] + o[1] * o[1]) + (o[2] * o[2] + o[3] * o[3]); }
                s += __shfl_xor(s, 16); s += __shfl_xor(s, 32);
                if (fq == 0) atomicAdd(ss + row, s); }
    }
};

__device__ const unsigned char T5B[132] = {0, 1, 2, 3, 4, 5, 6, 7, 8, 9, 10, 11, 12, 13, 14, 15, 16, 16, 16, 17, 17, 18, 18, 18, 19, 19, 19, 20, 20, 20, 20, 21, 21, 21, 21, 22, 22, 22, 22, 22, 23, 23, 23, 23, 23, 23, 24, 24, 24, 24, 24, 24, 25, 25, 25, 25, 25, 25, 25, 26, 26, 26, 26, 26, 26, 26, 26, 27, 27, 27, 27, 27, 27, 27, 27, 27, 27, 28, 28, 28, 28, 28, 28, 28, 28, 28, 28, 29, 29, 29, 29, 29, 29, 29, 29, 29, 29, 29, 29, 30, 30, 30, 30, 30, 30, 30, 30, 30, 30, 30, 30, 30, 30, 31, 31, 31, 31, 31, 31, 31, 31, 31, 31, 31, 31, 31, 31, 31, 31, 31, 31, 31};
constexpr int AT_KP = 144, AT_VP = 520, AT_VT_OFF = 256 * AT_KP, AT_BT_OFF = AT_VT_OFF + 64 * AT_VP;
__device__ __forceinline__ int crow(int r, int hi) { return (r & 3) + 8 * (r >> 2) + 4 * hi; }

template <int MODE>
__device__ __forceinline__ void attn_task(const Frame& F, const Args& AR, bf16* OB_, int b, int kvh, int n, int g_, int i) {
    LAS unsigned char* KL = F.lds; LAS unsigned char* VT = F.lds + AT_VT_OFF; LAS float* BT = (LAS float*)(F.lds + AT_BT_OFF);
    const int lane = lane_id(), q = lane & 31, hi = lane >> 5;
    int g, mq, dq;
    if (MODE == 0) { g = g_; mq = b * SEQ + n * 128 + 32 * i + q; dq = 128 + q; }
    else { g = q >> 3; mq = MP + b * DECS + (q & 7); dq = 128 + (q & 7); }
    const int h = kvh * 4 + g;
    bf16* QO = (bf16*)(F.ws + WS_Q); const bf16* GA = (const bf16*)(F.ws + WS_GA);
    bf16x8 qf[4];
    { const bf16* qp = QO + (size_t)mq * DM + h * HD + 8 * hi;
#pragma unroll
      for (int s = 0; s < 4; ++s) qf[s] = *(const bf16x8*)(qp + 16 * s); }
    const int kt0 = MODE == 0 ? i : 0;
    f32x16 sc[5];
    const float sink = AR.in[I_SINK][h];
    const LAS float* bt = BT + g * 192 + 32 + dq - 4 * hi;
    float mx = sink;
#pragma unroll
    for (int t = 0; t < 5; ++t) { const LAS unsigned char* kp = KL + (32 * (kt0 + t) + q) * AT_KP + 16 * hi; f32x16 a = {0.f, 0.f, 0.f, 0.f, 0.f, 0.f, 0.f, 0.f, 0.f, 0.f, 0.f, 0.f, 0.f, 0.f, 0.f, 0.f};
#pragma unroll
        for (int s = 0; s < 4; ++s) { const bf16x8 kf = *(const LAS bf16x8*)(kp + 32 * s); a = __builtin_amdgcn_mfma_f32_32x32x16_bf16(kf, qf[s], a, 0, 0, 0); }
        const bool dead = (MODE == 0) && n == 0 && (i + t) < 4;
#pragma unroll
        for (int r = 0; r < 16; ++r) { const int kb0 = 32 * t + (r & 3) + 8 * (r >> 2);
            float sv = a[r] * 0.125f + bt[-kb0]; sv = dead ? -INFINITY : sv; a[r] = sv; mx = fmaxf(mx, sv); }
        sc[t] = a;
        __builtin_amdgcn_sched_barrier(0); }
    mx = fmaxf(mx, __shfl_xor(mx, 32));
    float sum = 0.f;
#pragma unroll
    for (int t = 0; t < 5; ++t)
#pragma unroll
        for (int r = 0; r < 16; ++r) { const float p = __expf(sc[t][r] - mx); sum += p; sc[t][r] = p; }
    sum += __shfl_xor(sum, 32); sum += __expf(sink - mx);
    const float inv = 1.0f / sum;
    f32x16 o[2];
#pragma unroll
    for (int d = 0; d < 2; ++d) o[d] = (f32x16){0.f, 0.f, 0.f, 0.f, 0.f, 0.f, 0.f, 0.f, 0.f, 0.f, 0.f, 0.f, 0.f, 0.f, 0.f, 0.f};
#pragma unroll
    for (int t = 0; t < 5; ++t)
#pragma unroll
        for (int s2 = 0; s2 < 2; ++s2) {
            v4u pw; pw.x = pk2(sc[t][8 * s2 + 0], sc[t][8 * s2 + 1]); pw.y = pk2(sc[t][8 * s2 + 2], sc[t][8 * s2 + 3]); pw.z = pk2(sc[t][8 * s2 + 4], sc[t][8 * s2 + 5]); pw.w = pk2(sc[t][8 * s2 + 6], sc[t][8 * s2 + 7]);
            const bf16x8 pb = __builtin_bit_cast(bf16x8, pw);
#pragma unroll
            for (int d = 0; d < 2; ++d) { const LAS unsigned char* vp = VT + (32 * d + q) * AT_VP + (32 * (kt0 + t) + 16 * s2 + 4 * hi) * 2;
                const v2u lo = *(const LAS v2u*)vp, hi2 = *(const LAS v2u*)(vp + 16);
                v4u aw; aw.x = lo.x; aw.y = lo.y; aw.z = hi2.x; aw.w = hi2.y;
                o[d] = __builtin_amdgcn_mfma_f32_32x32x16_bf16(__builtin_bit_cast(bf16x8, aw), pb, o[d], 0, 0, 0); }
            __builtin_amdgcn_sched_barrier(0); }
    bf16* op = OB_ + (size_t)mq * DM + h * HD; const bf16* gp = GA + (size_t)mq * DM + h * HD;
#pragma unroll
    for (int d = 0; d < 2; ++d)
#pragma unroll
        for (int rq = 0; rq < 4; ++rq) { const int dv0 = 32 * d + 8 * rq + 4 * hi; const v2u gv = *(const v2u*)(gp + dv0);
            v2u w; w.x = pk2(o[d][4 * rq + 0] * inv * bflo(gv.x), o[d][4 * rq + 1] * inv * bfhi(gv.x)); w.y = pk2(o[d][4 * rq + 2] * inv * bflo(gv.y), o[d][4 * rq + 3] * inv * bfhi(gv.y));
            *(v2u*)(op + dv0) = w; }
}

__device__ __forceinline__ void attn_unit(const Frame& F, const Args& AR, int unit, bf16* OB_) {
    LAS unsigned char* KL = F.lds; LAS unsigned char* VT = F.lds + AT_VT_OFF; LAS float* BT = (LAS float*)(F.lds + AT_BT_OFF);
    const bf16* Kb = (const bf16*)(F.ws + WS_K); const bf16* Vb = (const bf16*)(F.ws + WS_V);
    const int tid = F.wave * 64 + lane_id();
    __syncthreads();
    int b, kvh, n = 0;
    const bool sample = unit >= 1024;
    if (!sample) {
        kvh = unit & 3; n = (unit >> 2) & 31; b = unit >> 7;
        const int t0 = (n - 1) * 128;
#pragma unroll
        for (int it = 0; it < 4; ++it) { const int c = it * NTHR + tid, key = c >> 3, part = c & 7, tok = t0 + key; v4u val = (v4u){0u, 0u, 0u, 0u};
            if (tok >= 0) val = *(const v4u*)(Kb + (size_t)(b * SEQ + tok) * KVW + kvh * HD + part * 8);
            *(LAS v4u*)(KL + key * AT_KP + part * 16) = val; }
#pragma unroll
        for (int it = 0; it < 4; ++it) { const int c = it * NTHR + tid, key = c & 255, part = c >> 8, tok = t0 + key; v4u val = (v4u){0u, 0u, 0u, 0u};
            if (tok >= 0) val = *(const v4u*)(Vb + (size_t)(b * SEQ + tok) * KVW + kvh * HD + part * 8);
            LAS bf16* vt = (LAS bf16*)(VT + (part * 8) * AT_VP + key * 2);
            vt[0 * (AT_VP / 2)] = (bf16)val.x; vt[1 * (AT_VP / 2)] = (bf16)(val.x >> 16); vt[2 * (AT_VP / 2)] = (bf16)val.y; vt[3 * (AT_VP / 2)] = (bf16)(val.y >> 16);
            vt[4 * (AT_VP / 2)] = (bf16)val.z; vt[5 * (AT_VP / 2)] = (bf16)(val.z >> 16); vt[6 * (AT_VP / 2)] = (bf16)val.w; vt[7 * (AT_VP / 2)] = (bf16)(val.w >> 16); }
    } else {
        const int su = unit - 1024; kvh = su & 3; b = su >> 2;
        for (int c = tid; c < 160 * 8; c += NTHR) {
            { const int key = c >> 3, part = c & 7; v4u val = (v4u){0u, 0u, 0u, 0u};
              if (key < 128) { const float* src = AR.in[I_CK] + ((size_t)(b * WIN + key) * NKV + kvh) * HD + part * 8; const f32x4 a = *(const f32x4*)src, bb = *(const f32x4*)(src + 4);
                  val.x = pk2(a.x, a.y); val.y = pk2(a.z, a.w); val.z = pk2(bb.x, bb.y); val.w = pk2(bb.z, bb.w);
                  if (key >= 8) { float* d = F.out + O_SKW + ((size_t)(b * WIN + key - 8) * NKV + kvh) * HD + part * 8; *(f32x4*)d = a; *(f32x4*)(d + 4) = bb; } }
              else if (key < 136) val = *(const v4u*)(Kb + (size_t)(MP + b * DECS + key - 128) * KVW + kvh * HD + part * 8);
              *(LAS v4u*)(KL + key * AT_KP + part * 16) = val; }
            { const int key = c % 160, part = c / 160; v4u val = (v4u){0u, 0u, 0u, 0u};
              if (key < 128) { const float* src = AR.in[I_CV] + ((size_t)(b * WIN + key) * NKV + kvh) * HD + part * 8; const f32x4 a = *(const f32x4*)src, bb = *(const f32x4*)(src + 4);
                  val.x = pk2(a.x, a.y); val.y = pk2(a.z, a.w); val.z = pk2(bb.x, bb.y); val.w = pk2(bb.z, bb.w);
                  if (key >= 8) { float* d = F.out + O_SVW + ((size_t)(b * WIN + key - 8) * NKV + kvh) * HD + part * 8; *(f32x4*)d = a; *(f32x4*)(d + 4) = bb; } }
              else if (key < 136) val = *(const v4u*)(Vb + (size_t)(MP + b * DECS + key - 128) * KVW + kvh * HD + part * 8);
              LAS bf16* vt = (LAS bf16*)(VT + (part * 8) * AT_VP + key * 2);
              vt[0 * (AT_VP / 2)] = (bf16)val.x; vt[1 * (AT_VP / 2)] = (bf16)(val.x >> 16); vt[2 * (AT_VP / 2)] = (bf16)val.y; vt[3 * (AT_VP / 2)] = (bf16)(val.y >> 16);
              vt[4 * (AT_VP / 2)] = (bf16)val.z; vt[5 * (AT_VP / 2)] = (bf16)(val.z >> 16); vt[6 * (AT_VP / 2)] = (bf16)val.w; vt[7 * (AT_VP / 2)] = (bf16)(val.w >> 16); }
        }
    }
    for (int idx = tid; idx < 4 * 192; idx += NTHR) { const int g = idx / 192, d = idx - g * 192 - 32; BT[idx] = (d >= 0 && d <= 128) ? AR.in[I_RELB][(int)T5B[d] * NH + kvh * 4 + g] : -INFINITY; }
    __syncthreads();
    if (!sample) { for (int task = F.wave; task < 16; task += NWAVES) attn_task<0>(F, AR, OB_, b, kvh, n, task >> 2, task & 3); }
    else if (F.wave == 0) attn_task<1>(F, AR, OB_, b, kvh, 0, 0, 0);
}

namespace s3 {
constexpr int P68 = 136, P36 = 72;
constexpr int W2T = 0, A2T = W2T + 64 * P68, PAR = A2T + 64 * P68, YT = PAR + 12 * 256, SCR = YT + 32 * 272;
constexpr int RM0 = 0, RM1 = 2304, IMGV = 4608, IMG2 = 9216, SCRW = 13824;
constexpr int END = SCR + 7 * SCRW;
static_assert(END <= RING_BYTES && (YT % 16) == 0 && (SCR % 16) == 0, "scan LDS map");
constexpr int R_R2 = 0, R_Y02 = 4096, R_G = 8192, R_H = 16384, R_V = 24576, R_GC = 28672, R_RK = 28928, R_SIZE = 29184, RING = 14;
constexpr size_t RING_BYTES_WG = (size_t)RING * R_SIZE;
static_assert(128 * RING_BYTES_WG <= 66 * MiB && 64 * RING_BYTES_WG <= 33 * MiB, "record rings: prompt workgroups in the XN region, sample workgroups in the K/V region");
}
typedef float f32x2_t __attribute__((ext_vector_type(2))); typedef __bf16 bf16x2_t __attribute__((ext_vector_type(2)));
__device__ __forceinline__ unsigned cvtpk(float lo, float hi) { f32x2_t v = {lo, hi}; bf16x2_t b = __builtin_convertvector(v, bf16x2_t); return __builtin_bit_cast(unsigned, b); }
__device__ __forceinline__ bf16x8 frag_nat(LAS const unsigned char* base, int pitch, int row, int col0) {
    LAS const unsigned char* p = base + row * pitch + col0 * 2; const v2u a = *(LAS const v2u*)p, b = *(LAS const v2u*)(p + 8);
    v4u w; w.x = a.x; w.y = a.y; w.z = b.x; w.w = b.y; return __builtin_bit_cast(bf16x8, w); }
__device__ __forceinline__ bf16x8 frag_perm(LAS const unsigned char* base, int pitch, int row, int c0, int hi) {
    LAS const unsigned char* p = base + row * pitch + (c0 + 4 * hi) * 2; const v2u a = *(LAS const v2u*)p, b = *(LAS const v2u*)(p + 16);
    v4u w; w.x = a.x; w.y = a.y; w.z = b.x; w.w = b.y; return __builtin_bit_cast(bf16x8, w); }
__device__ __forceinline__ bf16x8 pk8(const f32x16& x, int s) {
    v4u w; w.x = cvtpk(x[8 * s + 0], x[8 * s + 1]); w.y = cvtpk(x[8 * s + 2], x[8 * s + 3]); w.z = cvtpk(x[8 * s + 4], x[8 * s + 5]); w.w = cvtpk(x[8 * s + 6], x[8 * s + 7]); return __builtin_bit_cast(bf16x8, w); }
__device__ __forceinline__ bf16x8 pk8f(const float* x) { v4u w; w.x = cvtpk(x[0], x[1]); w.y = cvtpk(x[2], x[3]); w.z = cvtpk(x[4], x[5]); w.w = cvtpk(x[6], x[7]); return __builtin_bit_cast(bf16x8, w); }
__device__ __forceinline__ void store_rm(LAS unsigned char* base, int pitch, const f32x16& x, int q, int hi) {
#pragma unroll
    for (int r = 0; r < 16; r += 2) { const unsigned w = cvtpk(x[r], x[r + 1]);
        *(LAS bf16*)(base + crow(r, hi) * pitch + 2 * q) = (bf16)w; *(LAS bf16*)(base + crow(r + 1, hi) * pitch + 2 * q) = (bf16)(w >> 16); }
}
__device__ __forceinline__ void store16bf(unsigned char* p, const f32x16& x) {
    v4u a, b; a.x = cvtpk(x[0], x[1]); a.y = cvtpk(x[2], x[3]); a.z = cvtpk(x[4], x[5]); a.w = cvtpk(x[6], x[7]); b.x = cvtpk(x[8], x[9]); b.y = cvtpk(x[10], x[11]); b.z = cvtpk(x[12], x[13]); b.w = cvtpk(x[14], x[15]);
    *(v4u*)p = a; *(v4u*)(p + 16) = b; }
__device__ __forceinline__ f32x16 load16bf(const unsigned char* p) {
    const v4u a = *(const v4u*)p, b = *(const v4u*)(p + 16);
    return (f32x16){bflo(a.x), bfhi(a.x), bflo(a.y), bfhi(a.y), bflo(a.z), bfhi(a.z), bflo(a.w), bfhi(a.w), bflo(b.x), bfhi(b.x), bflo(b.y), bfhi(b.y), bflo(b.z), bfhi(b.z), bflo(b.w), bfhi(b.w)}; }
#define MFMA32(a, b, c) __builtin_amdgcn_mfma_f32_32x32x16_bf16((a), (b), (c), 0, 0, 0)
#define ZERO16 ((f32x16){0.f, 0.f, 0.f, 0.f, 0.f, 0.f, 0.f, 0.f, 0.f, 0.f, 0.f, 0.f, 0.f, 0.f, 0.f, 0.f})
#define DPPV(x, ctrl, rowmask) __builtin_bit_cast(float, __builtin_amdgcn_update_dpp(0, __builtin_bit_cast(int, (x)), (ctrl), (rowmask), 0xF, true))
__device__ __forceinline__ float tanh_fast(float x) { return 1.0f - 2.0f * __builtin_amdgcn_rcpf(__expf(2.0f * x) + 1.0f); }
__device__ __forceinline__ float xhalf_sum(float x) { return x + __shfl_xor(x, 32); }

__device__ __forceinline__ f32x4 s1_z4(const bf16* P, const bf16* PP, int col, f32x4 mu, bool act) {
    const v2u cu = *(const v2u*)(P + col), pu = *(const v2u*)(PP + col);
    const f32x4 cur = {bflo(cu.x), bfhi(cu.x), bflo(cu.y), bfhi(cu.y)}, prv = {bflo(pu.x), bfhi(pu.x), bflo(pu.y), bfhi(pu.y)};
    f32x4 z = cur + (prv - cur) * mu;
    if (!act) z = (f32x4){0.f, 0.f, 0.f, 0.f};
    return z;
}

__device__ __forceinline__ void s1_chunk(const Args& AR, LAS unsigned char* L, LAS unsigned char* scr, unsigned char* rec, const bf16* PS, size_t row0, const bf16* vrow  , int h, int ntok, int lane_) {
    int lane = lane_; asm volatile("" : "+v"(lane));
    const int t = lane & 31, hh = lane >> 5;
    const bool act = t < ntok;
    const bf16* P = PS + (row0 + (act ? t : 0)) * SHW; const bf16* PP = (vrow && t == 0) ? vrow : P - SHW;
    float lw[32]; unsigned asgp[16];
    {
        bf16x8 TWf[4], ALf[4];
#pragma unroll
        for (int s = 0; s < 4; ++s) { const int jb = 16 * s + 8 * hh;
            const f32x4 w0 = s1_z4(P, PP, 3072 + jb, *(LAS const f32x4*)(L + s3::PAR + 10 * 256 + jb * 4), act), w1 = s1_z4(P, PP, 3072 + jb + 4, *(LAS const f32x4*)(L + s3::PAR + 10 * 256 + (jb + 4) * 4), act);
            const f32x4 a0 = s1_z4(P, PP, 3136 + jb, *(LAS const f32x4*)(L + s3::PAR + 11 * 256 + jb * 4), act), a1 = s1_z4(P, PP, 3136 + jb + 4, *(LAS const f32x4*)(L + s3::PAR + 11 * 256 + (jb + 4) * 4), act);
            const float tw[8] = {tanh_fast(w0[0]), tanh_fast(w0[1]), tanh_fast(w0[2]), tanh_fast(w0[3]), tanh_fast(w1[0]), tanh_fast(w1[1]), tanh_fast(w1[2]), tanh_fast(w1[3])};
            const float al[8] = {a0[0], a0[1], a0[2], a0[3], a1[0], a1[1], a1[2], a1[3]};
            TWf[s] = pk8f(tw); ALf[s] = pk8f(al);
            if (s & 1) __builtin_amdgcn_sched_barrier(0); }
        f32x16 uw[2] = {ZERO16, ZERO16}, ua[2] = {ZERO16, ZERO16};
#pragma unroll
        for (int ct = 0; ct < 2; ++ct)
#pragma unroll
            for (int s = 0; s < 4; ++s) { uw[ct] = MFMA32(frag_nat(L + s3::W2T, s3::P68, 32 * ct + t, 16 * s + 8 * hh), TWf[s], uw[ct]);
                                          ua[ct] = MFMA32(frag_nat(L + s3::A2T, s3::P68, 32 * ct + t, 16 * s + 8 * hh), ALf[s], ua[ct]);
                                          if (s & 1) __builtin_amdgcn_sched_barrier(0); }
#pragma unroll
        for (int u = 0; u < 8; ++u) { const int chb = 8 * u + 4 * hh; const f32x4 w0 = *(LAS const f32x4*)(L + s3::PAR + 0 * 256 + chb * 4), a0 = *(LAS const f32x4*)(L + s3::PAR + 1 * 256 + chb * 4);
            float ag[4];
#pragma unroll
            for (int j = 0; j < 4; ++j) { const int sl = 4 * u + j;
                lw[sl] = act ? -0.6065306597126334f * sigmoidf_(uw[sl >> 4][sl & 15] + w0[j]) : 0.f; ag[j] = sigmoidf_(ua[sl >> 4][sl & 15] + a0[j]); }
            asgp[2 * u] = cvtpk(ag[0], ag[1]); asgp[2 * u + 1] = cvtpk(ag[2], ag[3]);
            if (u & 1) __builtin_amdgcn_sched_barrier(0); }
    }
    __builtin_amdgcn_sched_barrier(0);
#define Lc lw
#pragma unroll
    for (int sl = 0; sl < 32; ++sl) { float x = lw[sl];
        x += DPPV(x, 0x111, 0xF); x += DPPV(x, 0x112, 0xF); x += DPPV(x, 0x114, 0xF); x += DPPV(x, 0x118, 0xF);
        x += __builtin_bit_cast(float, __builtin_amdgcn_update_dpp(0, __builtin_bit_cast(int, x), 0x142, 0xA, 0xF, false));
        Lc[sl] = x; }
    __builtin_amdgcn_sched_barrier(0);
    {
        float zv[32]; bf16x8 Vf[4];
#pragma unroll
        for (int u = 0; u < 8; ++u) { const int chb = 8 * u + 4 * hh;
            const f32x4 c = s1_z4(P, PP, 2 * 1024 + h * HD + chb, *(LAS const f32x4*)(L + s3::PAR + 9 * 256 + chb * 4), act);
#pragma unroll
            for (int j = 0; j < 4; ++j) zv[4 * u + j] = c[j]; }
#pragma unroll
        for (int s = 0; s < 4; ++s) Vf[s] = pk8f(zv + 8 * s);
#pragma unroll
        for (int u = 0; u < 8; ++u)
#pragma unroll
            for (int j = 0; j < 4; j += 2) { const unsigned w = cvtpk(zv[4 * u + j], zv[4 * u + j + 1]);
                *(LAS bf16*)(scr + s3::IMGV + (8 * u + 4 * hh + j) * s3::P36 + 2 * t) = (bf16)w; *(LAS bf16*)(scr + s3::IMGV + (8 * u + 4 * hh + j + 1) * s3::P36 + 2 * t) = (bf16)(w >> 16); }
#pragma unroll
        for (int s = 0; s < 4; ++s) *(bf16x8*)(rec + s3::R_V + (s * 64 + lane) * 16) = Vf[s];
    }
    __builtin_amdgcn_sched_barrier(0);
    float rk = 0.f;
    f32x16 Mab = ZERO16, Mak = ZERO16, Mrk = ZERO16, Mrb = ZERO16;
    {
        unsigned zkp[16]; float ss = 0.f;
#pragma unroll
        for (int u = 0; u < 8; ++u) { const int chb = 8 * u + 4 * hh;
            const f32x4 b = s1_z4(P, PP, 1 * 1024 + h * HD + chb, *(LAS const f32x4*)(L + s3::PAR + 8 * 256 + chb * 4), act);
            const f32x4 kkw = *(LAS const f32x4*)(L + s3::PAR + 2 * 256 + chb * 4);
#pragma unroll
            for (int j = 0; j < 4; ++j) { const float kk = b[j] * kkw[j]; ss += kk * kk; }
            zkp[2 * u] = cvtpk(b[0], b[1]); zkp[2 * u + 1] = cvtpk(b[2], b[3]); }
        ss = xhalf_sum(ss);
        const float invn = 1.0f / fmaxf(sqrtf(ss), 1e-12f);
        const int last = (lane & 32) | 31;
        __builtin_amdgcn_sched_barrier(0);
#pragma unroll
        for (int s = 0; s < 4; ++s) {
            unsigned aw[4], rw[4], bw[4], kw[4], hw[4];
#pragma unroll
            for (int e = 0; e < 2; ++e) { const int u = 2 * s + e, chb = 8 * u + 4 * hh;
                const f32x4 zr = s1_z4(P, PP, 0 * 1024 + h * HD + chb, *(LAS const f32x4*)(L + s3::PAR + 7 * 256 + chb * 4), act);
                const f32x4 kkw = *(LAS const f32x4*)(L + s3::PAR + 2 * 256 + chb * 4), kaw = *(LAS const f32x4*)(L + s3::PAR + 3 * 256 + chb * 4), rkw = *(LAS const f32x4*)(L + s3::PAR + 4 * 256 + chb * 4);
                float at[4], rt[4], bt[4], kt[4], bh[4], kh[4];
                const float zk4[4] = {bflo(zkp[2 * u]), bfhi(zkp[2 * u]), bflo(zkp[2 * u + 1]), bfhi(zkp[2 * u + 1])}, as4[4] = {bflo(asgp[2 * u]), bfhi(asgp[2 * u]), bflo(asgp[2 * u + 1]), bfhi(asgp[2 * u + 1])};
#pragma unroll
                for (int j = 0; j < 4; ++j) { const int sl = 4 * u + j;
                    const float lp = __shfl_up(Lc[sl], 1); const float e2 = __expf(Lc[sl]), e1 = __expf(t == 0 ? 0.f : lp), e3 = __builtin_amdgcn_rcpf(e2), gcv = __shfl(e2, last), e4 = gcv * e3;
                    const float kn = zk4[j] * kkw[j] * invn, kp = zk4[j] * (1.0f + (as4[j] - 1.0f) * kaw[j]), bb = kn * as4[j];
                    at[j] = -kn * e1; rt[j] = zr[j] * e2; bt[j] = bb * e3; kt[j] = kp * e3; bh[j] = bb * e4; kh[j] = kp * e4; rk += zr[j] * kp * rkw[j]; }
#pragma unroll
                for (int p = 0; p < 2; ++p) { aw[2 * e + p] = cvtpk(at[2 * p], at[2 * p + 1]); rw[2 * e + p] = cvtpk(rt[2 * p], rt[2 * p + 1]); bw[2 * e + p] = cvtpk(bt[2 * p], bt[2 * p + 1]); kw[2 * e + p] = cvtpk(kt[2 * p], kt[2 * p + 1]); hw[2 * e + p] = cvtpk(bh[2 * p], bh[2 * p + 1]);
                    const unsigned w = cvtpk(kh[2 * p], kh[2 * p + 1]); const int ch = chb + 2 * p;
                    *(LAS bf16*)(scr + s3::IMG2 + ch * s3::P36 + 2 * t) = (bf16)w; *(LAS bf16*)(scr + s3::IMG2 + (ch + 1) * s3::P36 + 2 * t) = (bf16)(w >> 16); } }
            const bf16x8 Af = __builtin_bit_cast(bf16x8, (v4u){aw[0], aw[1], aw[2], aw[3]}), Rf = __builtin_bit_cast(bf16x8, (v4u){rw[0], rw[1], rw[2], rw[3]}), Bf = __builtin_bit_cast(bf16x8, (v4u){bw[0], bw[1], bw[2], bw[3]}), Kf = __builtin_bit_cast(bf16x8, (v4u){kw[0], kw[1], kw[2], kw[3]});
            Mab = MFMA32(Af, Bf, Mab); Mak = MFMA32(Af, Kf, Mak); Mrk = MFMA32(Rf, Kf, Mrk); Mrb = MFMA32(Rf, Bf, Mrb);
            *(bf16x8*)(rec + s3::R_G + 4096 + (s * 64 + lane) * 16) = Af; *(bf16x8*)(rec + s3::R_R2 + (s * 64 + lane) * 16) = Rf; *(v4u*)(rec + s3::R_G + (s * 64 + lane) * 16) = (v4u){hw[0], hw[1], hw[2], hw[3]};
            __builtin_amdgcn_sched_barrier(0);
        }
        rk = xhalf_sum(rk);
        if (hh == 0) *(float*)(rec + s3::R_RK + t * 4) = rk;
        if (t == 31) {
#pragma unroll
            for (int u = 0; u < 8; ++u) *(f32x4*)(rec + s3::R_GC + (8 * u + 4 * hh) * 4) = (f32x4){__expf(Lc[4 * u]), __expf(Lc[4 * u + 1]), __expf(Lc[4 * u + 2]), __expf(Lc[4 * u + 3])}; }
    }
#pragma unroll
    for (int r = 0; r < 16; ++r) { const int rr = crow(r, hh); Mab[r] = (t < rr) ? Mab[r] : 0.f; Mak[r] = (t < rr) ? Mak[r] : 0.f; Mrk[r] = (t <= rr) ? Mrk[r] : 0.f; Mrb[r] = (t <= rr) ? Mrb[r] : 0.f; }
#pragma unroll
    for (int kt = 0; kt < 2; ++kt)
#pragma unroll
        for (int vt = 0; vt < 2; ++vt) { f32x16 Hh = ZERO16;
#pragma unroll
            for (int s = 0; s < 2; ++s) Hh = MFMA32(frag_nat(scr + s3::IMG2, s3::P36, 32 * kt + t, 16 * s + 8 * hh), frag_nat(scr + s3::IMGV, s3::P36, 32 * vt + t, 16 * s + 8 * hh), Hh);
            store16bf(rec + s3::R_H + ((kt * 2 + vt) * 64 + lane) * 32, Hh); }
    __builtin_amdgcn_sched_barrier(0);
#define S1_IMG(img, f) do { _Pragma("unroll") for (int s_ = 0; s_ < 4; ++s_) { const v4u w_ = __builtin_bit_cast(v4u, (f)[s_]); _Pragma("unroll") for (int e_ = 0; e_ < 4; ++e_) { const unsigned x_ = e_ == 0 ? w_.x : (e_ == 1 ? w_.y : (e_ == 2 ? w_.z : w_.w)); \
        const int ch_ = 8 * (2 * s_ + (e_ >> 1)) + 4 * hh + 2 * (e_ & 1); *(LAS bf16*)(scr + (img) + ch_ * s3::P36 + 2 * t) = (bf16)x_; *(LAS bf16*)(scr + (img) + (ch_ + 1) * s3::P36 + 2 * t) = (bf16)(x_ >> 16); } } } while (0)
    f32x16 Tm;
    {
        f32x16 Pm = Mab;
        Tm = Pm;
#pragma unroll
        for (int r = 0; r < 16; ++r) Tm[r] += (crow(r, hh) == t) ? 1.0f : 0.0f;
#pragma unroll
        for (int lv = 0; lv < 4; ++lv) {
            store_rm(scr + s3::RM0, s3::P36, Pm, t, hh); store_rm(scr + s3::RM1, s3::P36, Tm, t, hh);
            const bf16x8 p0 = pk8(Pm, 0), p1 = pk8(Pm, 1);
            f32x16 Pn = MFMA32(frag_perm(scr + s3::RM0, s3::P36, t, 0, hh), p0, ZERO16); Pn = MFMA32(frag_perm(scr + s3::RM0, s3::P36, t, 16, hh), p1, Pn);
            const bf16x8 n0 = pk8(Pn, 0), n1 = pk8(Pn, 1);
            Tm = MFMA32(frag_perm(scr + s3::RM1, s3::P36, t, 0, hh), n0, Tm); Tm = MFMA32(frag_perm(scr + s3::RM1, s3::P36, t, 16, hh), n1, Tm);
            Pm = Pn;
        }
        store_rm(scr + s3::RM0, s3::P36, Tm, t, hh);
    }
    f32x16 W1[2];
    asm volatile("s_waitcnt vmcnt(0)" ::: "memory");
    { bf16x8 Atf[4];
#pragma unroll
      for (int s = 0; s < 4; ++s) Atf[s] = *(const bf16x8*)(rec + s3::R_G + 4096 + (s * 64 + lane) * 16);
      S1_IMG(s3::IMG2, Atf); }
#pragma unroll
    for (int nt = 0; nt < 2; ++nt) { W1[nt] = ZERO16;
#pragma unroll
        for (int s = 0; s < 2; ++s) W1[nt] = MFMA32(frag_nat(scr + s3::RM0, s3::P36, t, 16 * s + 8 * hh), frag_nat(scr + s3::IMG2, s3::P36, 32 * nt + t, 16 * s + 8 * hh), W1[nt]); }
    f32x16 W2[2];
    {
        store_rm(scr + s3::RM1, s3::P36, Mak, t, hh);
#pragma unroll
        for (int vt = 0; vt < 2; ++vt) { f32x16 X = ZERO16;
#pragma unroll
            for (int s = 0; s < 2; ++s) X = MFMA32(frag_nat(scr + s3::RM1, s3::P36, t, 16 * s + 8 * hh), frag_nat(scr + s3::IMGV, s3::P36, 32 * vt + t, 16 * s + 8 * hh), X);
            W2[vt] = MFMA32(frag_perm(scr + s3::RM0, s3::P36, t, 0, hh), pk8(X, 0), ZERO16); W2[vt] = MFMA32(frag_perm(scr + s3::RM0, s3::P36, t, 16, hh), pk8(X, 1), W2[vt]); }
    }
    f32x16 Y02[2];
    {
        store_rm(scr + s3::RM1, s3::P36, Mrk, t, hh);
#pragma unroll
        for (int vt = 0; vt < 2; ++vt) { Y02[vt] = ZERO16;
#pragma unroll
            for (int s = 0; s < 2; ++s) Y02[vt] = MFMA32(frag_nat(scr + s3::RM1, s3::P36, t, 16 * s + 8 * hh), frag_nat(scr + s3::IMGV, s3::P36, 32 * vt + t, 16 * s + 8 * hh), Y02[vt]); }
    }
    {
        store_rm(scr + s3::RM1, s3::P36, Mrb, t, hh);
        const bf16x8 mb0 = frag_perm(scr + s3::RM1, s3::P36, t, 0, hh), mb1 = frag_perm(scr + s3::RM1, s3::P36, t, 16, hh);
#pragma unroll
        for (int vt = 0; vt < 2; ++vt) { Y02[vt] = MFMA32(mb0, pk8(W2[vt], 0), Y02[vt]); Y02[vt] = MFMA32(mb1, pk8(W2[vt], 1), Y02[vt]);
            store16bf(rec + s3::R_Y02 + (vt * 64 + lane) * 32, Y02[vt]); }
#pragma unroll
        for (int kt = 0; kt < 2; ++kt) { f32x16 R2 = MFMA32(pk8(W1[kt], 0), mb0, ZERO16); R2 = MFMA32(pk8(W1[kt], 1), mb1, R2);
#pragma unroll
            for (int sx = 0; sx < 2; ++sx) { const v4u rw = *(const v4u*)(rec + s3::R_R2 + ((2 * kt + sx) * 64 + lane) * 16);
                R2[8 * sx + 0] += bflo(rw.x); R2[8 * sx + 1] += bfhi(rw.x); R2[8 * sx + 2] += bflo(rw.y); R2[8 * sx + 3] += bfhi(rw.y); R2[8 * sx + 4] += bflo(rw.z); R2[8 * sx + 5] += bfhi(rw.z); R2[8 * sx + 6] += bflo(rw.w); R2[8 * sx + 7] += bfhi(rw.w); }
            *(bf16x8*)(rec + s3::R_R2 + ((2 * kt + 0) * 64 + lane) * 16) = pk8(R2, 0); *(bf16x8*)(rec + s3::R_R2 + ((2 * kt + 1) * 64 + lane) * 16) = pk8(R2, 1); }
    }
    asm volatile("s_waitcnt vmcnt(0)" ::: "memory");
    { bf16x8 Bhf[4];
#pragma unroll
      for (int s = 0; s < 4; ++s) Bhf[s] = *(const bf16x8*)(rec + s3::R_G + (s * 64 + lane) * 16);
      S1_IMG(s3::IMG2, Bhf); }
#pragma unroll
    for (int kt = 0; kt < 2; ++kt) { const bf16x8 b0 = frag_perm(scr + s3::IMG2, s3::P36, 32 * kt + t, 0, hh), b1 = frag_perm(scr + s3::IMG2, s3::P36, 32 * kt + t, 16, hh);
#pragma unroll
        for (int vt = 0; vt < 2; ++vt) { f32x16 Hh = load16bf(rec + s3::R_H + ((kt * 2 + vt) * 64 + lane) * 32); Hh = MFMA32(b0, pk8(W2[vt], 0), Hh); Hh = MFMA32(b1, pk8(W2[vt], 1), Hh);
            store16bf(rec + s3::R_H + ((kt * 2 + vt) * 64 + lane) * 32, Hh); }
#pragma unroll
        for (int kp = 0; kp < 2; ++kp) { f32x16 G = MFMA32(pk8(W1[kp], 0), b0, ZERO16); G = MFMA32(pk8(W1[kp], 1), b1, G);
            *(bf16x8*)(rec + s3::R_G + (((kt * 2 + kp) * 2 + 0) * 64 + lane) * 16) = pk8(G, 0); *(bf16x8*)(rec + s3::R_G + (((kt * 2 + kp) * 2 + 1) * 64 + lane) * 16) = pk8(G, 1); } }
#undef S1_IMG
#undef Lc
}

__device__ __forceinline__ void s2_chunk(LAS unsigned char* L, const unsigned char* rec, f32x16 (&ST)[2][2], const bf16* GB, bf16* OB, size_t row0, int h, int ntok, int lane_) {
    int lane = lane_; asm volatile("" : "+v"(lane));
    const int q = lane & 31, hi = lane >> 5;
    bf16x8 Sb[2][2][2];
#pragma unroll
    for (int kt = 0; kt < 2; ++kt)
#pragma unroll
        for (int vt = 0; vt < 2; ++vt) { Sb[kt][vt][0] = pk8(ST[kt][vt], 0); Sb[kt][vt][1] = pk8(ST[kt][vt], 1); }
    {
        bf16x8 R2p[4];
#pragma unroll
        for (int s = 0; s < 4; ++s) R2p[s] = *(const bf16x8*)(rec + s3::R_R2 + (s * 64 + lane) * 16);
#pragma unroll
        for (int vt = 0; vt < 2; ++vt) { f32x16 Y = load16bf(rec + s3::R_Y02 + (vt * 64 + lane) * 32);
#pragma unroll
            for (int kt = 0; kt < 2; ++kt) { Y = MFMA32(R2p[2 * kt + 0], Sb[kt][vt][0], Y); Y = MFMA32(R2p[2 * kt + 1], Sb[kt][vt][1], Y); }
            LAS float* yo = (LAS float*)(L + s3::YT) + 32 * vt + q;
#pragma unroll
            for (int r = 0; r < 16; ++r) yo[crow(r, hi) * 68] = Y[r]; }
    }
#pragma unroll
    for (int mt = 0; mt < 2; ++mt) {
        bf16x8 Gp[2][2];
#pragma unroll
        for (int kp = 0; kp < 2; ++kp) { Gp[kp][0] = *(const bf16x8*)(rec + s3::R_G + (((mt * 2 + kp) * 2 + 0) * 64 + lane) * 16); Gp[kp][1] = *(const bf16x8*)(rec + s3::R_G + (((mt * 2 + kp) * 2 + 1) * 64 + lane) * 16); }
        f32x4 gc[4];
#pragma unroll
        for (int g = 0; g < 4; ++g) gc[g] = *(const f32x4*)(rec + s3::R_GC + (32 * mt + 8 * g + 4 * hi) * 4);
#pragma unroll
        for (int vt = 0; vt < 2; ++vt) { f32x16 acc = load16bf(rec + s3::R_H + ((mt * 2 + vt) * 64 + lane) * 32);
#pragma unroll
            for (int g = 0; g < 4; ++g) { acc[4 * g + 0] += gc[g].x * ST[mt][vt][4 * g + 0]; acc[4 * g + 1] += gc[g].y * ST[mt][vt][4 * g + 1]; acc[4 * g + 2] += gc[g].z * ST[mt][vt][4 * g + 2]; acc[4 * g + 3] += gc[g].w * ST[mt][vt][4 * g + 3]; }
#pragma unroll
            for (int kp = 0; kp < 2; ++kp) { acc = MFMA32(Gp[kp][0], Sb[kp][vt][0], acc); acc = MFMA32(Gp[kp][1], Sb[kp][vt][1], acc); }
            ST[mt][vt] = acc; }
    }
    if (q < ntok) {
        const int t = q, hh = hi;
        float y[32]; float s = 0.f;
#pragma unroll
        for (int u = 0; u < 8; ++u) { const f32x4 v = *(LAS const f32x4*)(L + s3::YT + (t * 68 + 8 * u + 4 * hh) * 4); y[4 * u] = v.x; y[4 * u + 1] = v.y; y[4 * u + 2] = v.z; y[4 * u + 3] = v.w; s += (v.x + v.y) + (v.z + v.w); }
        const float mean = xhalf_sum(s) * (1.0f / 64.0f); float qv = 0.f;
#pragma unroll
        for (int i = 0; i < 32; ++i) { y[i] -= mean; qv += y[i] * y[i]; }
        const float rstd = 1.0f / sqrtf(xhalf_sum(qv) * (1.0f / 64.0f) + GN_EPS);
        const float rk = *(const float*)(rec + s3::R_RK + t * 4);
        const bf16* gp = GB + (row0 + t) * DM + h * HD; bf16* op = OB + (row0 + t) * DM + h * HD;
#pragma unroll
        for (int s2 = 0; s2 < 4; ++s2) { const v4u vv = *(const v4u*)(rec + s3::R_V + (s2 * 64 + lane) * 16);
            const float vf[8] = {bflo(vv.x), bfhi(vv.x), bflo(vv.y), bfhi(vv.y), bflo(vv.z), bfhi(vv.z), bflo(vv.w), bfhi(vv.w)};
#pragma unroll
            for (int e = 0; e < 2; ++e) { const int u = 2 * s2 + e, chb = 8 * u + 4 * hh;
                const f32x4 lg = *(LAS const f32x4*)(L + s3::PAR + 5 * 256 + chb * 4), lb = *(LAS const f32x4*)(L + s3::PAR + 6 * 256 + chb * 4);
                const v2u gv = *(const v2u*)(gp + chb); const float gt[4] = {bflo(gv.x), bfhi(gv.x), bflo(gv.y), bfhi(gv.y)};
                float o[4];
#pragma unroll
                for (int j = 0; j < 4; ++j) o[j] = (y[4 * u + j] * rstd * lg[j] + lb[j] + rk * vf[4 * e + j]) * gt[j];
                v2u w; w.x = cvtpk(o[0], o[1]); w.y = cvtpk(o[2], o[3]); *(v2u*)(op + chb) = w; } }
    }
}

__device__ __forceinline__ void scan_wg(const Frame& F, const Args& AR, int w, bf16* OB_) {
    LAS unsigned char* L = F.lds;
    int lane = lane_id(); asm volatile("" : "+v"(lane));
    const int wave = F.wave, tid = wave * 64 + lane;
    const bool sample = w >= 128;
    const int h = sample ? ((w - 128) * 32) >> 7 : (w & 15);
    const int nch = sample ? 1 : SEQ / 32, nitems = sample ? 32 : nch, ntok = sample ? DECS : 32;
    const bf16* PS = (const bf16*)(F.ws + WS_PS); const bf16* GB = (const bf16*)(F.ws + WS_GA);
    unsigned char* ring = F.ws + (sample ? WS_K + (size_t)(w - 128) * s3::RING_BYTES_WG : WS_XN + (size_t)w * s3::RING_BYTES_WG);
    __syncthreads();
    {
        const int j = tid >> 3, cb = (tid & 7) * 8;
        const float* p = AR.in[I_W2] + (size_t)j * DM + h * HD + cb; const f32x4 a0 = *(const f32x4*)p, a1 = *(const f32x4*)(p + 4);
        const float* p2 = AR.in[I_A2] + (size_t)j * DM + h * HD + cb; const f32x4 b0 = *(const f32x4*)p2, b1 = *(const f32x4*)(p2 + 4);
        const float wv[8] = {a0.x, a0.y, a0.z, a0.w, a1.x, a1.y, a1.z, a1.w}, av[8] = {b0.x, b0.y, b0.z, b0.w, b1.x, b1.y, b1.z, b1.w};
#pragma unroll
        for (int i = 0; i < 8; ++i) { *(LAS bf16*)(L + s3::W2T + (cb + i) * s3::P68 + 2 * j) = (bf16)cvtpk(wv[i], 0.f); *(LAS bf16*)(L + s3::A2T + (cb + i) * s3::P68 + 2 * j) = (bf16)cvtpk(av[i], 0.f); }
        for (int idx = tid; idx < 12 * 64; idx += NTHR) { const int arr = idx >> 6, c = idx & 63; const float* src;
            switch (arr) { case 0: src = AR.in[I_W0] + h * HD; break; case 1: src = AR.in[I_A0] + h * HD; break; case 2: src = AR.in[I_KK] + h * HD; break; case 3: src = AR.in[I_KA] + h * HD; break;
                case 4: src = AR.in[I_RK] + h * HD; break; case 5: src = AR.in[I_LNG] + h * HD; break; case 6: src = AR.in[I_LNB] + h * HD; break;
                case 7: src = AR.in[I_MU] + h * HD; break; case 8: src = AR.in[I_MU] + 1024 + h * HD; break; case 9: src = AR.in[I_MU] + 2048 + h * HD; break; case 10: src = AR.in[I_MU] + 3072; break; default: src = AR.in[I_MU] + 3136; break; }
            ((LAS float*)(L + s3::PAR))[idx] = src[c]; }
    }
    __syncthreads();
    const int nb = (nitems + 6) / 7;

    for (int j = 0; j <= nb; ++j) {
        int ln = lane; asm volatile("" : "+v"(ln));
        if (wave != 6) {
            const int item = 7 * j + (wave < 6 ? wave : 6);
            if (item < nitems) {
                int b, c; if (sample) { b = ((w - 128) * 32 + item) & 127; c = 0; } else { b = w >> 4; c = item; }
                const size_t row0 = sample ? (size_t)MP + (size_t)b * DECS : (size_t)b * SEQ + (size_t)c * 32;
                s1_chunk(AR, L, L + s3::SCR + (wave < 6 ? wave : 6) * s3::SCRW, ring + (size_t)(item % s3::RING) * s3::R_SIZE, PS, row0, c == 0 ? (sample ? (const bf16*)(F.ws + WS_SROW) + (size_t)b * SHW : (const bf16*)(F.ws + WS_ZROW)) : nullptr, h, ntok, ln);
            }
        } else if (j >= 1) {
            LAS f32x4* STS = (LAS f32x4*)(L + SMALL_OFF) + ln;
            f32x16 ST[2][2];
#pragma unroll
            for (int a = 0; a < 4; ++a)
#pragma unroll
                for (int g = 0; g < 4; ++g) { const f32x4 x = STS[(a * 4 + g) * 64]; ST[a >> 1][a & 1][4 * g + 0] = x.x; ST[a >> 1][a & 1][4 * g + 1] = x.y; ST[a >> 1][a & 1][4 * g + 2] = x.z; ST[a >> 1][a & 1][4 * g + 3] = x.w; }
            for (int i = 0; i < 7; ++i) { const int item = 7 * (j - 1) + i; if (item >= nitems) break;
                int b, c; if (sample) { b = ((w - 128) * 32 + item) & 127; c = 0; } else { b = w >> 4; c = item; }
                const size_t row0 = sample ? (size_t)MP + (size_t)b * DECS : (size_t)b * SEQ + (size_t)c * 32;
                const int q = ln & 31, hi = ln >> 5;
                if (c == 0) {
#pragma unroll
                    for (int kt = 0; kt < 2; ++kt)
#pragma unroll
                        for (int vt = 0; vt < 2; ++vt) { ST[kt][vt] = ZERO16;
                            if (sample) { const float* sp = AR.in[I_SWKV] + ((size_t)(b * NH + h) * HD + 32 * vt + q) * HD + 32 * kt + 4 * hi;
#pragma unroll
                                for (int g = 0; g < 4; ++g) { const f32x4 x = *(const f32x4*)(sp + 8 * g); ST[kt][vt][4 * g + 0] = x.x; ST[kt][vt][4 * g + 1] = x.y; ST[kt][vt][4 * g + 2] = x.z; ST[kt][vt][4 * g + 3] = x.w; } } }
                }
                s2_chunk(L, ring + (size_t)(item % s3::RING) * s3::R_SIZE, ST, GB, OB_, row0, h, ntok, ln);
                if (c == nch - 1) {
                    float* dp = F.out + (sample ? O_SWKV : O_PWKV) + (size_t)(b * NH + h) * HD * HD;
#pragma unroll
                    for (int kt = 0; kt < 2; ++kt)
#pragma unroll
                        for (int vt = 0; vt < 2; ++vt)
#pragma unroll
                            for (int g = 0; g < 4; ++g) *(f32x4*)(dp + (size_t)(32 * vt + q) * HD + 32 * kt + 8 * g + 4 * hi) = (f32x4){ST[kt][vt][4 * g + 0], ST[kt][vt][4 * g + 1], ST[kt][vt][4 * g + 2], ST[kt][vt][4 * g + 3]};
                }
            }
#pragma unroll
            for (int a = 0; a < 4; ++a)
#pragma unroll
                for (int g = 0; g < 4; ++g) STS[(a * 4 + g) * 64] = (f32x4){ST[a >> 1][a & 1][4 * g + 0], ST[a >> 1][a & 1][4 * g + 1], ST[a >> 1][a & 1][4 * g + 2], ST[a >> 1][a & 1][4 * g + 3]};
        }
        asm volatile("s_waitcnt vmcnt(0)" ::: "memory");
        __syncthreads();
    }
}

__device__ __forceinline__ void final_norm(const Frame& F, const Args& AR, float* dst) {
    const int gw = F.vcu * NWAVES + F.wave, NGW = F.G * NWAVES;
    const float* ss = (const float*)(F.ws + WS_SS); const int lane = lane_id(); const GAS f32x4* gr = (const GAS f32x4*)AR.in[I_FING] + lane;
    for (int m = gw; m < MT; m += NGW) {
        const float sc = 1.0f / sqrtf(ss[m] * (1.f / DM) + NORM_EPS);
        GAS f32x4* xr = (GAS f32x4*)(F.out + (size_t)m * DM) + lane;
        GAS f32x4* yr = (GAS f32x4*)(dst + (size_t)m * DM) + lane;
#pragma unroll
        for (int j = 0; j < 4; ++j) { const f32x4 v = xr[64 * j], g = gr[64 * j]; yr[64 * j] = v * sc * g; }
    }
}

#ifndef MK_PER_PHASE
#define MK_PER_PHASE 0
#endif
constexpr int N_PHASES = 9;
__global__ void __launch_bounds__(NTHR, 2) hybrid_fwd(Args args) {
    extern __shared__ __attribute__((aligned(16))) unsigned char lds[];
    Frame F;
    F.lds = (LAS unsigned char*)lds;
    F.wave = __builtin_amdgcn_readfirstlane(threadIdx.x >> 6);
    F.G = gridDim.x; { const int bx = blockIdx.x; F.vcu = (F.G % 8 == 0) ? (bx % 8) * (F.G / 8) + bx / 8 : bx; }
    F.out = args.out; F.ws = args.ws;
    volatile LAS unsigned* MISC = (volatile LAS unsigned*)(F.lds + MISC_OFF);
    for (int u = threadIdx.x; u < (LDS_BYTES - LDSCTL_OFF) / 4; u += NTHR) ((LAS unsigned*)(F.lds + LDSCTL_OFF))[u] = 0u;
    __syncthreads();
    XcdBarrier bar; bar.bar = (unsigned*)(F.ws + WS_CTL) + CW_BAR; bar.x = 0; bar.st = nullptr;
    if (!MK_PER_PHASE) bar = xcd_barrier_post((unsigned*)(F.ws + WS_CTL) + CW_BAR, MISC + 8);
    const int lo = args.ph_lo, hi = args.ph_hi;
#ifndef DUP
#define DUP 0
#endif
#define REP(k) for (int rep_ = ((DUP >> (k)) & 1) ? 0 : 1; rep_ < 2; ++rep_)
#ifndef PHMASK
#define PHMASK 0x1ff
#endif
#define IN(k) ((((PHMASK) >> (k)) & 1) && lo <= (k) && (k) < hi)
#define SEAM(k) do { if (IN(k) && IN((k) + 1)) xcd_barrier(bar); } while (0)

    if (IN(0)) { REP(0) p0_prologue(F, args); }
    SEAM(0);
    if (IN(1)) {
        pg8::Gemm g{(const bf16*)(F.ws + WS_XN), (const bf16*)(F.ws + WS_W1T), MT, N1A, DM}; pg8::StaticOrder S; S.init(MT, N1A, F.G, (int)blockIdx.x);
        EpiG1 E{0, F.ws, F.out};
        REP(1) pg8::gemm_phase<EpiG1, pg8::StaticOrder, true, true>(F.lds, g, S, E);
    }
    SEAM(1);
    if (IN(2)) { REP(2) { bf16* ob = (bf16*)(F.ws + (rep_ ? WS_Q : WS_PS)); for (int u = F.vcu; u < 1024 + 512; u += F.G) attn_unit(F, args, u, ob); } }
    SEAM(2);
    if (IN(3)) {
        pg8::Gemm g{(const bf16*)(F.ws + WS_XN), (const bf16*)(F.ws + WS_W1T) + (size_t)N1A * DM, MT, N1B, DM}; pg8::StaticOrder S; S.init(MT, N1B, F.G, (int)blockIdx.x);
        EpiG1 E{1, F.ws, F.out};
        REP(3) pg8::gemm_phase<EpiG1, pg8::StaticOrder, true, true>(F.lds, g, S, E);
    }
    SEAM(3);
    if (IN(4)) { REP(4) { bf16* ob = (bf16*)(F.ws + (rep_ ? WS_GA : WS_PS + (size_t)MT * SHW * 2 - (size_t)MT * DM * 2)); for (int w = (int)blockIdx.x; w < 192; w += F.G) scan_wg(F, args, w, ob); } }
    SEAM(4);
    if (IN(5)) {
        pg8::Gemm g{(const bf16*)(F.ws + WS_Q), (const bf16*)(F.ws + WS_WAT), MT, DM, DM}; pg8::StaticOrder S; S.init(MT, DM, F.G, (int)blockIdx.x);
        EpiGate E{0, (const bf16*)F.out, nullptr, (bf16*)(F.ws + WS_PS)};
        REP(5) pg8::gemm_phase<EpiGate, pg8::StaticOrder, true, true>(F.lds, g, S, E);
    }
    SEAM(5);
    if (IN(6)) {
        pg8::Gemm g{(const bf16*)(F.ws + WS_GA), (const bf16*)(F.ws + WS_WBT), MT, DM, DM}; pg8::StaticOrder S; S.init(MT, DM, F.G, (int)blockIdx.x);
        EpiGate E{1, (const bf16*)F.out + (size_t)MT * DM, (const bf16*)(F.ws + WS_PS), (bf16*)(F.ws + WS_XN)};
        REP(6) pg8::gemm_phase<EpiGate, pg8::StaticOrder, true, true>(F.lds, g, S, E);
    }
    SEAM(6);
    if (IN(7)) {
        pg8::Gemm g{(const bf16*)(F.ws + WS_XN), (const bf16*)(F.ws + WS_WOT), MT, DM, DM}; pg8::StaticOrder S; S.init(MT, DM, F.G, (int)blockIdx.x);
        REP(7) { EpiOut E{args.in[I_XP], args.in[I_XS], F.out, (float*)(F.ws + WS_SS + (rep_ ? 0 : 192 * 1024))};
        pg8::gemm_phase<EpiOut, pg8::StaticOrder, true, true>(F.lds, g, S, E); }
    }
    SEAM(7);
    if (IN(8)) { REP(8) final_norm(F, args, rep_ ? F.out : (float*)(F.ws + WS_PS)); }
#undef IN
#undef SEAM
}

extern "C" void kernel_launch(void* const* d_in, const int* in_sizes, int n_in, void* d_out, int out_size, void* d_ws, size_t ws_size, hipStream_t stream) {
    static int grid = 0;
    if (grid == 0) {
        if (n_in != 24 || (size_t)out_size != O_END || ws_size < WS_END) { fprintf(stderr, "kernel_launch: unexpected sizes: n_in %d out %d ws %zu (need %zu)\n", n_in, out_size, ws_size, (size_t)WS_END); grid = -1; return; }
        int dev = 0, cus = 0;
        if (hipGetDevice(&dev) != hipSuccess || hipDeviceGetAttribute(&cus, hipDeviceAttributeMultiprocessorCount, dev) != hipSuccess) { grid = -1; return; }
        if (hipFuncSetAttribute((const void*)hybrid_fwd, hipFuncAttributeMaxDynamicSharedMemorySize, LDS_BYTES) != hipSuccess) { fprintf(stderr, "kernel_launch: hipFuncSetAttribute failed\n"); grid = -1; return; }
        int per_cu = 0;
        if (hipOccupancyMaxActiveBlocksPerMultiprocessor(&per_cu, (const void*)hybrid_fwd, NTHR, LDS_BYTES) != hipSuccess || per_cu < 1) fprintf(stderr, "kernel_launch: occupancy query says %d\n", per_cu);
        (void)hipGetLastError();
        grid = cus;
    }
    if (grid < 0) return;
    (void)hipMemsetAsync((char*)d_ws + WS_CTL, 0, CTL_ZERO_BYTES, stream);
    Args a{};
    for (int i = 0; i < 24; ++i) a.in[i] = (const float*)d_in[i];
    a.out = (float*)d_out; a.ws = (unsigned char*)d_ws;
#if MK_PER_PHASE
    for (int p = 0; p < N_PHASES; ++p) { a.ph_lo = p; a.ph_hi = p + 1; hipLaunchKernelGGL(hybrid_fwd, dim3(grid), dim3(NTHR), LDS_BYTES, stream, a); }
#else
    a.ph_lo = 0; a.ph_hi = N_PHASES; hipLaunchKernelGGL(hybrid_fwd, dim3(grid), dim3(NTHR), LDS_BYTES, stream, a);
#endif
}
```

```cpp
#include <hip/hip_runtime.h>
#include <cstdio>
#include <cstdint>
#include <cmath>
namespace pg8 {
#define PG8_LAS __attribute__((address_space(3)))
typedef unsigned short bf16_t;
typedef short bf16x8 __attribute__((ext_vector_type(8)));
typedef float f32x4 __attribute__((ext_vector_type(4)));
typedef unsigned u32x4 __attribute__((ext_vector_type(4)));
constexpr int BM = 256, BK = 64, HALF = 128, HTB = HALF * BK * 2  , STAGE_BYTES = 8 * HTB, NXCD = 8, WGM = 8;

__host__ __device__ __forceinline__ int lds_byte(int r, int c) { const int st = (r >> 4) * 2 + (c >> 5), rr = r & 15, cc = c & 31, ob = rr * 64 + cc * 2; return st * 1024 + (ob ^ (((ob >> 9) & 1) << 5)); }
__host__ __device__ __forceinline__ void stage_rc(int b, int& R, int& C) { const int st = b / 1024, sb = b % 1024, swz = sb ^ (((sb >> 9) & 1) << 5); R = (st >> 1) * 16 + swz / 64; C = (st & 1) * 32 + (swz % 64) / 2; }
__host__ __device__ __forceinline__ int perm32(int rho) { const int n = rho >> 4, i = rho & 15; return 8 * (i >> 2) + 4 * n + (i & 3); }

struct Unit { int pm, pn; };
struct Gemm { const bf16_t* A; const bf16_t* Bt; int M, N, K; };

struct StaticOrder {
    int nM, nN, nwg, G, c;
    __host__ __device__ void init(int M, int N, int G_, int c_) { nM = M / BM; nN = N / BM; nwg = nM * nN; G = G_; c = c_; }
    __host__ __device__ bool next(int i, Unit& u) const {
        const long L = (long)i * G + c; if (L >= nwg) return false;
        int wgid = (int)L; { const int q = nwg / NXCD, r = nwg % NXCD, xcd = wgid % NXCD, off = wgid / NXCD; wgid = (xcd < r ? xcd * (q + 1) : r * (q + 1) + (xcd - r) * q) + off; }
        const int nig = WGM * nN, gid = wgid / nig, fm = gid * WGM, gsz = (nM - fm) < WGM ? (nM - fm) : WGM;
        u.pm = fm + ((wgid % nig) % gsz); u.pn = (wgid % nig) / gsz; return true;
    }
    __device__ __forceinline__ void a_ready(const Unit&) const {}
    __device__ __forceinline__ void done(const Unit&) const {}
};

__device__ __forceinline__ unsigned cvt_pk_bf16(float lo, float hi) { unsigned r; asm volatile("v_cvt_pk_bf16_f32 %0, %1, %2" : "=v"(r) : "v"(lo), "v"(hi)); return r; }
typedef float f32x2 __attribute__((ext_vector_type(2)));
template <class Epi, class Sched, bool ALIGN_EPI = false, bool SP2 = false>
__device__ __forceinline__ void gemm_phase(PG8_LAS unsigned char* lds, const Gemm g, const Sched& S, const Epi& E) {
    const int tid = threadIdx.x, wid = __builtin_amdgcn_readfirstlane(tid >> 6), lane = tid & 63, wr = wid >> 2, wc = wid & 3, fr = lane & 15, fq = lane >> 4;
    const int K = g.K, nt = K / BK;
    unsigned voffA[2], voffB[2];
#pragma unroll
    for (int i = 0; i < 2; ++i) { int R, C; stage_rc(tid * 16 + i * 8192, R, C); const int Rb = Epi::PERM ? ((R & ~31) + perm32(R & 31)) : R;
        voffA[i] = (unsigned)(R * K + C) * 2u; voffB[i] = (unsigned)(Rb * K + C) * 2u; }
    const size_t kstep = (size_t)(BK * 2);
    const size_t hstep = (size_t)HALF * K * 2;
    const size_t tstep = 2 * hstep;
    const unsigned ldsw = (unsigned)wid * 1024u;
    const int aoff = lds_byte(wr * 64 + fr, fq * 8), boff = lds_byte(wc * 32 + fr, fq * 8);
#define PG8_SA(b, h) (((b) * 2 + (h)) * HTB)
#define PG8_SB(b, h) ((4 + (b) * 2 + (h)) * HTB)
#define PG8_STAGE(bufoff, gbase, voff) do { _Pragma("unroll") for (int _i = 0; _i < 2; ++_i) \
        __builtin_amdgcn_global_load_lds((const unsigned*)((const char*)(gbase) + (voff)[_i]), (PG8_LAS unsigned*)(lds + (bufoff) + ldsw + _i * 8192), 16, 0, 0); } while (0)
#define PG8_LDA(dst, b, h) do { _Pragma("unroll") for (int m = 0; m < 4; ++m) _Pragma("unroll") for (int k = 0; k < 2; ++k) dst[m][k] = *(const PG8_LAS bf16x8*)(lds + PG8_SA(b, h) + aoff + m * 2048 + k * 1024); } while (0)
#define PG8_LDB(dst, b, h) do { _Pragma("unroll") for (int n = 0; n < 2; ++n) _Pragma("unroll") for (int k = 0; k < 2; ++k) dst[n][k] = *(const PG8_LAS bf16x8*)(lds + PG8_SB(b, h) + boff + n * 2048 + k * 1024); } while (0)
#define PG8_MMA(ai, bj, At, Bt) do { __builtin_amdgcn_s_setprio(1); _Pragma("unroll") for (int m = 0; m < 4; ++m) _Pragma("unroll") for (int n = 0; n < 2; ++n) _Pragma("unroll") for (int k = 0; k < 2; ++k) \
        acc[ai][bj][m][n] = __builtin_amdgcn_mfma_f32_16x16x32_bf16(Bt[n][k], At[m][k], acc[ai][bj][m][n], 0, 0, 0); __builtin_amdgcn_s_setprio(0); } while (0)
#define PG8_WAIT_V(n) asm volatile("s_waitcnt vmcnt(" #n ")" ::: "memory")
#define PG8_WAIT_L(n) asm volatile("s_waitcnt lgkmcnt(" #n ")" ::: "memory")
#define PG8_BAR __builtin_amdgcn_s_barrier()
#define PG8_SCHED __builtin_amdgcn_sched_barrier(0)
    Unit cur, nxt; int ui = 0;
    if (!S.next(0, cur)) return;
    f32x4 acc[2][2][4][2];
#pragma unroll
    for (int a = 0; a < 2; ++a)
#pragma unroll
        for (int b = 0; b < 2; ++b)
#pragma unroll
            for (int m = 0; m < 4; ++m)
#pragma unroll
                for (int n = 0; n < 2; ++n) acc[a][b][m][n] = (f32x4){0.f, 0.f, 0.f, 0.f};
    bf16x8 At[4][2], B0[2][2], B1[2][2];
    const char* cA = (const char*)g.A + (size_t)cur.pm * tstep; const char* cB = (const char*)g.Bt + (size_t)cur.pn * tstep;
    S.a_ready(cur);
    if constexpr (SP2) {
        PG8_STAGE(PG8_SB(0, 0), cB, voffB); PG8_STAGE(PG8_SB(0, 1), cB + hstep, voffB); PG8_STAGE(PG8_SA(0, 0), cA, voffA); PG8_STAGE(PG8_SA(0, 1), cA + hstep, voffA);
        if (wr == 1) PG8_BAR;
        PG8_WAIT_V(2); PG8_BAR;
        PG8_STAGE(PG8_SB(1, 0), cB + kstep, voffB); PG8_STAGE(PG8_SA(1, 0), cA + kstep, voffA); PG8_STAGE(PG8_SB(1, 1), cB + hstep + kstep, voffB);
        PG8_WAIT_V(6); PG8_BAR;
    } else {
        PG8_STAGE(PG8_SB(0, 0), cB, voffB); PG8_STAGE(PG8_SA(0, 0), cA, voffA); PG8_STAGE(PG8_SB(0, 1), cB + hstep, voffB); PG8_STAGE(PG8_SA(0, 1), cA + hstep, voffA);
        if (wr == 1) PG8_BAR;
        PG8_WAIT_V(4); PG8_BAR;
        PG8_STAGE(PG8_SB(1, 0), cB + kstep, voffB); PG8_STAGE(PG8_SA(1, 0), cA + kstep, voffA); PG8_STAGE(PG8_SB(1, 1), cB + hstep + kstep, voffB);
        PG8_WAIT_V(6); PG8_BAR;
    }
    for (;;) {
        const bool has_next = S.next(ui + 1, nxt);
        const char* nA = has_next ? (const char*)g.A + (size_t)nxt.pm * tstep : cA; const char* nB = has_next ? (const char*)g.Bt + (size_t)nxt.pn * tstep : cB;
        for (int t = 0; t < nt; t += 2) {
            const bool last = (t == nt - 2);
            const char* a1 = cA + (size_t)(t + 1) * kstep;
            const char* a2 = last ? nA : cA + (size_t)(t + 2) * kstep; const char* b2 = last ? nB : cB + (size_t)(t + 2) * kstep;
            const char* a3 = a2 + kstep; const char* b3 = b2 + kstep;
            if (last && has_next) S.a_ready(nxt);
            if constexpr (SP2) {
            PG8_LDB(B0, 0, 0); PG8_LDB(B1, 0, 1); PG8_SCHED; PG8_LDA(At, 0, 0); PG8_STAGE(PG8_SA(1, 1), a1 + hstep, voffA);
            PG8_WAIT_V(8); PG8_WAIT_L(0); PG8_BAR; PG8_MMA(0, 0, At, B0); PG8_MMA(0, 1, At, B1); PG8_BAR; PG8_SCHED;
            PG8_LDA(At, 0, 1); PG8_STAGE(PG8_SB(0, 0), b2, voffB); PG8_STAGE(PG8_SB(0, 1), b2 + hstep, voffB); PG8_STAGE(PG8_SA(0, 0), a2, voffA);
            PG8_WAIT_V(8); PG8_WAIT_L(0); PG8_BAR; PG8_MMA(1, 0, At, B0); PG8_MMA(1, 1, At, B1); PG8_BAR; PG8_SCHED;
            PG8_LDB(B0, 1, 0); PG8_LDB(B1, 1, 1); PG8_SCHED; PG8_LDA(At, 1, 0); PG8_STAGE(PG8_SA(0, 1), a2 + hstep, voffA);
            PG8_WAIT_V(8); PG8_WAIT_L(0); PG8_BAR; PG8_MMA(0, 0, At, B0); PG8_MMA(0, 1, At, B1); PG8_BAR; PG8_SCHED;
            PG8_LDA(At, 1, 1); PG8_STAGE(PG8_SB(1, 0), b3, voffB); PG8_STAGE(PG8_SB(1, 1), b3 + hstep, voffB); PG8_STAGE(PG8_SA(1, 0), a3, voffA);
            PG8_WAIT_V(8); PG8_WAIT_L(0); PG8_BAR; PG8_MMA(1, 0, At, B0); PG8_MMA(1, 1, At, B1); PG8_BAR; PG8_SCHED;
            } else {
            PG8_LDB(B0, 0, 0); PG8_SCHED; PG8_LDA(At, 0, 0); PG8_STAGE(PG8_SA(1, 1), a1 + hstep, voffA);
            PG8_WAIT_L(8); PG8_BAR; PG8_WAIT_L(0); PG8_MMA(0, 0, At, B0); PG8_BAR; PG8_SCHED;
            PG8_LDB(B1, 0, 1); PG8_STAGE(PG8_SB(0, 0), b2, voffB);
            PG8_BAR; PG8_WAIT_L(0); PG8_MMA(0, 1, At, B1); PG8_BAR;
            PG8_LDA(At, 0, 1); PG8_STAGE(PG8_SA(0, 0), a2, voffA);
            PG8_BAR; PG8_WAIT_L(0); PG8_MMA(1, 0, At, B0); PG8_BAR; PG8_SCHED;
            PG8_STAGE(PG8_SB(0, 1), b2 + hstep, voffB);
            PG8_WAIT_V(6); PG8_BAR; PG8_MMA(1, 1, At, B1); PG8_BAR;
            PG8_LDB(B0, 1, 0); PG8_SCHED; PG8_LDA(At, 1, 0); PG8_STAGE(PG8_SA(0, 1), a2 + hstep, voffA);
            PG8_WAIT_L(8); PG8_BAR; PG8_WAIT_L(0); PG8_MMA(0, 0, At, B0); PG8_BAR; PG8_SCHED;
            PG8_LDB(B1, 1, 1); PG8_STAGE(PG8_SB(1, 0), b3, voffB);
            PG8_BAR; PG8_WAIT_L(0); PG8_MMA(0, 1, At, B1); PG8_BAR;
            PG8_LDA(At, 1, 1); PG8_STAGE(PG8_SA(1, 0), a3, voffA);
            PG8_BAR; PG8_WAIT_L(0); PG8_MMA(1, 0, At, B0); PG8_BAR; PG8_SCHED;
            PG8_STAGE(PG8_SB(1, 1), b3 + hstep, voffB);
            PG8_WAIT_V(6); PG8_BAR; PG8_MMA(1, 1, At, B1); PG8_BAR;
            }
        }
        if constexpr (ALIGN_EPI) { if (wr == 0) PG8_BAR; }
        if constexpr (!Epi::AFTER_DRAIN) { E(acc, cur, wr, wc, fr, fq); S.done(cur); }
        if (!has_next) break;
#pragma unroll
        for (int a = 0; a < 2; ++a)
#pragma unroll
            for (int b = 0; b < 2; ++b)
#pragma unroll
                for (int m = 0; m < 4; ++m)
#pragma unroll
                    for (int n = 0; n < 2; ++n) acc[a][b][m][n] = (f32x4){0.f, 0.f, 0.f, 0.f};
        cur = nxt; cA = nA; cB = nB; ++ui;
        if constexpr (ALIGN_EPI) { if (wr == 1) PG8_BAR; }
    }
    PG8_WAIT_V(0);
    if constexpr (!ALIGN_EPI) { if (wr == 0) PG8_BAR; }
    PG8_BAR;
    if constexpr (Epi::AFTER_DRAIN) { E.fused(acc, cur, wr, wc, fr, fq, lds, wid, lane); S.done(cur); }
#undef PG8_SA
#undef PG8_SB
#undef PG8_STAGE
#undef PG8_LDA
#undef PG8_LDB
#undef PG8_MMA
#undef PG8_WAIT_V
#undef PG8_WAIT_L
#undef PG8_BAR
#undef PG8_SCHED
}
}

constexpr int DM = 1024, NBATCH = 8, SEQ = 4096, DECB = 128, DECS = 8;
constexpr int MP = NBATCH * SEQ, MS = DECB * DECS, MT = MP + MS;
constexpr int HD = 64, NH = 16, NKV = 4, WIN = 128, KVW = 256;
constexpr int SHW = 3200, INC = 8832;
constexpr int N1A = 2560, N1B = 6400, N1 = N1A + N1B;
constexpr float NORM_EPS = 1e-6f, GN_EPS = 64e-5f;

constexpr size_t O_Y = 0;
constexpr size_t O_PKW = (size_t)MT * DM;
constexpr size_t O_PVW = O_PKW + (size_t)NBATCH * WIN * KVW;
constexpr size_t O_PWKV = O_PVW + (size_t)NBATCH * WIN * KVW;
constexpr size_t O_PSH = O_PWKV + (size_t)NBATCH * NH * HD * HD;
constexpr size_t O_SKW = O_PSH + (size_t)NBATCH * SHW;
constexpr size_t O_SVW = O_SKW + (size_t)DECB * WIN * KVW;
constexpr size_t O_SWKV = O_SVW + (size_t)DECB * WIN * KVW;
constexpr size_t O_SSH = O_SWKV + (size_t)DECB * NH * HD * HD;
constexpr size_t O_END = O_SSH + (size_t)DECB * SHW;
static_assert(O_END == 52864000, "output size");

constexpr size_t MiB = 1u << 20;
constexpr size_t WS_CTL = 0, CTL_ZERO_BYTES = 1 * MiB;
constexpr size_t WS_SS = 512 * 1024;
constexpr size_t WS_ZROW = 900 * 1024;
constexpr size_t WS_SROW = 1 * MiB;
constexpr size_t WS_W1T = 2 * MiB;
constexpr size_t WS_WAT = 20 * MiB, WS_WBT = 22 * MiB, WS_WOT = 24 * MiB;
constexpr size_t WS_XN = 26 * MiB;
constexpr size_t WS_Q = 92 * MiB;
constexpr size_t WS_K = 158 * MiB;
constexpr size_t WS_V = WS_K + (size_t)MT * KVW * 2;
constexpr size_t WS_GA = 191 * MiB;
constexpr size_t WS_PS = 257 * MiB;
constexpr size_t WS_END = 464 * MiB;
static_assert(WS_W1T + (size_t)N1 * DM * 2 <= WS_WAT && WS_V + (size_t)MT * KVW * 2 <= WS_GA && WS_PS + (size_t)MT * SHW * 2 <= WS_END, "ws map");

constexpr int CW_BAR = 4096;

constexpr int RING_BYTES = 131072;
constexpr int LDSCTL_OFF = RING_BYTES, MISC_OFF = LDSCTL_OFF + 320, SMALL_OFF = LDSCTL_OFF + 1024;
constexpr int LDS_BYTES = 163840;
constexpr int NWAVES = 8, NTHR = 512;

#define GAS __attribute__((address_space(1)))
#define LAS __attribute__((address_space(3)))
typedef unsigned short bf16;
typedef unsigned v4u __attribute__((ext_vector_type(4)));
typedef unsigned v2u __attribute__((ext_vector_type(2)));
typedef float f32x4 __attribute__((ext_vector_type(4)));
typedef float f32x16 __attribute__((ext_vector_type(16)));
typedef short bf16x8 __attribute__((ext_vector_type(8)));
typedef GAS unsigned gu32;
#define RLX_AGENT __ATOMIC_RELAXED, __HIP_MEMORY_SCOPE_AGENT
#define LDS_WAIT() asm volatile("s_waitcnt lgkmcnt(0)" ::: "memory")
#define VM_WAIT() asm volatile("s_waitcnt vmcnt(0)" ::: "memory")
__device__ __forceinline__ unsigned f2bf(float f) { unsigned u = __builtin_bit_cast(unsigned, f); return (u + 0x7fffu + ((u >> 16) & 1u)) >> 16; }
__device__ __forceinline__ unsigned pk2(float lo, float hi) { return f2bf(lo) | (f2bf(hi) << 16); }
__device__ __forceinline__ float bflo(unsigned u) { return __builtin_bit_cast(float, u << 16); }
__device__ __forceinline__ float bfhi(unsigned u) { return __builtin_bit_cast(float, u & 0xffff0000u); }
__device__ __forceinline__ float sigmoidf_(float x) { return __builtin_amdgcn_rcpf(1.0f + __expf(-x)); }

#define XB_TMO      128
#define XB_XCNT(j)  (256  + 64 * (j))
#define XB_XSUB(j)  (1280 + 64 * (j))
#define XB_XGEN(j)  (2304 + 64 * (j))
#define XB_TOP      3328
#define XB_TOPGEN   3392
#define XCD_BAR_WORDS 3456
#define XB_SPIN_CAP (1u << 23)
__device__ __forceinline__ unsigned xb_ld(unsigned* p)              { return __hip_atomic_load(p, __ATOMIC_RELAXED, __HIP_MEMORY_SCOPE_AGENT); }
__device__ __forceinline__ unsigned xb_add(unsigned* p, unsigned v) { return __hip_atomic_fetch_add(p, v, __ATOMIC_RELAXED, __HIP_MEMORY_SCOPE_AGENT); }
__device__ __forceinline__ unsigned xb_xcc_id() { return (unsigned)__builtin_amdgcn_s_getreg((3 << 11) | 20) & 0xFu; }
#define XB_SPIN(cond, bar) do { unsigned _sp = 0; while (cond) { __builtin_amdgcn_s_sleep(1); \
    if ((++_sp & 255u) == 0u) { if (xb_ld(&(bar)[XB_TMO])) break; if (_sp > XB_SPIN_CAP) { atomicAdd(&(bar)[XB_TMO], 1u); break; } } } } while (0)
struct XcdBarrier { unsigned* bar; unsigned x; volatile LAS unsigned* st; };
__device__ __forceinline__ XcdBarrier xcd_barrier_post(unsigned* bar, volatile LAS unsigned* st) {
    XcdBarrier b; b.bar = bar; b.x = xb_xcc_id(); b.st = st;
    if (threadIdx.x == 0) (void)xb_add(&bar[XB_XCNT(b.x)], 1u);
    return b;
}
__device__ __forceinline__ void xcd_barrier_complete(unsigned* bar, unsigned x, unsigned& nloc, unsigned& nx) {
    const unsigned G = gridDim.x * gridDim.y * gridDim.z;
    unsigned sum, cnt, mine, sp = 0u;
    for (;;) {
        sum = 0u; cnt = 0u; mine = 0u;
#pragma unroll
        for (unsigned j = 0; j < 16; ++j) { const unsigned c = xb_ld(&bar[XB_XCNT(j)]); sum += c; cnt += (c > 0u) ? 1u : 0u; mine = (j == x) ? c : mine; }
        if (sum == G) break;
        __builtin_amdgcn_s_sleep(1);
        if ((++sp & 255u) == 0u) { if (xb_ld(&bar[XB_TMO])) break; if (sp > XB_SPIN_CAP) { atomicAdd(&bar[XB_TMO], 1u); break; } }
    }
    nloc = mine > 0u ? mine : 1u; nx = cnt > 0u ? cnt : 1u;
}
__device__ __forceinline__ void xcd_barrier(const XcdBarrier& b) {
    asm volatile("s_waitcnt vmcnt(0)" ::: "memory");
    __syncthreads();
    if (threadIdx.x == 0) {
        unsigned* bar = b.bar;
        __builtin_amdgcn_s_waitcnt(0);
        unsigned nloc = b.st[0], nx = b.st[1];
        if (nloc == 0u) { xcd_barrier_complete(bar, b.x, nloc, nx); b.st[0] = nloc; b.st[1] = nx; }
        const unsigned old = xb_add(&bar[XB_XSUB(b.x)], 1u);
        const unsigned gen = old / nloc;
        if (old + 1u == (gen + 1u) * nloc) {
            __builtin_amdgcn_fence(__ATOMIC_RELEASE, "agent");
            asm volatile("s_waitcnt vmcnt(0)" ::: "memory");
            const unsigned og = xb_add(&bar[XB_TOP], 1u);
            const unsigned tg = og / nx;
            if (og + 1u == (tg + 1u) * nx) xb_add(&bar[XB_TOPGEN], 1u);
            else XB_SPIN(xb_ld(&bar[XB_TOPGEN]) == tg, bar);
            __builtin_amdgcn_fence(__ATOMIC_ACQUIRE, "agent");
            xb_add(&bar[XB_XGEN(b.x)], 1u);
            asm volatile("s_waitcnt vmcnt(0)" ::: "memory");
        } else {
            XB_SPIN(xb_ld(&bar[XB_XGEN(b.x)]) == gen, bar);
            __builtin_amdgcn_fence(__ATOMIC_ACQUIRE, "agent");
            asm volatile("s_waitcnt vmcnt(0)" ::: "memory");
        }
    }
    __syncthreads();
}

struct Args { const float* in[24]; float* out; unsigned char* ws; int ph_lo, ph_hi; };
static_assert(sizeof(Args) == 24 * 8 + 8 + 8 + 8, "no padding");
struct Frame {
    LAS unsigned char* lds;
    int wave, G, vcu;
    float* out; unsigned char* ws;
};
__device__ __forceinline__ int lane_id() { return (int)__builtin_amdgcn_mbcnt_hi(~0u, __builtin_amdgcn_mbcnt_lo(~0u, 0u)); }
enum { I_XP = 0, I_XS, I_CK, I_CV, I_SWKV, I_SSHIFT, I_RELB, I_NORMG, I_WIN, I_SINK, I_MU, I_W0, I_W2, I_A0, I_A2, I_KK, I_KA, I_RK, I_LNG, I_LNB, I_WOA, I_WOB, I_WO, I_FING };

__device__ __forceinline__ float wave_sum(float v) {
#pragma unroll
    for (int o = 1; o < 64; o <<= 1) v += __shfl_xor(v, o);
    return v;
}

__device__ __forceinline__ void p0_transpose_item(const float* W, int ldw, int srccol0, int K, bf16* WT, int dstrow0, LAS float* scr, int kb, int lane) {
    const int k0 = 64 * kb;
    if (srccol0 >= 0) {
#pragma unroll 8
        for (int i = 0; i < 32; ++i) { const int kk = 2 * i + (lane >> 5); scr[kk * 33 + (lane & 31)] = W[(size_t)(k0 + kk) * ldw + srccol0 + (lane & 31)]; }
    }
    LDS_WAIT(); asm volatile("" ::: "memory");
    const int c = lane & 7;
#pragma unroll
    for (int j = 0; j < 4; ++j) { const int n = (lane >> 3) + 8 * j; const LAS float* s = scr + (8 * c) * 33 + n;
        v4u o = (v4u){0u, 0u, 0u, 0u};
        if (srccol0 >= 0) { o.x = pk2(s[0 * 33], s[1 * 33]); o.y = pk2(s[2 * 33], s[3 * 33]); o.z = pk2(s[4 * 33], s[5 * 33]); o.w = pk2(s[6 * 33], s[7 * 33]); }
        *(GAS v4u*)(WT + (size_t)(dstrow0 + n) * K + k0 + 8 * c) = o; }
    LDS_WAIT(); asm volatile("" ::: "memory");
}
__device__ __forceinline__ void rms_row_to_bf16(const float* xrow, const float* g, bf16* orow, int lane) {
    const GAS f32x4* xr = (const GAS f32x4*)xrow + lane; const GAS f32x4* gr = (const GAS f32x4*)g + lane;
    f32x4 v[4]; float s = 0.f;
#pragma unroll
    for (int j = 0; j < 4; ++j) { v[j] = xr[64 * j]; s += (v[j].x * v[j].x + v[j].y * v[j].y) + (v[j].z * v[j].z + v[j].w * v[j].w); }
    const float sc = 1.0f / sqrtf(wave_sum(s) * (1.f / DM) + NORM_EPS);
    GAS v2u* o8 = (GAS v2u*)orow + lane;
#pragma unroll
    for (int j = 0; j < 4; ++j) { const f32x4 gv = gr[64 * j]; v2u o; o.x = pk2(v[j].x * sc * gv.x, v[j].y * sc * gv.y); o.y = pk2(v[j].z * sc * gv.z, v[j].w * sc * gv.w); o8[64 * j] = o; }
}
__device__ __forceinline__ void p0_prologue(const Frame& F, const Args& AR) {
    const int lane = lane_id();
    LAS float* scr = (LAS float*)(F.lds + F.wave * 16384);
    const int gw = F.vcu * NWAVES + F.wave, NGW = F.G * NWAVES;
    constexpr int I_1 = 16 * (N1 / 32), I_S = 16 * 32, NITEMS = I_1 + 3 * I_S;
    bf16* W1T = (bf16*)(F.ws + WS_W1T);
    for (int it = gw; it < NITEMS; it += NGW) {
        int r = it;
        if (r < I_1) { const int kb = r / (N1 / 32), nb = r % (N1 / 32), n0 = 32 * nb;
            const int src = n0 < 5760 ? n0 : (n0 < 5888 ? -1 : n0 - 128);
            p0_transpose_item(AR.in[I_WIN], INC, src, DM, W1T, n0, scr, kb, lane); continue; }
        r -= I_1;
        const int which = r / I_S; r -= which * I_S;
        const float* W = which == 0 ? AR.in[I_WOA] : (which == 1 ? AR.in[I_WOB] : AR.in[I_WO]);
        bf16* WT = (bf16*)(F.ws + (which == 0 ? WS_WAT : (which == 1 ? WS_WBT : WS_WOT)));
        p0_transpose_item(W, DM, 32 * (r % 32), DM, WT, 32 * (r % 32), scr, r / 32, lane);
    }
    { bf16* SR = (bf16*)(F.ws + WS_SROW); const float* ss = AR.in[I_SSHIFT];
      for (int i = gw * 64 + lane; i < DECB * SHW / 4; i += NGW * 64) { const f32x4 v = *(const f32x4*)(ss + (size_t)i * 4); v2u w; w.x = pk2(v.x, v.y); w.y = pk2(v.z, v.w); *(v2u*)(SR + (size_t)i * 4) = w; } }
    bf16* XN = (bf16*)(F.ws + WS_XN);
    for (int m = gw; m < MT; m += NGW) {
        const float* xr = m < MP ? AR.in[I_XP] + (size_t)m * DM : AR.in[I_XS] + (size_t)(m - MP) * DM;
        rms_row_to_bf16(xr, AR.in[I_NORMG], XN + (size_t)m * DM, lane);
    }
}

struct EpiG1 {
    static constexpr bool PERM = true, AFTER_DRAIN = false;
    int part; unsigned char* ws; float* out;
    __device__ __forceinline__ void operator()(const f32x4 (&acc)[2][2][4][2], const pg8::Unit& u, int wr, int wc, int fr, int fq) const {
        bf16* dst; int ld, act = 0, valid = 256, side = 0;
        const int pn = u.pn;
        if (part == 0) {
            if (pn < 4) { dst = (bf16*)(ws + WS_Q) + pn * 256; ld = DM; }
            else if (pn == 4) { dst = (bf16*)(ws + WS_K); ld = KVW; side = 1; }
            else if (pn == 5) { dst = (bf16*)(ws + WS_V); ld = KVW; side = 2; }
            else { dst = (bf16*)(ws + WS_GA) + (pn - 6) * 256; ld = DM; act = 1; }
        } else {
            if (pn < 13) { dst = (bf16*)(ws + WS_PS) + pn * 256; ld = SHW; side = 3; if (pn == 12) valid = 128; }
            else if (pn < 17) { dst = (bf16*)(ws + WS_GA) + (pn - 13) * 256; ld = DM; act = 1; }
            else if (pn < 21) { dst = (bf16*)out + (pn - 17) * 256; ld = DM; act = 2; }
            else { dst = (bf16*)out + (size_t)MT * DM + (pn - 21) * 256; ld = DM; act = 2; }
        }
        const int rt0 = wr * 64 + fr, cit0 = wc * 32 + 8 * fq;
#pragma unroll
        for (int ai = 0; ai < 2; ++ai)
#pragma unroll
            for (int m = 0; m < 4; ++m) { bf16* rowp = dst + (size_t)(u.pm * 256 + rt0 + ai * 128 + m * 16) * ld + cit0;
#pragma unroll
                for (int bj = 0; bj < 2; ++bj) { if (bj * 128 >= valid) continue;
                    f32x4 v0 = acc[ai][bj][m][0], v1 = acc[ai][bj][m][1];
                    if (act) {
#pragma unroll
                        for (int e = 0; e < 4; ++e) { const float s0 = sigmoidf_(v0[e]), s1 = sigmoidf_(v1[e]); v0[e] = act == 1 ? v0[e] * s0 : s0; v1[e] = act == 1 ? v1[e] * s1 : s1; }
                    }
                    pg8::u32x4 w; w.x = pg8::cvt_pk_bf16(v0[0], v0[1]); w.y = pg8::cvt_pk_bf16(v0[2], v0[3]); w.z = pg8::cvt_pk_bf16(v1[0], v1[1]); w.w = pg8::cvt_pk_bf16(v1[2], v1[3]);
                    *(pg8::u32x4*)(rowp + bj * 128) = w; } }
        int r0 = rt0, c0 = cit0;
        if (side) asm volatile("" : "+v"(r0), "+v"(c0));
        if (side == 1 || side == 2) {
            if (u.pm < 128) {
                if ((u.pm & 15) == 15) { float* base = out + (side == 1 ? O_PKW : O_PVW) + (size_t)(u.pm >> 4) * WIN * KVW;
#pragma unroll
                    for (int m = 0; m < 4; ++m) { float* rp = base + (size_t)(r0 + m * 16) * KVW + c0;
#pragma unroll
                        for (int bj = 0; bj < 2; ++bj)
#pragma unroll
                            for (int n = 0; n < 2; ++n) *(f32x4*)(rp + bj * 128 + 4 * n) = acc[1][bj][m][n]; } }
            } else { float* base = out + (side == 1 ? O_SKW : O_SVW);
#pragma unroll
                for (int ai = 0; ai < 2; ++ai)
#pragma unroll
                    for (int m = 0; m < 4; ++m) { const int rs = (u.pm - 128) * 256 + r0 + ai * 128 + m * 16; float* rp = base + ((size_t)(rs >> 3) * WIN + 120 + (rs & 7)) * KVW + c0;
#pragma unroll
                        for (int bj = 0; bj < 2; ++bj)
#pragma unroll
                            for (int n = 0; n < 2; ++n) *(f32x4*)(rp + bj * 128 + 4 * n) = acc[ai][bj][m][n]; }
            }
        } else if (side == 3) {
            if (u.pm < 128) {
                if ((u.pm & 15) == 15 && wr == 1 && fr == 15) { float* rp = out + O_PSH + (size_t)(u.pm >> 4) * SHW + pn * 256 + c0;
#pragma unroll
                    for (int bj = 0; bj < 2; ++bj) { if (bj * 128 >= valid) continue;
#pragma unroll
                        for (int n = 0; n < 2; ++n) *(f32x4*)(rp + bj * 128 + 4 * n) = acc[1][bj][3][n]; } }
            } else if ((fr & 7) == 7) {
#pragma unroll
                for (int ai = 0; ai < 2; ++ai)
#pragma unroll
                    for (int m = 0; m < 4; ++m) { const int rs = (u.pm - 128) * 256 + r0 + ai * 128 + m * 16; float* rp = out + O_SSH + (size_t)(rs >> 3) * SHW + pn * 256 + c0;
#pragma unroll
                        for (int bj = 0; bj < 2; ++bj) { if (bj * 128 >= valid) continue;
#pragma unroll
                            for (int n = 0; n < 2; ++n) *(f32x4*)(rp + bj * 128 + 4 * n) = acc[ai][bj][m][n]; } }
            }
        }
    }
};
struct EpiGate {
    static constexpr bool PERM = true, AFTER_DRAIN = false;
    int mode; const bf16* gate; const bf16* tin; bf16* dst;
    __device__ __forceinline__ void operator()(const f32x4 (&acc)[2][2][4][2], const pg8::Unit& u, int wr, int wc, int fr, int fq) const {
        const int rt0 = u.pm * 256 + wr * 64 + fr, c0 = u.pn * 256 + wc * 32 + 8 * fq;
#pragma unroll
        for (int ai = 0; ai < 2; ++ai)
#pragma unroll
            for (int m = 0; m < 4; ++m) { const size_t ro = (size_t)(rt0 + ai * 128 + m * 16) * DM + c0;
#pragma unroll
                for (int bj = 0; bj < 2; ++bj) {
                    const v4u g = *(const v4u*)(gate + ro + bj * 128);
                    f32x4 v0 = acc[ai][bj][m][0], v1 = acc[ai][bj][m][1];
                    v0[0] *= bflo(g.x); v0[1] *= bfhi(g.x); v0[2] *= bflo(g.y); v0[3] *= bfhi(g.y); v1[0] *= bflo(g.z); v1[1] *= bfhi(g.z); v1[2] *= bflo(g.w); v1[3] *= bfhi(g.w);
                    if (mode == 1) { const v4u t = *(const v4u*)(tin + ro + bj * 128);
                        v0[0] += bflo(t.x); v0[1] += bfhi(t.x); v0[2] += bflo(t.y); v0[3] += bfhi(t.y); v1[0] += bflo(t.z); v1[1] += bfhi(t.z); v1[2] += bflo(t.w); v1[3] += bfhi(t.w); }
                    pg8::u32x4 w; w.x = pg8::cvt_pk_bf16(v0[0], v0[1]); w.y = pg8::cvt_pk_bf16(v0[2], v0[3]); w.z = pg8::cvt_pk_bf16(v1[0], v1[1]); w.w = pg8::cvt_pk_bf16(v1[2], v1[3]);
                    *(pg8::u32x4*)(dst + ro + bj * 128) = w; } }
    }
};
struct EpiOut {
    static constexpr bool PERM = false, AFTER_DRAIN = false;
    const float* xp; const float* xs; float* out; float* ss;
    __device__ __forceinline__ void operator()(const f32x4 (&acc)[2][2][4][2], const pg8::Unit& u, int wr, int wc, int fr, int fq) const {
        const int rt0 = u.pm * 256 + wr * 64 + fr, c0 = u.pn * 256 + wc * 32 + 4 * fq;
#pragma unroll
        for (int ai = 0; ai < 2; ++ai)
#pragma unroll
            for (int m = 0; m < 4; ++m) { const int row = rt0 + ai * 128 + m * 16;
                const float* xr = (row < MP ? xp + (size_t)row * DM : xs + (size_t)(row - MP) * DM) + c0; float* orow = out + (size_t)row * DM + c0; float s = 0.f;
#pragma unroll
                for (int bj = 0; bj < 2; ++bj)
#pragma unroll
                    for (int n = 0; n < 2; ++n) { const f32x4 xv = *(const f32x4*)(xr + bj * 128 + n * 16); const f32x4 o = xv + acc[ai][bj][m][n];
                        *(f32x4*)(orow + bj * 128 + n * 16) = o; s += (o[0] * o[0] + o[1] * o[1]) + (o[2] * o[2] + o[3] * o[3]); }
                s += __shfl_xor(s, 16); s += __shfl_xor(s, 32);
                if (fq == 0) atomicAdd(ss + row, s); }
    }
};

__device__ const unsigned char T5B[132] = {0, 1, 2, 3, 4, 5, 6, 7, 8, 9, 10, 11, 12, 13, 14, 15, 16, 16, 16, 17, 17, 18, 18, 18, 19, 19, 19, 20, 20, 20, 20, 21, 21, 21, 21, 22, 22, 22, 22, 22, 23, 23, 23, 23, 23, 23, 24, 24, 24, 24, 24, 24, 25, 25, 25, 25, 25, 25, 25, 26, 26, 26, 26, 26, 26, 26, 26, 27, 27, 27, 27, 27, 27, 27, 27, 27, 27, 28, 28, 28, 28, 28, 28, 28, 28, 28, 28, 29, 29, 29, 29, 29, 29, 29, 29, 29, 29, 29, 29, 30, 30, 30, 30, 30, 30, 30, 30, 30, 30, 30, 30, 30, 30, 31, 31, 31, 31, 31, 31, 31, 31, 31, 31, 31, 31, 31, 31, 31, 31, 31, 31, 31};
constexpr int AT_KP = 144, AT_VP = 520, AT_VT_OFF = 256 * AT_KP, AT_BT_OFF = AT_VT_OFF + 64 * AT_VP;
__device__ __forceinline__ int crow(int r, int hi) { return (r & 3) + 8 * (r >> 2) + 4 * hi; }

template <int MODE>
__device__ __forceinline__ void attn_task(const Frame& F, const Args& AR, bf16* OB_, int b, int kvh, int n, int g_, int i) {
    LAS unsigned char* KL = F.lds; LAS unsigned char* VT = F.lds + AT_VT_OFF; LAS float* BT = (LAS float*)(F.lds + AT_BT_OFF);
    const int lane = lane_id(), q = lane & 31, hi = lane >> 5;
    int g, mq, dq;
    if (MODE == 0) { g = g_; mq = b * SEQ + n * 128 + 32 * i + q; dq = 128 + q; }
    else { g = q >> 3; mq = MP + b * DECS + (q & 7); dq = 128 + (q & 7); }
    const int h = kvh * 4 + g;
    bf16* QO = (bf16*)(F.ws + WS_Q); const bf16* GA = (const bf16*)(F.ws + WS_GA);
    bf16x8 qf[4];
    { const bf16* qp = QO + (size_t)mq * DM + h * HD + 8 * hi;
#pragma unroll
      for (int s = 0; s < 4; ++s) qf[s] = *(const bf16x8*)(qp + 16 * s); }
    const int kt0 = MODE == 0 ? i : 0;
    f32x16 sc[5];
    const float sink = AR.in[I_SINK][h];
    const LAS float* bt = BT + g * 192 + 32 + dq - 4 * hi;
    float mx = sink;
#pragma unroll
    for (int t = 0; t < 5; ++t) { const LAS unsigned char* kp = KL + (32 * (kt0 + t) + q) * AT_KP + 16 * hi; f32x16 a = {0.f, 0.f, 0.f, 0.f, 0.f, 0.f, 0.f, 0.f, 0.f, 0.f, 0.f, 0.f, 0.f, 0.f, 0.f, 0.f};
#pragma unroll
        for (int s = 0; s < 4; ++s) { const bf16x8 kf = *(const LAS bf16x8*)(kp + 32 * s); a = __builtin_amdgcn_mfma_f32_32x32x16_bf16(kf, qf[s], a, 0, 0, 0); }
        const bool dead = (MODE == 0) && n == 0 && (i + t) < 4;
#pragma unroll
        for (int r = 0; r < 16; ++r) { const int kb0 = 32 * t + (r & 3) + 8 * (r >> 2);
            float sv = a[r] * 0.125f + bt[-kb0]; sv = dead ? -INFINITY : sv; a[r] = sv; mx = fmaxf(mx, sv); }
        sc[t] = a;
        __builtin_amdgcn_sched_barrier(0); }
    mx = fmaxf(mx, __shfl_xor(mx, 32));
    float sum = 0.f;
#pragma unroll
    for (int t = 0; t < 5; ++t)
#pragma unroll
        for (int r = 0; r < 16; ++r) { const float p = __expf(sc[t][r] - mx); sum += p; sc[t][r] = p; }
    sum += __shfl_xor(sum, 32); sum += __expf(sink - mx);
    const float inv = 1.0f / sum;
    f32x16 o[2];
#pragma unroll
    for (int d = 0; d < 2; ++d) o[d] = (f32x16){0.f, 0.f, 0.f, 0.f, 0.f, 0.f, 0.f, 0.f, 0.f, 0.f, 0.f, 0.f, 0.f, 0.f, 0.f, 0.f};
#pragma unroll
    for (int t = 0; t < 5; ++t)
#pragma unroll
        for (int s2 = 0; s2 < 2; ++s2) {
            v4u pw; pw.x = pk2(sc[t][8 * s2 + 0], sc[t][8 * s2 + 1]); pw.y = pk2(sc[t][8 * s2 + 2], sc[t][8 * s2 + 3]); pw.z = pk2(sc[t][8 * s2 + 4], sc[t][8 * s2 + 5]); pw.w = pk2(sc[t][8 * s2 + 6], sc[t][8 * s2 + 7]);
            const bf16x8 pb = __builtin_bit_cast(bf16x8, pw);
#pragma unroll
            for (int d = 0; d < 2; ++d) { const LAS unsigned char* vp = VT + (32 * d + q) * AT_VP + (32 * (kt0 + t) + 16 * s2 + 4 * hi) * 2;
                const v2u lo = *(const LAS v2u*)vp, hi2 = *(const LAS v2u*)(vp + 16);
                v4u aw; aw.x = lo.x; aw.y = lo.y; aw.z = hi2.x; aw.w = hi2.y;
                o[d] = __builtin_amdgcn_mfma_f32_32x32x16_bf16(__builtin_bit_cast(bf16x8, aw), pb, o[d], 0, 0, 0); }
            __builtin_amdgcn_sched_barrier(0); }
    bf16* op = OB_ + (size_t)mq * DM + h * HD; const bf16* gp = GA + (size_t)mq * DM + h * HD;
#pragma unroll
    for (int d = 0; d < 2; ++d)
#pragma unroll
        for (int rq = 0; rq < 4; ++rq) { const int dv0 = 32 * d + 8 * rq + 4 * hi; const v2u gv = *(const v2u*)(gp + dv0);
            v2u w; w.x = pk2(o[d][4 * rq + 0] * inv * bflo(gv.x), o[d][4 * rq + 1] * inv * bfhi(gv.x)); w.y = pk2(o[d][4 * rq + 2] * inv * bflo(gv.y), o[d][4 * rq + 3] * inv * bfhi(gv.y));
            *(v2u*)(op + dv0) = w; }
}

__device__ __forceinline__ void attn_unit(const Frame& F, const Args& AR, int unit, bf16* OB_) {
    LAS unsigned char* KL = F.lds; LAS unsigned char* VT = F.lds + AT_VT_OFF; LAS float* BT = (LAS float*)(F.lds + AT_BT_OFF);
    const bf16* Kb = (const bf16*)(F.ws + WS_K); const bf16* Vb = (const bf16*)(F.ws + WS_V);
    const int tid = F.wave * 64 + lane_id();
    __syncthreads();
    int b, kvh, n = 0;
    const bool sample = unit >= 1024;
    if (!sample) {
        kvh = unit & 3; n = (unit >> 2) & 31; b = unit >> 7;
        const int t0 = (n - 1) * 128;
#pragma unroll
        for (int it = 0; it < 4; ++it) { const int c = it * NTHR + tid, key = c >> 3, part = c & 7, tok = t0 + key; v4u val = (v4u){0u, 0u, 0u, 0u};
            if (tok >= 0) val = *(const v4u*)(Kb + (size_t)(b * SEQ + tok) * KVW + kvh * HD + part * 8);
            *(LAS v4u*)(KL + key * AT_KP + part * 16) = val; }
#pragma unroll
        for (int it = 0; it < 4; ++it) { const int c = it * NTHR + tid, key = c & 255, part = c >> 8, tok = t0 + key; v4u val = (v4u){0u, 0u, 0u, 0u};
            if (tok >= 0) val = *(const v4u*)(Vb + (size_t)(b * SEQ + tok) * KVW + kvh * HD + part * 8);
            LAS bf16* vt = (LAS bf16*)(VT + (part * 8) * AT_VP + key * 2);
            vt[0 * (AT_VP / 2)] = (bf16)val.x; vt[1 * (AT_VP / 2)] = (bf16)(val.x >> 16); vt[2 * (AT_VP / 2)] = (bf16)val.y; vt[3 * (AT_VP / 2)] = (bf16)(val.y >> 16);
            vt[4 * (AT_VP / 2)] = (bf16)val.z; vt[5 * (AT_VP / 2)] = (bf16)(val.z >> 16); vt[6 * (AT_VP / 2)] = (bf16)val.w; vt[7 * (AT_VP / 2)] = (bf16)(val.w >> 16); }
    } else {
        const int su = unit - 1024; kvh = su & 3; b = su >> 2;
        for (int c = tid; c < 160 * 8; c += NTHR) {
            { const int key = c >> 3, part = c & 7; v4u val = (v4u){0u, 0u, 0u, 0u};
              if (key < 128) { const float* src = AR.in[I_CK] + ((size_t)(b * WIN + key) * NKV + kvh) * HD + part * 8; const f32x4 a = *(const f32x4*)src, bb = *(const f32x4*)(src + 4);
                  val.x = pk2(a.x, a.y); val.y = pk2(a.z, a.w); val.z = pk2(bb.x, bb.y); val.w = pk2(bb.z, bb.w);
                  if (key >= 8) { float* d = F.out + O_SKW + ((size_t)(b * WIN + key - 8) * NKV + kvh) * HD + part * 8; *(f32x4*)d = a; *(f32x4*)(d + 4) = bb; } }
              else if (key < 136) val = *(const v4u*)(Kb + (size_t)(MP + b * DECS + key - 128) * KVW + kvh * HD + part * 8);
              *(LAS v4u*)(KL + key * AT_KP + part * 16) = val; }
            { const int key = c % 160, part = c / 160; v4u val = (v4u){0u, 0u, 0u, 0u};
              if (key < 128) { const float* src = AR.in[I_CV] + ((size_t)(b * WIN + key) * NKV + kvh) * HD + part * 8; const f32x4 a = *(const f32x4*)src, bb = *(const f32x4*)(src + 4);
                  val.x = pk2(a.x, a.y); val.y = pk2(a.z, a.w); val.z = pk2(bb.x, bb.y); val.w = pk2(bb.z, bb.w);
                  if (key >= 8) { float* d = F.out + O_SVW + ((size_t)(b * WIN + key - 8) * NKV + kvh) * HD + part * 8; *(f32x4*)d = a; *(f32x4*)(d + 4) = bb; } }
              else if (key < 136) val = *(const v4u*)(Vb + (size_t)(MP + b * DECS + key - 128) * KVW + kvh * HD + part * 8);
              LAS bf16* vt = (LAS bf16*)(VT + (part * 8) * AT_VP + key * 2);
              vt[0 * (AT_VP / 2)] = (bf16)val.x; vt[1 * (AT_VP / 2)] = (bf16)(val.x >> 16); vt[2 * (AT_VP / 2)] = (bf16)val.y; vt[3 * (AT_VP / 2)] = (bf16)(val.y >> 16);
              vt[4 * (AT_VP / 2)] = (bf16)val.z; vt[5 * (AT_VP / 2)] = (bf16)(val.z >> 16); vt[6 * (AT_VP / 2)] = (bf16)val.w; vt[7 * (AT_VP / 2)] = (bf16)(val.w >> 16); }
        }
    }
    for (int idx = tid; idx < 4 * 192; idx += NTHR) { const int g = idx / 192, d = idx - g * 192 - 32; BT[idx] = (d >= 0 && d <= 128) ? AR.in[I_RELB][(int)T5B[d] * NH + kvh * 4 + g] : -INFINITY; }
    __syncthreads();
    if (!sample) { for (int task = F.wave; task < 16; task += NWAVES) attn_task<0>(F, AR, OB_, b, kvh, n, task >> 2, task & 3); }
    else if (F.wave == 0) attn_task<1>(F, AR, OB_, b, kvh, 0, 0, 0);
}

namespace s3 {
constexpr int P68 = 136, P36 = 72;
constexpr int W2T = 0, A2T = W2T + 64 * P68, PAR = A2T + 64 * P68, YT = PAR + 12 * 256  , XCH = YT + 2 * 4608  , GCRK = XCH + 1280  , SCR = GCRK + 12 * 384;
constexpr int RM0 = 0, RM1 = 2304, IMGV = 4608, IMG2 = 9216, SCRW = 13824;
constexpr int END = SCR + 6 * SCRW;
static_assert(END <= RING_BYTES && (YT % 16) == 0 && (SCR % 16) == 0, "scan LDS map");
constexpr int R_R2 = 0, R_Y02 = 4096, R_G = 8192, R_H = 16384, R_V = 24576, R_GC = 28672, R_RK = 28928, R_SIZE = 29184, RING = 12;
constexpr size_t RING_BYTES_WG = (size_t)RING * R_SIZE;
static_assert(128 * RING_BYTES_WG <= 66 * MiB && 64 * RING_BYTES_WG <= 33 * MiB, "record rings: prompt workgroups in the XN region, sample workgroups in the K/V region");
}
typedef float f32x2_t __attribute__((ext_vector_type(2))); typedef __bf16 bf16x2_t __attribute__((ext_vector_type(2)));
__device__ __forceinline__ unsigned cvtpk(float lo, float hi) { f32x2_t v = {lo, hi}; bf16x2_t b = __builtin_convertvector(v, bf16x2_t); return __builtin_bit_cast(unsigned, b); }
__device__ __forceinline__ bf16x8 frag_nat(LAS const unsigned char* base, int pitch, int row, int col0) {
    LAS const unsigned char* p = base + row * pitch + col0 * 2; const v2u a = *(LAS const v2u*)p, b = *(LAS const v2u*)(p + 8);
    v4u w; w.x = a.x; w.y = a.y; w.z = b.x; w.w = b.y; return __builtin_bit_cast(bf16x8, w); }
__device__ __forceinline__ bf16x8 frag_perm(LAS const unsigned char* base, int pitch, int row, int c0, int hi) {
    LAS const unsigned char* p = base + row * pitch + (c0 + 4 * hi) * 2; const v2u a = *(LAS const v2u*)p, b = *(LAS const v2u*)(p + 16);
    v4u w; w.x = a.x; w.y = a.y; w.z = b.x; w.w = b.y; return __builtin_bit_cast(bf16x8, w); }
__device__ __forceinline__ bf16x8 pk8(const f32x16& x, int s) {
    v4u w; w.x = cvtpk(x[8 * s + 0], x[8 * s + 1]); w.y = cvtpk(x[8 * s + 2], x[8 * s + 3]); w.z = cvtpk(x[8 * s + 4], x[8 * s + 5]); w.w = cvtpk(x[8 * s + 6], x[8 * s + 7]); return __builtin_bit_cast(bf16x8, w); }
__device__ __forceinline__ bf16x8 pk8f(const float* x) { v4u w; w.x = cvtpk(x[0], x[1]); w.y = cvtpk(x[2], x[3]); w.z = cvtpk(x[4], x[5]); w.w = cvtpk(x[6], x[7]); return __builtin_bit_cast(bf16x8, w); }
__device__ __forceinline__ void store_rm(LAS unsigned char* base, int pitch, const f32x16& x, int q, int hi) {
#pragma unroll
    for (int r = 0; r < 16; r += 2) { const unsigned w = cvtpk(x[r], x[r + 1]);
        *(LAS bf16*)(base + crow(r, hi) * pitch + 2 * q) = (bf16)w; *(LAS bf16*)(base + crow(r + 1, hi) * pitch + 2 * q) = (bf16)(w >> 16); }
}
__device__ __forceinline__ void store16bf(unsigned char* p, const f32x16& x) {
    v4u a, b; a.x = cvtpk(x[0], x[1]); a.y = cvtpk(x[2], x[3]); a.z = cvtpk(x[4], x[5]); a.w = cvtpk(x[6], x[7]); b.x = cvtpk(x[8], x[9]); b.y = cvtpk(x[10], x[11]); b.z = cvtpk(x[12], x[13]); b.w = cvtpk(x[14], x[15]);
    *(v4u*)p = a; *(v4u*)(p + 16) = b; }
__device__ __forceinline__ f32x16 load16bf(const unsigned char* p) {
    const v4u a = *(const v4u*)p, b = *(const v4u*)(p + 16);
    return (f32x16){bflo(a.x), bfhi(a.x), bflo(a.y), bfhi(a.y), bflo(a.z), bfhi(a.z), bflo(a.w), bfhi(a.w), bflo(b.x), bfhi(b.x), bflo(b.y), bfhi(b.y), bflo(b.z), bfhi(b.z), bflo(b.w), bfhi(b.w)}; }
#define MFMA32(a, b, c) __builtin_amdgcn_mfma_f32_32x32x16_bf16((a), (b), (c), 0, 0, 0)
#define ZERO16 ((f32x16){0.f, 0.f, 0.f, 0.f, 0.f, 0.f, 0.f, 0.f, 0.f, 0.f, 0.f, 0.f, 0.f, 0.f, 0.f, 0.f})
#define DPPV(x, ctrl, rowmask) __builtin_bit_cast(float, __builtin_amdgcn_update_dpp(0, __builtin_bit_cast(int, (x)), (ctrl), (rowmask), 0xF, true))
__device__ __forceinline__ float tanh_fast(float x) { return 1.0f - 2.0f * __builtin_amdgcn_rcpf(__expf(2.0f * x) + 1.0f); }
__device__ __forceinline__ float xhalf_sum(float x) { return x + __shfl_xor(x, 32); }

__device__ __forceinline__ void s1_stage(LAS unsigned char* stg, const bf16* PS, size_t row0, const bf16* vrow, int col0, int nrows, int lane) {
    v4u x[5];
#pragma unroll
    for (int i = 0; i < 5; ++i) { const int p = lane + 64 * i; int row = p >> 3; const int piece = p & 7; if (row > nrows) row = nrows;
        const bf16* rp = (row == 0 && vrow) ? vrow : PS + (row0 + row - 1) * SHW;
        if (i < 4 || lane < 8) x[i] = *(const v4u*)(rp + col0 + piece * 8); }
#pragma unroll
    for (int i = 0; i < 5; ++i) { const int p = lane + 64 * i; const int row = p >> 3, piece = p & 7;
        if (i < 4 || lane < 8) { LAS unsigned char* d = stg + row * 136 + piece * 16; *(LAS v2u*)d = (v2u){x[i].x, x[i].y}; *(LAS v2u*)(d + 8) = (v2u){x[i].z, x[i].w}; } }
}
__device__ __forceinline__ f32x4 s1_z4(LAS const unsigned char* stg, int t, int off, f32x4 mu, bool act) {
    const v2u cu = *(LAS const v2u*)(stg + (t + 1) * 136 + off), pu = *(LAS const v2u*)(stg + t * 136 + off);
    const f32x4 cur = {bflo(cu.x), bfhi(cu.x), bflo(cu.y), bfhi(cu.y)}, prv = {bflo(pu.x), bfhi(pu.x), bflo(pu.y), bfhi(pu.y)};
    f32x4 z = cur + (prv - cur) * mu;
    if (!act) z = (f32x4){0.f, 0.f, 0.f, 0.f};
    return z;
}

__device__ __forceinline__ void s1_chunk(const Args& AR, LAS unsigned char* L, LAS unsigned char* scr, unsigned char* rec, LAS float* gcrk, const bf16* PS, size_t row0, const bf16* vrow  , int h, int ntok, int lane_) {
    int lane = lane_; asm volatile("" : "+v"(lane));
    const int t = lane & 31, hh = lane >> 5;
    const bool act = t < ntok;
    LAS unsigned char* stg = scr + s3::RM0;
    float lw[32]; unsigned asgp[16];
    {
        bf16x8 TWf[4], ALf[4];
        s1_stage(stg, PS, row0, vrow, 3072, ntok, lane);
#pragma unroll
        for (int s = 0; s < 4; ++s) { const int jb = 16 * s + 8 * hh;
            const f32x4 w0 = s1_z4(stg, t, jb * 2, *(LAS const f32x4*)(L + s3::PAR + 10 * 256 + jb * 4), act), w1 = s1_z4(stg, t, jb * 2 + 8, *(LAS const f32x4*)(L + s3::PAR + 10 * 256 + (jb + 4) * 4), act);
            const float tw[8] = {tanh_fast(w0[0]), tanh_fast(w0[1]), tanh_fast(w0[2]), tanh_fast(w0[3]), tanh_fast(w1[0]), tanh_fast(w1[1]), tanh_fast(w1[2]), tanh_fast(w1[3])};
            TWf[s] = pk8f(tw); }
        __builtin_amdgcn_sched_barrier(0);
        s1_stage(stg, PS, row0, vrow, 3136, ntok, lane);
#pragma unroll
        for (int s = 0; s < 4; ++s) { const int jb = 16 * s + 8 * hh;
            const f32x4 a0 = s1_z4(stg, t, jb * 2, *(LAS const f32x4*)(L + s3::PAR + 11 * 256 + jb * 4), act), a1 = s1_z4(stg, t, jb * 2 + 8, *(LAS const f32x4*)(L + s3::PAR + 11 * 256 + (jb + 4) * 4), act);
            const float al[8] = {a0[0], a0[1], a0[2], a0[3], a1[0], a1[1], a1[2], a1[3]};
            ALf[s] = pk8f(al); }
        __builtin_amdgcn_sched_barrier(0);
        f32x16 uw[2] = {ZERO16, ZERO16}, ua[2] = {ZERO16, ZERO16};
#pragma unroll
        for (int ct = 0; ct < 2; ++ct)
#pragma unroll
            for (int s = 0; s < 4; ++s) { uw[ct] = MFMA32(frag_nat(L + s3::W2T, s3::P68, 32 * ct + t, 16 * s + 8 * hh), TWf[s], uw[ct]);
                                          ua[ct] = MFMA32(frag_nat(L + s3::A2T, s3::P68, 32 * ct + t, 16 * s + 8 * hh), ALf[s], ua[ct]);
                                          if (s & 1) __builtin_amdgcn_sched_barrier(0); }
#pragma unroll
        for (int u = 0; u < 8; ++u) { const int chb = 8 * u + 4 * hh; const f32x4 w0 = *(LAS const f32x4*)(L + s3::PAR + 0 * 256 + chb * 4), a0 = *(LAS const f32x4*)(L + s3::PAR + 1 * 256 + chb * 4);
            float ag[4];
#pragma unroll
            for (int j = 0; j < 4; ++j) { const int sl = 4 * u + j;
                lw[sl] = act ? -0.6065306597126334f * sigmoidf_(uw[sl >> 4][sl & 15] + w0[j]) : 0.f; ag[j] = sigmoidf_(ua[sl >> 4][sl & 15] + a0[j]); }
            asgp[2 * u] = cvtpk(ag[0], ag[1]); asgp[2 * u + 1] = cvtpk(ag[2], ag[3]);
            if (u & 1) __builtin_amdgcn_sched_barrier(0); }
    }
    __builtin_amdgcn_sched_barrier(0);
#define Lc lw
#pragma unroll
    for (int sl = 0; sl < 32; ++sl) { float x = lw[sl];
        x += DPPV(x, 0x111, 0xF); x += DPPV(x, 0x112, 0xF); x += DPPV(x, 0x114, 0xF); x += DPPV(x, 0x118, 0xF);
        x += __builtin_bit_cast(float, __builtin_amdgcn_update_dpp(0, __builtin_bit_cast(int, x), 0x142, 0xA, 0xF, false));
        Lc[sl] = x; }
    __builtin_amdgcn_sched_barrier(0);
    {
        float zv[32]; bf16x8 Vf[4];
        s1_stage(stg, PS, row0, vrow, 2 * 1024 + h * HD, ntok, lane);
#pragma unroll
        for (int u = 0; u < 8; ++u) { const int chb = 8 * u + 4 * hh;
            const f32x4 c = s1_z4(stg, t, chb * 2, *(LAS const f32x4*)(L + s3::PAR + 9 * 256 + chb * 4), act);
#pragma unroll
            for (int j = 0; j < 4; ++j) zv[4 * u + j] = c[j]; }
#pragma unroll
        for (int s = 0; s < 4; ++s) Vf[s] = pk8f(zv + 8 * s);
#pragma unroll
        for (int u = 0; u < 8; ++u)
#pragma unroll
            for (int j = 0; j < 4; j += 2) { const unsigned w = cvtpk(zv[4 * u + j], zv[4 * u + j + 1]);
                *(LAS bf16*)(scr + s3::IMGV + (8 * u + 4 * hh + j) * s3::P36 + 2 * t) = (bf16)w; *(LAS bf16*)(scr + s3::IMGV + (8 * u + 4 * hh + j + 1) * s3::P36 + 2 * t) = (bf16)(w >> 16); }
#pragma unroll
        for (int s = 0; s < 4; ++s) *(bf16x8*)(rec + s3::R_V + (s * 64 + lane) * 16) = Vf[s];
    }
    __builtin_amdgcn_sched_barrier(0);
    float rk = 0.f;
    f32x16 Mab = ZERO16, Mak = ZERO16, Mrk = ZERO16, Mrb = ZERO16;
    {
        unsigned zkp[16]; float ss = 0.f;
        s1_stage(stg, PS, row0, vrow, 1 * 1024 + h * HD, ntok, lane);
#pragma unroll
        for (int u = 0; u < 8; ++u) { const int chb = 8 * u + 4 * hh;
            const f32x4 b = s1_z4(stg, t, chb * 2, *(LAS const f32x4*)(L + s3::PAR + 8 * 256 + chb * 4), act);
            const f32x4 kkw = *(LAS const f32x4*)(L + s3::PAR + 2 * 256 + chb * 4);
#pragma unroll
            for (int j = 0; j < 4; ++j) { const float kk = b[j] * kkw[j]; ss += kk * kk; }
            zkp[2 * u] = cvtpk(b[0], b[1]); zkp[2 * u + 1] = cvtpk(b[2], b[3]); }
        ss = xhalf_sum(ss);
        const float invn = 1.0f / fmaxf(sqrtf(ss), 1e-12f);
        const int last = (lane & 32) | 31;
        __builtin_amdgcn_sched_barrier(0);
        s1_stage(stg, PS, row0, vrow, 0 * 1024 + h * HD, ntok, lane);
#pragma unroll
        for (int s = 0; s < 4; ++s) {
            unsigned aw[4], rw[4], bw[4], kw[4], hw[4];
#pragma unroll
            for (int e = 0; e < 2; ++e) { const int u = 2 * s + e, chb = 8 * u + 4 * hh;
                const f32x4 zr = s1_z4(stg, t, chb * 2, *(LAS const f32x4*)(L + s3::PAR + 7 * 256 + chb * 4), act);
                const f32x4 kkw = *(LAS const f32x4*)(L + s3::PAR + 2 * 256 + chb * 4), kaw = *(LAS const f32x4*)(L + s3::PAR + 3 * 256 + chb * 4), rkw = *(LAS const f32x4*)(L + s3::PAR + 4 * 256 + chb * 4);
                float at[4], rt[4], bt[4], kt[4], bh[4], kh[4];
                const float zk4[4] = {bflo(zkp[2 * u]), bfhi(zkp[2 * u]), bflo(zkp[2 * u + 1]), bfhi(zkp[2 * u + 1])}, as4[4] = {bflo(asgp[2 * u]), bfhi(asgp[2 * u]), bflo(asgp[2 * u + 1]), bfhi(asgp[2 * u + 1])};
#pragma unroll
                for (int j = 0; j < 4; ++j) { const int sl = 4 * u + j;
                    const float lp = __shfl_up(Lc[sl], 1); const float e2 = __expf(Lc[sl]), e1 = __expf(t == 0 ? 0.f : lp), e3 = __builtin_amdgcn_rcpf(e2), gcv = __shfl(e2, last), e4 = gcv * e3;
                    const float kn = zk4[j] * kkw[j] * invn, kp = zk4[j] * (1.0f + (as4[j] - 1.0f) * kaw[j]), bb = kn * as4[j];
                    at[j] = -kn * e1; rt[j] = zr[j] * e2; bt[j] = bb * e3; kt[j] = kp * e3; bh[j] = bb * e4; kh[j] = kp * e4; rk += zr[j] * kp * rkw[j]; }
#pragma unroll
                for (int p = 0; p < 2; ++p) { aw[2 * e + p] = cvtpk(at[2 * p], at[2 * p + 1]); rw[2 * e + p] = cvtpk(rt[2 * p], rt[2 * p + 1]); bw[2 * e + p] = cvtpk(bt[2 * p], bt[2 * p + 1]); kw[2 * e + p] = cvtpk(kt[2 * p], kt[2 * p + 1]); hw[2 * e + p] = cvtpk(bh[2 * p], bh[2 * p + 1]);
                    const unsigned w = cvtpk(kh[2 * p], kh[2 * p + 1]); const int ch = chb + 2 * p;
                    *(LAS bf16*)(scr + s3::IMG2 + ch * s3::P36 + 2 * t) = (bf16)w; *(LAS bf16*)(scr + s3::IMG2 + (ch + 1) * s3::P36 + 2 * t) = (bf16)(w >> 16); } }
            const bf16x8 Af = __builtin_bit_cast(bf16x8, (v4u){aw[0], aw[1], aw[2], aw[3]}), Rf = __builtin_bit_cast(bf16x8, (v4u){rw[0], rw[1], rw[2], rw[3]}), Bf = __builtin_bit_cast(bf16x8, (v4u){bw[0], bw[1], bw[2], bw[3]}), Kf = __builtin_bit_cast(bf16x8, (v4u){kw[0], kw[1], kw[2], kw[3]});
            Mab = MFMA32(Af, Bf, Mab); Mak = MFMA32(Af, Kf, Mak); Mrk = MFMA32(Rf, Kf, Mrk); Mrb = MFMA32(Rf, Bf, Mrb);
            *(bf16x8*)(rec + s3::R_G + 4096 + (s * 64 + lane) * 16) = Af; *(bf16x8*)(rec + s3::R_R2 + (s * 64 + lane) * 16) = Rf; *(v4u*)(rec + s3::R_G + (s * 64 + lane) * 16) = (v4u){hw[0], hw[1], hw[2], hw[3]};
            __builtin_amdgcn_sched_barrier(0);
        }
        rk = xhalf_sum(rk);
        if (hh == 0) gcrk[64 + t] = rk;
        if (t == 31) {
#pragma unroll
            for (int u = 0; u < 8; ++u) *(LAS f32x4*)(gcrk + 8 * u + 4 * hh) = (f32x4){__expf(Lc[4 * u]), __expf(Lc[4 * u + 1]), __expf(Lc[4 * u + 2]), __expf(Lc[4 * u + 3])}; }
    }
#pragma unroll
    for (int r = 0; r < 16; ++r) { const int rr = crow(r, hh); Mab[r] = (t < rr) ? Mab[r] : 0.f; Mak[r] = (t < rr) ? Mak[r] : 0.f; Mrk[r] = (t <= rr) ? Mrk[r] : 0.f; Mrb[r] = (t <= rr) ? Mrb[r] : 0.f; }
#pragma unroll
    for (int kt = 0; kt < 2; ++kt)
#pragma unroll
        for (int vt = 0; vt < 2; ++vt) { f32x16 Hh = ZERO16;
#pragma unroll
            for (int s = 0; s < 2; ++s) Hh = MFMA32(frag_nat(scr + s3::IMG2, s3::P36, 32 * kt + t, 16 * s + 8 * hh), frag_nat(scr + s3::IMGV, s3::P36, 32 * vt + t, 16 * s + 8 * hh), Hh);
            store16bf(rec + s3::R_H + ((kt * 2 + vt) * 64 + lane) * 32, Hh); }
    __builtin_amdgcn_sched_barrier(0);
#define S1_IMG(img, f) do { _Pragma("unroll") for (int s_ = 0; s_ < 4; ++s_) { const v4u w_ = __builtin_bit_cast(v4u, (f)[s_]); _Pragma("unroll") for (int e_ = 0; e_ < 4; ++e_) { const unsigned x_ = e_ == 0 ? w_.x : (e_ == 1 ? w_.y : (e_ == 2 ? w_.z : w_.w)); \
        const int ch_ = 8 * (2 * s_ + (e_ >> 1)) + 4 * hh + 2 * (e_ & 1); *(LAS bf16*)(scr + (img) + ch_ * s3::P36 + 2 * t) = (bf16)x_; *(LAS bf16*)(scr + (img) + (ch_ + 1) * s3::P36 + 2 * t) = (bf16)(x_ >> 16); } } } while (0)
    f32x16 Tm;
    {
        f32x16 Pm = Mab;
        Tm = Pm;
#pragma unroll
        for (int r = 0; r < 16; ++r) Tm[r] += (crow(r, hh) == t) ? 1.0f : 0.0f;
#pragma unroll
        for (int lv = 0; lv < 4; ++lv) {
            store_rm(scr + s3::RM0, s3::P36, Pm, t, hh); store_rm(scr + s3::RM1, s3::P36, Tm, t, hh);
            const bf16x8 p0 = pk8(Pm, 0), p1 = pk8(Pm, 1);
            f32x16 Pn = MFMA32(frag_perm(scr + s3::RM0, s3::P36, t, 0, hh), p0, ZERO16); Pn = MFMA32(frag_perm(scr + s3::RM0, s3::P36, t, 16, hh), p1, Pn);
            const bf16x8 n0 = pk8(Pn, 0), n1 = pk8(Pn, 1);
            Tm = MFMA32(frag_perm(scr + s3::RM1, s3::P36, t, 0, hh), n0, Tm); Tm = MFMA32(frag_perm(scr + s3::RM1, s3::P36, t, 16, hh), n1, Tm);
            Pm = Pn;
        }
        store_rm(scr + s3::RM0, s3::P36, Tm, t, hh);
    }
    f32x16 W1[2];
    asm volatile("s_waitcnt vmcnt(0)" ::: "memory");
    { bf16x8 Atf[4];
#pragma unroll
      for (int s = 0; s < 4; ++s) Atf[s] = *(const bf16x8*)(rec + s3::R_G + 4096 + (s * 64 + lane) * 16);
      S1_IMG(s3::IMG2, Atf); }
#pragma unroll
    for (int nt = 0; nt < 2; ++nt) { W1[nt] = ZERO16;
#pragma unroll
        for (int s = 0; s < 2; ++s) W1[nt] = MFMA32(frag_nat(scr + s3::RM0, s3::P36, t, 16 * s + 8 * hh), frag_nat(scr + s3::IMG2, s3::P36, 32 * nt + t, 16 * s + 8 * hh), W1[nt]); }
    f32x16 W2[2];
    {
        store_rm(scr + s3::RM1, s3::P36, Mak, t, hh);
#pragma unroll
        for (int vt = 0; vt < 2; ++vt) { f32x16 X = ZERO16;
#pragma unroll
            for (int s = 0; s < 2; ++s) X = MFMA32(frag_nat(scr + s3::RM1, s3::P36, t, 16 * s + 8 * hh), frag_nat(scr + s3::IMGV, s3::P36, 32 * vt + t, 16 * s + 8 * hh), X);
            W2[vt] = MFMA32(frag_perm(scr + s3::RM0, s3::P36, t, 0, hh), pk8(X, 0), ZERO16); W2[vt] = MFMA32(frag_perm(scr + s3::RM0, s3::P36, t, 16, hh), pk8(X, 1), W2[vt]); }
    }
    f32x16 Y02[2];
    {
        store_rm(scr + s3::RM1, s3::P36, Mrk, t, hh);
#pragma unroll
        for (int vt = 0; vt < 2; ++vt) { Y02[vt] = ZERO16;
#pragma unroll
            for (int s = 0; s < 2; ++s) Y02[vt] = MFMA32(frag_nat(scr + s3::RM1, s3::P36, t, 16 * s + 8 * hh), frag_nat(scr + s3::IMGV, s3::P36, 32 * vt + t, 16 * s + 8 * hh), Y02[vt]); }
    }
    {
        store_rm(scr + s3::RM1, s3::P36, Mrb, t, hh);
        const bf16x8 mb0 = frag_perm(scr + s3::RM1, s3::P36, t, 0, hh), mb1 = frag_perm(scr + s3::RM1, s3::P36, t, 16, hh);
#pragma unroll
        for (int vt = 0; vt < 2; ++vt) { Y02[vt] = MFMA32(mb0, pk8(W2[vt], 0), Y02[vt]); Y02[vt] = MFMA32(mb1, pk8(W2[vt], 1), Y02[vt]);
            store16bf(rec + s3::R_Y02 + (vt * 64 + lane) * 32, Y02[vt]); }
#pragma unroll
        for (int kt = 0; kt < 2; ++kt) { f32x16 R2 = MFMA32(pk8(W1[kt], 0), mb0, ZERO16); R2 = MFMA32(pk8(W1[kt], 1), mb1, R2);
#pragma unroll
            for (int sx = 0; sx < 2; ++sx) { const v4u rw = *(const v4u*)(rec + s3::R_R2 + ((2 * kt + sx) * 64 + lane) * 16);
                R2[8 * sx + 0] += bflo(rw.x); R2[8 * sx + 1] += bfhi(rw.x); R2[8 * sx + 2] += bflo(rw.y); R2[8 * sx + 3] += bfhi(rw.y); R2[8 * sx + 4] += bflo(rw.z); R2[8 * sx + 5] += bfhi(rw.z); R2[8 * sx + 6] += bflo(rw.w); R2[8 * sx + 7] += bfhi(rw.w); }
            *(bf16x8*)(rec + s3::R_R2 + ((2 * kt + 0) * 64 + lane) * 16) = pk8(R2, 0); *(bf16x8*)(rec + s3::R_R2 + ((2 * kt + 1) * 64 + lane) * 16) = pk8(R2, 1); }
    }
    asm volatile("s_waitcnt vmcnt(0)" ::: "memory");
    { bf16x8 Bhf[4];
#pragma unroll
      for (int s = 0; s < 4; ++s) Bhf[s] = *(const bf16x8*)(rec + s3::R_G + (s * 64 + lane) * 16);
      S1_IMG(s3::IMG2, Bhf); }
#pragma unroll
    for (int kt = 0; kt < 2; ++kt) { const bf16x8 b0 = frag_perm(scr + s3::IMG2, s3::P36, 32 * kt + t, 0, hh), b1 = frag_perm(scr + s3::IMG2, s3::P36, 32 * kt + t, 16, hh);
#pragma unroll
        for (int vt = 0; vt < 2; ++vt) { f32x16 Hh = load16bf(rec + s3::R_H + ((kt * 2 + vt) * 64 + lane) * 32); Hh = MFMA32(b0, pk8(W2[vt], 0), Hh); Hh = MFMA32(b1, pk8(W2[vt], 1), Hh);
            store16bf(rec + s3::R_H + ((kt * 2 + vt) * 64 + lane) * 32, Hh); }
#pragma unroll
        for (int kp = 0; kp < 2; ++kp) { f32x16 G = MFMA32(pk8(W1[kp], 0), b0, ZERO16); G = MFMA32(pk8(W1[kp], 1), b1, G);
            *(bf16x8*)(rec + s3::R_G + (((kt * 2 + kp) * 2 + 0) * 64 + lane) * 16) = pk8(G, 0); *(bf16x8*)(rec + s3::R_G + (((kt * 2 + kp) * 2 + 1) * 64 + lane) * 16) = pk8(G, 1); } }
#undef S1_IMG
#undef Lc
}

struct S2Pre { bf16x8 R2p[4]; v4u Y02a, Y02b; };
__device__ __forceinline__ void s2_prefetch(S2Pre& p, const unsigned char* rec, int vt, int lane) {
#pragma unroll
    for (int s = 0; s < 4; ++s) p.R2p[s] = *(const bf16x8*)(rec + s3::R_R2 + (s * 64 + lane) * 16);
    p.Y02a = *(const v4u*)(rec + s3::R_Y02 + (vt * 64 + lane) * 32); p.Y02b = *(const v4u*)(rec + s3::R_Y02 + (vt * 64 + lane) * 32 + 16);
}
__device__ __forceinline__ f32x16 unpack16(v4u a, v4u b) {
    return (f32x16){bflo(a.x), bfhi(a.x), bflo(a.y), bfhi(a.y), bflo(a.z), bfhi(a.z), bflo(a.w), bfhi(a.w), bflo(b.x), bfhi(b.x), bflo(b.y), bfhi(b.y), bflo(b.z), bfhi(b.z), bflo(b.w), bfhi(b.w)}; }
__device__ __forceinline__ void s2_chunk(LAS unsigned char* L, const unsigned char* rec, const S2Pre& p, LAS const float* gcrk, f32x16 (&ST)[2], const bf16* GB, bf16* OB, size_t row0, int h, int ntok, int vt, unsigned cnt, int lane_) {
    int lane = lane_; asm volatile("" : "+v"(lane));
    const int q = lane & 31, hi = lane >> 5;
    bf16x8 Gp[2][2][2];
#pragma unroll
    for (int mt = 0; mt < 2; ++mt)
#pragma unroll
        for (int kp = 0; kp < 2; ++kp) { Gp[mt][kp][0] = *(const bf16x8*)(rec + s3::R_G + (((mt * 2 + kp) * 2 + 0) * 64 + lane) * 16); Gp[mt][kp][1] = *(const bf16x8*)(rec + s3::R_G + (((mt * 2 + kp) * 2 + 1) * 64 + lane) * 16); }
    v4u Ha[2], Hb[2];
#pragma unroll
    for (int mt = 0; mt < 2; ++mt) { Ha[mt] = *(const v4u*)(rec + s3::R_H + ((mt * 2 + vt) * 64 + lane) * 32); Hb[mt] = *(const v4u*)(rec + s3::R_H + ((mt * 2 + vt) * 64 + lane) * 32 + 16); }
    const int tq = q < ntok ? q : 0;
    const bf16* gp = GB + (row0 + tq) * DM + h * HD + 32 * vt + 4 * hi; bf16* op = OB + (row0 + tq) * DM + h * HD + 32 * vt + 4 * hi;
    v4u Vp[2]; v2u gv[4];
#pragma unroll
    for (int e = 0; e < 2; ++e) Vp[e] = *(const v4u*)(rec + s3::R_V + ((2 * vt + e) * 64 + lane) * 16);
#pragma unroll
    for (int u = 0; u < 4; ++u) gv[u] = *(const v2u*)(gp + 8 * u);
    bf16x8 Sb[2][2];
#pragma unroll
    for (int kt = 0; kt < 2; ++kt) { Sb[kt][0] = pk8(ST[kt], 0); Sb[kt][1] = pk8(ST[kt], 1); }
    LAS float* YT = (LAS float*)(L + s3::YT + vt * 4608);
    {
        f32x16 Y = unpack16(p.Y02a, p.Y02b);
#pragma unroll
        for (int kt = 0; kt < 2; ++kt) { Y = MFMA32(p.R2p[2 * kt + 0], Sb[kt][0], Y); Y = MFMA32(p.R2p[2 * kt + 1], Sb[kt][1], Y); }
#pragma unroll
        for (int r = 0; r < 16; ++r) YT[crow(r, hi) * 36 + q] = Y[r];
    }
    {
        const int t = q, hh = hi;
        float y[16]; float s1 = 0.f, s2 = 0.f;
#pragma unroll
        for (int u = 0; u < 4; ++u) { const f32x4 v = *(LAS const f32x4*)(YT + t * 36 + 8 * u + 4 * hh); y[4 * u] = v.x; y[4 * u + 1] = v.y; y[4 * u + 2] = v.z; y[4 * u + 3] = v.w;
            s1 += (v.x + v.y) + (v.z + v.w); s2 += (v.x * v.x + v.y * v.y) + (v.z * v.z + v.w * v.w); }
        s1 = xhalf_sum(s1); s2 = xhalf_sum(s2);
        volatile LAS float* XCH = (volatile LAS float*)(L + s3::XCH);
        volatile LAS unsigned* FLG = (volatile LAS unsigned*)(L + s3::XCH + 1024);
        const int par = cnt & 1;
        if (hh == 0) { XCH[((par * 2 + vt) * 32 + t) * 2] = s1; XCH[((par * 2 + vt) * 32 + t) * 2 + 1] = s2; }
        asm volatile("s_waitcnt lgkmcnt(0)" ::: "memory");
        if (lane == 0) FLG[vt] = cnt + 1u;
        { unsigned spin = 0; while (FLG[vt ^ 1] < cnt + 1u) { __builtin_amdgcn_s_sleep(1); if (++spin > (1u << 22)) break; } }
        asm volatile("" ::: "memory");
        const float o1 = XCH[((par * 2 + (vt ^ 1)) * 32 + t) * 2], o2 = XCH[((par * 2 + (vt ^ 1)) * 32 + t) * 2 + 1];
        const float mean = (s1 + o1) * (1.0f / 64.0f), var = fmaxf((s2 + o2) * (1.0f / 64.0f) - mean * mean, 0.f);
        const float rstd = 1.0f / sqrtf(var + GN_EPS);
        const float rk = gcrk[64 + t];
        if (q < ntok) {
#pragma unroll
            for (int e = 0; e < 2; ++e) { const v4u vv = Vp[e];
                const float vf[8] = {bflo(vv.x), bfhi(vv.x), bflo(vv.y), bfhi(vv.y), bflo(vv.z), bfhi(vv.z), bflo(vv.w), bfhi(vv.w)};
#pragma unroll
                for (int e2 = 0; e2 < 2; ++e2) { const int u = 2 * e + e2, chb = 32 * vt + 8 * u + 4 * hh;
                    const f32x4 lg = *(LAS const f32x4*)(L + s3::PAR + 5 * 256 + chb * 4), lb = *(LAS const f32x4*)(L + s3::PAR + 6 * 256 + chb * 4);
                    const float gt[4] = {bflo(gv[u].x), bfhi(gv[u].x), bflo(gv[u].y), bfhi(gv[u].y)};
                    float o[4];
#pragma unroll
                    for (int j = 0; j < 4; ++j) o[j] = ((y[4 * u + j] - mean) * rstd * lg[j] + lb[j] + rk * vf[4 * e2 + j]) * gt[j];
                    v2u w; w.x = cvtpk(o[0], o[1]); w.y = cvtpk(o[2], o[3]); *(v2u*)(op + 8 * u) = w; } }
        }
    }
#pragma unroll
    for (int mt = 0; mt < 2; ++mt) { f32x16 acc = unpack16(Ha[mt], Hb[mt]);
#pragma unroll
        for (int g = 0; g < 4; ++g) { const f32x4 gc = *(LAS const f32x4*)(gcrk + 32 * mt + 8 * g + 4 * hi);
            acc[4 * g + 0] += gc.x * ST[mt][4 * g + 0]; acc[4 * g + 1] += gc.y * ST[mt][4 * g + 1]; acc[4 * g + 2] += gc.z * ST[mt][4 * g + 2]; acc[4 * g + 3] += gc.w * ST[mt][4 * g + 3]; }
#pragma unroll
        for (int kp = 0; kp < 2; ++kp) { acc = MFMA32(Gp[mt][kp][0], Sb[kp][0], acc); acc = MFMA32(Gp[mt][kp][1], Sb[kp][1], acc); }
        ST[mt] = acc; }
}

__device__ __forceinline__ void scan_wg(const Frame& F, const Args& AR, int w, bf16* OB_, unsigned& s2cnt) {
    LAS unsigned char* L = F.lds;
    int lane = lane_id(); asm volatile("" : "+v"(lane));
    const int wave = F.wave, tid = wave * 64 + lane;
    const bool sample = w >= 128;
    const int h = sample ? ((w - 128) * 32) >> 7 : (w & 15);
    const int nch = sample ? 1 : SEQ / 32, nitems = sample ? 32 : nch, ntok = sample ? DECS : 32;
    const bf16* PS = (const bf16*)(F.ws + WS_PS); const bf16* GB = (const bf16*)(F.ws + WS_GA);
    unsigned char* ring = F.ws + (sample ? WS_K + (size_t)(w - 128) * s3::RING_BYTES_WG : WS_XN + (size_t)w * s3::RING_BYTES_WG);
    __syncthreads();
    if (tid < 2) ((LAS unsigned*)(L + s3::XCH + 1024))[tid] = 0u;
    {
        const int j = tid >> 3, cb = (tid & 7) * 8;
        const float* p = AR.in[I_W2] + (size_t)j * DM + h * HD + cb; const f32x4 a0 = *(const f32x4*)p, a1 = *(const f32x4*)(p + 4);
        const float* p2 = AR.in[I_A2] + (size_t)j * DM + h * HD + cb; const f32x4 b0 = *(const f32x4*)p2, b1 = *(const f32x4*)(p2 + 4);
        const float wv[8] = {a0.x, a0.y, a0.z, a0.w, a1.x, a1.y, a1.z, a1.w}, av[8] = {b0.x, b0.y, b0.z, b0.w, b1.x, b1.y, b1.z, b1.w};
#pragma unroll
        for (int i = 0; i < 8; ++i) { *(LAS bf16*)(L + s3::W2T + (cb + i) * s3::P68 + 2 * j) = (bf16)cvtpk(wv[i], 0.f); *(LAS bf16*)(L + s3::A2T + (cb + i) * s3::P68 + 2 * j) = (bf16)cvtpk(av[i], 0.f); }
        for (int idx = tid; idx < 12 * 64; idx += NTHR) { const int arr = idx >> 6, c = idx & 63; const float* src;
            switch (arr) { case 0: src = AR.in[I_W0] + h * HD; break; case 1: src = AR.in[I_A0] + h * HD; break; case 2: src = AR.in[I_KK] + h * HD; break; case 3: src = AR.in[I_KA] + h * HD; break;
                case 4: src = AR.in[I_RK] + h * HD; break; case 5: src = AR.in[I_LNG] + h * HD; break; case 6: src = AR.in[I_LNB] + h * HD; break;
                case 7: src = AR.in[I_MU] + h * HD; break; case 8: src = AR.in[I_MU] + 1024 + h * HD; break; case 9: src = AR.in[I_MU] + 2048 + h * HD; break; case 10: src = AR.in[I_MU] + 3072; break; default: src = AR.in[I_MU] + 3136; break; }
            ((LAS float*)(L + s3::PAR))[idx] = src[c]; }
    }
    __syncthreads();
    const int nb = (nitems + 5) / 6;
    for (int j = 0; j <= nb; ++j) {
        int ln = lane; asm volatile("" : "+v"(ln));
        if (wave < 6) {
            const int item = 6 * j + wave;
            if (item < nitems) {
                int b, c; if (sample) { b = ((w - 128) * 32 + item) & 127; c = 0; } else { b = w >> 4; c = item; }
                const size_t row0 = sample ? (size_t)MP + (size_t)b * DECS : (size_t)b * SEQ + (size_t)c * 32;
                s1_chunk(AR, L, L + s3::SCR + wave * s3::SCRW, ring + (size_t)(item % s3::RING) * s3::R_SIZE, (LAS float*)(L + s3::GCRK) + (item % s3::RING) * 96, PS, row0, c == 0 ? (sample ? (const bf16*)(F.ws + WS_SROW) + (size_t)b * SHW : (const bf16*)(F.ws + WS_ZROW)) : nullptr, h, ntok, ln);
            }
        } else if (j >= 1) {
            const int vt = wave - 6;
            LAS f32x4* STS = (LAS f32x4*)(L + SMALL_OFF) + vt * 512 + ln;
            f32x16 ST[2];
#pragma unroll
            for (int a = 0; a < 2; ++a)
#pragma unroll
                for (int g = 0; g < 4; ++g) { const f32x4 x = STS[(a * 4 + g) * 64]; ST[a][4 * g + 0] = x.x; ST[a][4 * g + 1] = x.y; ST[a][4 * g + 2] = x.z; ST[a][4 * g + 3] = x.w; }
            const int i0 = 6 * (j - 1);
            for (int i = 0; i < 6; ++i) { const int item = i0 + i; if (item >= nitems) break;
                int b, c; if (sample) { b = ((w - 128) * 32 + item) & 127; c = 0; } else { b = w >> 4; c = item; }
                const size_t row0 = sample ? (size_t)MP + (size_t)b * DECS : (size_t)b * SEQ + (size_t)c * 32;
                const int q = ln & 31, hi = ln >> 5;
                if (c == 0) {
#pragma unroll
                    for (int kt = 0; kt < 2; ++kt) { ST[kt] = ZERO16;
                        if (sample) { const float* sp = AR.in[I_SWKV] + ((size_t)(b * NH + h) * HD + 32 * vt + q) * HD + 32 * kt + 4 * hi;
#pragma unroll
                            for (int g = 0; g < 4; ++g) { const f32x4 x = *(const f32x4*)(sp + 8 * g); ST[kt][4 * g + 0] = x.x; ST[kt][4 * g + 1] = x.y; ST[kt][4 * g + 2] = x.z; ST[kt][4 * g + 3] = x.w; } } }
                }
                S2Pre cur; s2_prefetch(cur, ring + (size_t)(item % s3::RING) * s3::R_SIZE, vt, ln);
                s2_chunk(L, ring + (size_t)(item % s3::RING) * s3::R_SIZE, cur, (LAS const float*)(L + s3::GCRK) + (item % s3::RING) * 96, ST, GB, OB_, row0, h, ntok, vt, (unsigned)item, ln);
                if (c == nch - 1) {
                    float* dp = F.out + (sample ? O_SWKV : O_PWKV) + (size_t)(b * NH + h) * HD * HD;
#pragma unroll
                    for (int kt = 0; kt < 2; ++kt)
#pragma unroll
                        for (int g = 0; g < 4; ++g) *(f32x4*)(dp + (size_t)(32 * vt + q) * HD + 32 * kt + 8 * g + 4 * hi) = (f32x4){ST[kt][4 * g + 0], ST[kt][4 * g + 1], ST[kt][4 * g + 2], ST[kt][4 * g + 3]};
                }
            }
#pragma unroll
            for (int a = 0; a < 2; ++a)
#pragma unroll
                for (int g = 0; g < 4; ++g) STS[(a * 4 + g) * 64] = (f32x4){ST[a][4 * g + 0], ST[a][4 * g + 1], ST[a][4 * g + 2], ST[a][4 * g + 3]};
        }
        asm volatile("s_waitcnt vmcnt(0)" ::: "memory");
        __syncthreads();
    }
}
__device__ __forceinline__ void final_norm(const Frame& F, const Args& AR, float* dst) {
    const int gw = F.vcu * NWAVES + F.wave, NGW = F.G * NWAVES;
    const float* ss = (const float*)(F.ws + WS_SS); const int lane = lane_id(); const GAS f32x4* gr = (const GAS f32x4*)AR.in[I_FING] + lane;
    for (int m = gw; m < MT; m += NGW) {
        const float sc = 1.0f / sqrtf(ss[m] * (1.f / DM) + NORM_EPS);
        GAS f32x4* xr = (GAS f32x4*)(F.out + (size_t)m * DM) + lane;
        GAS f32x4* yr = (GAS f32x4*)(dst + (size_t)m * DM) + lane;
#pragma unroll
        for (int j = 0; j < 4; ++j) { const f32x4 v = xr[64 * j], g = gr[64 * j]; yr[64 * j] = v * sc * g; }
    }
}

#ifndef MK_PER_PHASE
#define MK_PER_PHASE 0
#endif
constexpr int N_PHASES = 9;
__global__ void __launch_bounds__(NTHR, 2) hybrid_fwd(Args args) {
    extern __shared__ __attribute__((aligned(16))) unsigned char lds[];
    Frame F;
    F.lds = (LAS unsigned char*)lds;
    F.wave = __builtin_amdgcn_readfirstlane(threadIdx.x >> 6);
    F.G = gridDim.x; { const int bx = blockIdx.x; F.vcu = (F.G % 8 == 0) ? (bx % 8) * (F.G / 8) + bx / 8 : bx; }
    F.out = args.out; F.ws = args.ws;
    volatile LAS unsigned* MISC = (volatile LAS unsigned*)(F.lds + MISC_OFF);
    for (int u = threadIdx.x; u < (LDS_BYTES - LDSCTL_OFF) / 4; u += NTHR) ((LAS unsigned*)(F.lds + LDSCTL_OFF))[u] = 0u;
    __syncthreads();
    XcdBarrier bar; bar.bar = (unsigned*)(F.ws + WS_CTL) + CW_BAR; bar.x = 0; bar.st = nullptr;
    if (!MK_PER_PHASE) bar = xcd_barrier_post((unsigned*)(F.ws + WS_CTL) + CW_BAR, MISC + 8);
    const int lo = args.ph_lo, hi = args.ph_hi;
#ifndef DUP
#define DUP 0
#endif
#define REP(k) for (int rep_ = ((DUP >> (k)) & 1) ? 0 : 1; rep_ < 2; ++rep_)
#ifndef PHMASK
#define PHMASK 0x1ff
#endif
#define IN(k) ((((PHMASK) >> (k)) & 1) && lo <= (k) && (k) < hi)
#define SEAM(k) do { if (IN(k) && IN((k) + 1)) xcd_barrier(bar); } while (0)

    if (IN(0)) { REP(0) p0_prologue(F, args); }
    SEAM(0);
    if (IN(1)) {
        pg8::Gemm g{(const bf16*)(F.ws + WS_XN), (const bf16*)(F.ws + WS_W1T), MT, N1A, DM}; pg8::StaticOrder S; S.init(MT, N1A, F.G, (int)blockIdx.x);
        EpiG1 E{0, F.ws, F.out};
        REP(1) pg8::gemm_phase<EpiG1, pg8::StaticOrder, true, true>(F.lds, g, S, E);
    }
    SEAM(1);
    if (IN(2)) { REP(2) { bf16* ob = (bf16*)(F.ws + (rep_ ? WS_Q : WS_PS)); for (int u = F.vcu; u < 1024 + 512; u += F.G) attn_unit(F, args, u, ob); } }
    SEAM(2);
    if (IN(3)) {
        pg8::Gemm g{(const bf16*)(F.ws + WS_XN), (const bf16*)(F.ws + WS_W1T) + (size_t)N1A * DM, MT, N1B, DM}; pg8::StaticOrder S; S.init(MT, N1B, F.G, (int)blockIdx.x);
        EpiG1 E{1, F.ws, F.out};
        REP(3) pg8::gemm_phase<EpiG1, pg8::StaticOrder, true, true>(F.lds, g, S, E);
    }
    SEAM(3);
    if (IN(4)) { unsigned s2cnt = 0;
        if ((int)blockIdx.x < 192 || F.G < 256) { REP(4) { bf16* ob = (bf16*)(F.ws + (rep_ ? WS_GA : WS_PS + (size_t)MT * SHW * 2 - (size_t)MT * DM * 2)); for (int w = (int)blockIdx.x; w < 192; w += F.G) scan_wg(F, args, w, ob, s2cnt); } }
        if (F.G >= 256 ? (int)blockIdx.x >= 192 : true) {
            const int gg = F.G >= 256 ? F.G - 192 : F.G, cc = F.G >= 256 ? (int)blockIdx.x - 192 : (int)blockIdx.x;
            pg8::Gemm g{(const bf16*)(F.ws + WS_Q), (const bf16*)(F.ws + WS_WAT), MT, DM, DM}; pg8::StaticOrder S; S.init(MT, DM, gg, cc);
            EpiGate E{0, (const bf16*)F.out, nullptr, (bf16*)F.out};
            REP(5) pg8::gemm_phase<EpiGate, pg8::StaticOrder, true, true>(F.lds, g, S, E);
        } }
    SEAM(4);
    if (IN(6)) {
        pg8::Gemm g{(const bf16*)(F.ws + WS_GA), (const bf16*)(F.ws + WS_WBT), MT, DM, DM}; pg8::StaticOrder S; S.init(MT, DM, F.G, (int)blockIdx.x);
        EpiGate E{1, (const bf16*)F.out + (size_t)MT * DM, (const bf16*)F.out, (bf16*)(F.ws + WS_XN)};
        REP(6) pg8::gemm_phase<EpiGate, pg8::StaticOrder, true, true>(F.lds, g, S, E);
    }
    SEAM(6);
    if (IN(7)) {
        pg8::Gemm g{(const bf16*)(F.ws + WS_XN), (const bf16*)(F.ws + WS_WOT), MT, DM, DM}; pg8::StaticOrder S; S.init(MT, DM, F.G, (int)blockIdx.x);
        REP(7) { EpiOut E{args.in[I_XP], args.in[I_XS], F.out, (float*)(F.ws + WS_SS + (rep_ ? 0 : 192 * 1024))};
        pg8::gemm_phase<EpiOut, pg8::StaticOrder, true, true>(F.lds, g, S, E); }
    }
    SEAM(7);
    if (IN(8)) { REP(8) final_norm(F, args, rep_ ? F.out : (float*)(F.ws + WS_PS)); }
#undef IN
#undef SEAM
}

extern "C" void kernel_launch(void* const* d_in, const int* in_sizes, int n_in, void* d_out, int out_size, void* d_ws, size_t ws_size, hipStream_t stream) {
    static int grid = 0;
    if (grid == 0) {
        if (n_in != 24 || (size_t)out_size != O_END || ws_size < WS_END) { fprintf(stderr, "kernel_launch: unexpected sizes: n_in %d out %d ws %zu (need %zu)\n", n_in, out_size, ws_size, (size_t)WS_END); grid = -1; return; }
        int dev = 0, cus = 0;
        if (hipGetDevice(&dev) != hipSuccess || hipDeviceGetAttribute(&cus, hipDeviceAttributeMultiprocessorCount, dev) != hipSuccess) { grid = -1; return; }
        if (hipFuncSetAttribute((const void*)hybrid_fwd, hipFuncAttributeMaxDynamicSharedMemorySize, LDS_BYTES) != hipSuccess) { fprintf(stderr, "kernel_launch: hipFuncSetAttribute failed\n"); grid = -1; return; }
        int per_cu = 0;
        if (hipOccupancyMaxActiveBlocksPerMultiprocessor(&per_cu, (const void*)hybrid_fwd, NTHR, LDS_BYTES) != hipSuccess || per_cu < 1) fprintf(stderr, "kernel_launch: occupancy query says %d\n", per_cu);
        (void)hipGetLastError();
        grid = cus;
    }
    if (grid < 0) return;
    (void)hipMemsetAsync((char*)d_ws + WS_CTL, 0, CTL_ZERO_BYTES, stream);
    Args a{};
    for (int i = 0; i < 24; ++i) a.in[i] = (const float*)d_in[i];
    a.out = (float*)d_out; a.ws = (unsigned char*)d_ws;
#if MK_PER_PHASE
    for (int p = 0; p < N_PHASES; ++p) { a.ph_lo = p; a.ph_hi = p + 1; hipLaunchKernelGGL(hybrid_fwd, dim3(grid), dim3(NTHR), LDS_BYTES, stream, a); }
#else
    a.ph_lo = 0; a.ph_hi = N_PHASES; hipLaunchKernelGGL(hybrid_fwd, dim3(grid), dim3(NTHR), LDS_BYTES, stream, a);
#endif
}
```

```cpp
#include <hip/hip_runtime.h>
#include <cstdio>
#include <cstdint>
#include <cmath>
namespace pg8 {
#define PG8_LAS __attribute__((address_space(3)))
typedef unsigned short bf16_t;
typedef short bf16x8 __attribute__((ext_vector_type(8)));
typedef float f32x4 __attribute__((ext_vector_type(4)));
typedef unsigned u32x4 __attribute__((ext_vector_type(4)));
constexpr int BM = 256, BK = 64, HALF = 128, HTB = HALF * BK * 2  , STAGE_BYTES = 8 * HTB, NXCD = 8, WGM = 8;

__host__ __device__ __forceinline__ int lds_byte(int r, int c) { const int st = (r >> 4) * 2 + (c >> 5), rr = r & 15, cc = c & 31, ob = rr * 64 + cc * 2; return st * 1024 + (ob ^ (((ob >> 9) & 1) << 5)); }
__host__ __device__ __forceinline__ void stage_rc(int b, int& R, int& C) { const int st = b / 1024, sb = b % 1024, swz = sb ^ (((sb >> 9) & 1) << 5); R = (st >> 1) * 16 + swz / 64; C = (st & 1) * 32 + (swz % 64) / 2; }
__host__ __device__ __forceinline__ int perm32(int rho) { const int n = rho >> 4, i = rho & 15; return 8 * (i >> 2) + 4 * n + (i & 3); }

struct Unit { int pm, pn; };
struct Gemm { const bf16_t* A; const bf16_t* Bt; int M, N, K; };

struct StaticOrder {
    int nM, nN, nwg, G, c;
    __host__ __device__ void init(int M, int N, int G_, int c_) { nM = M / BM; nN = N / BM; nwg = nM * nN; G = G_; c = c_; }
    __host__ __device__ bool next(int i, Unit& u) const {
        const long L = (long)i * G + c; if (L >= nwg) return false;
        int wgid = (int)L; { const int q = nwg / NXCD, r = nwg % NXCD, xcd = wgid % NXCD, off = wgid / NXCD; wgid = (xcd < r ? xcd * (q + 1) : r * (q + 1) + (xcd - r) * q) + off; }
        const int nig = WGM * nN, gid = wgid / nig, fm = gid * WGM, gsz = (nM - fm) < WGM ? (nM - fm) : WGM;
        u.pm = fm + ((wgid % nig) % gsz); u.pn = (wgid % nig) / gsz; return true;
    }
    __device__ __forceinline__ void a_ready(const Unit&) const {}
    __device__ __forceinline__ void done(const Unit&) const {}
};

__device__ __forceinline__ unsigned cvt_pk_bf16(float lo, float hi) { unsigned r; asm volatile("v_cvt_pk_bf16_f32 %0, %1, %2" : "=v"(r) : "v"(lo), "v"(hi)); return r; }
typedef float f32x2 __attribute__((ext_vector_type(2)));
template <class Epi, class Sched, bool ALIGN_EPI = false, bool SP2 = false>
__device__ __forceinline__ void gemm_phase(PG8_LAS unsigned char* lds, const Gemm g, const Sched& S, const Epi& E) {
    const int tid = threadIdx.x, wid = __builtin_amdgcn_readfirstlane(tid >> 6), lane = tid & 63, wr = wid >> 2, wc = wid & 3, fr = lane & 15, fq = lane >> 4;
    const int K = g.K, nt = K / BK;
    unsigned voffA[2], voffB[2];
#pragma unroll
    for (int i = 0; i < 2; ++i) { int R, C; stage_rc(tid * 16 + i * 8192, R, C); const int Rb = Epi::PERM ? ((R & ~31) + perm32(R & 31)) : R;
        voffA[i] = (unsigned)(R * K + C) * 2u; voffB[i] = (unsigned)(Rb * K + C) * 2u; }
    const size_t kstep = (size_t)(BK * 2);
    const size_t hstep = (size_t)HALF * K * 2;
    const size_t tstep = 2 * hstep;
    const unsigned ldsw = (unsigned)wid * 1024u;
    const int aoff = lds_byte(wr * 64 + fr, fq * 8), boff = lds_byte(wc * 32 + fr, fq * 8);
#define PG8_SA(b, h) (((b) * 2 + (h)) * HTB)
#define PG8_SB(b, h) ((4 + (b) * 2 + (h)) * HTB)
#define PG8_STAGE(bufoff, gbase, voff) do { _Pragma("unroll") for (int _i = 0; _i < 2; ++_i) \
        __builtin_amdgcn_global_load_lds((const unsigned*)((const char*)(gbase) + (voff)[_i]), (PG8_LAS unsigned*)(lds + (bufoff) + ldsw + _i * 8192), 16, 0, 0); } while (0)
#define PG8_LDA(dst, b, h) do { _Pragma("unroll") for (int m = 0; m < 4; ++m) _Pragma("unroll") for (int k = 0; k < 2; ++k) dst[m][k] = *(const PG8_LAS bf16x8*)(lds + PG8_SA(b, h) + aoff + m * 2048 + k * 1024); } while (0)
#define PG8_LDB(dst, b, h) do { _Pragma("unroll") for (int n = 0; n < 2; ++n) _Pragma("unroll") for (int k = 0; k < 2; ++k) dst[n][k] = *(const PG8_LAS bf16x8*)(lds + PG8_SB(b, h) + boff + n * 2048 + k * 1024); } while (0)
#define PG8_MMA(ai, bj, At, Bt) do { __builtin_amdgcn_s_setprio(1); _Pragma("unroll") for (int m = 0; m < 4; ++m) _Pragma("unroll") for (int n = 0; n < 2; ++n) _Pragma("unroll") for (int k = 0; k < 2; ++k) \
        acc[ai][bj][m][n] = __builtin_amdgcn_mfma_f32_16x16x32_bf16(Bt[n][k], At[m][k], acc[ai][bj][m][n], 0, 0, 0); __builtin_amdgcn_s_setprio(0); } while (0)
#define PG8_WAIT_V(n) asm volatile("s_waitcnt vmcnt(" #n ")" ::: "memory")
#define PG8_WAIT_L(n) asm volatile("s_waitcnt lgkmcnt(" #n ")" ::: "memory")
#define PG8_BAR __builtin_amdgcn_s_barrier()
#define PG8_SCHED __builtin_amdgcn_sched_barrier(0)
    Unit cur, nxt; int ui = 0;
    if (!S.next(0, cur)) return;
    f32x4 acc[2][2][4][2];
#pragma unroll
    for (int a = 0; a < 2; ++a)
#pragma unroll
        for (int b = 0; b < 2; ++b)
#pragma unroll
            for (int m = 0; m < 4; ++m)
#pragma unroll
                for (int n = 0; n < 2; ++n) acc[a][b][m][n] = (f32x4){0.f, 0.f, 0.f, 0.f};
    bf16x8 At[4][2], B0[2][2], B1[2][2];
    const char* cA = (const char*)g.A + (size_t)cur.pm * tstep; const char* cB = (const char*)g.Bt + (size_t)cur.pn * tstep;
    S.a_ready(cur);
    if constexpr (SP2) {
        PG8_STAGE(PG8_SB(0, 0), cB, voffB); PG8_STAGE(PG8_SB(0, 1), cB + hstep, voffB); PG8_STAGE(PG8_SA(0, 0), cA, voffA); PG8_STAGE(PG8_SA(0, 1), cA + hstep, voffA);
        if (wr == 1) PG8_BAR;
        PG8_WAIT_V(2); PG8_BAR;
        PG8_STAGE(PG8_SB(1, 0), cB + kstep, voffB); PG8_STAGE(PG8_SA(1, 0), cA + kstep, voffA); PG8_STAGE(PG8_SB(1, 1), cB + hstep + kstep, voffB);
        PG8_WAIT_V(6); PG8_BAR;
    } else {
        PG8_STAGE(PG8_SB(0, 0), cB, voffB); PG8_STAGE(PG8_SA(0, 0), cA, voffA); PG8_STAGE(PG8_SB(0, 1), cB + hstep, voffB); PG8_STAGE(PG8_SA(0, 1), cA + hstep, voffA);
        if (wr == 1) PG8_BAR;
        PG8_WAIT_V(4); PG8_BAR;
        PG8_STAGE(PG8_SB(1, 0), cB + kstep, voffB); PG8_STAGE(PG8_SA(1, 0), cA + kstep, voffA); PG8_STAGE(PG8_SB(1, 1), cB + hstep + kstep, voffB);
        PG8_WAIT_V(6); PG8_BAR;
    }
    for (;;) {
        const bool has_next = S.next(ui + 1, nxt);
        const char* nA = has_next ? (const char*)g.A + (size_t)nxt.pm * tstep : cA; const char* nB = has_next ? (const char*)g.Bt + (size_t)nxt.pn * tstep : cB;
        for (int t = 0; t < nt; t += 2) {
            const bool last = (t == nt - 2);
            const char* a1 = cA + (size_t)(t + 1) * kstep;
            const char* a2 = last ? nA : cA + (size_t)(t + 2) * kstep; const char* b2 = last ? nB : cB + (size_t)(t + 2) * kstep;
            const char* a3 = a2 + kstep; const char* b3 = b2 + kstep;
            if (last && has_next) S.a_ready(nxt);
            if constexpr (SP2) {
            PG8_LDB(B0, 0, 0); PG8_LDB(B1, 0, 1); PG8_SCHED; PG8_LDA(At, 0, 0); PG8_STAGE(PG8_SA(1, 1), a1 + hstep, voffA);
            PG8_WAIT_V(8); PG8_WAIT_L(0); PG8_BAR; PG8_MMA(0, 0, At, B0); PG8_MMA(0, 1, At, B1); PG8_BAR; PG8_SCHED;
            PG8_LDA(At, 0, 1); PG8_STAGE(PG8_SB(0, 0), b2, voffB); PG8_STAGE(PG8_SB(0, 1), b2 + hstep, voffB); PG8_STAGE(PG8_SA(0, 0), a2, voffA);
            PG8_WAIT_V(8); PG8_WAIT_L(0); PG8_BAR; PG8_MMA(1, 0, At, B0); PG8_MMA(1, 1, At, B1); PG8_BAR; PG8_SCHED;
            PG8_LDB(B0, 1, 0); PG8_LDB(B1, 1, 1); PG8_SCHED; PG8_LDA(At, 1, 0); PG8_STAGE(PG8_SA(0, 1), a2 + hstep, voffA);
            PG8_WAIT_V(8); PG8_WAIT_L(0); PG8_BAR; PG8_MMA(0, 0, At, B0); PG8_MMA(0, 1, At, B1); PG8_BAR; PG8_SCHED;
            PG8_LDA(At, 1, 1); PG8_STAGE(PG8_SB(1, 0), b3, voffB); PG8_STAGE(PG8_SB(1, 1), b3 + hstep, voffB); PG8_STAGE(PG8_SA(1, 0), a3, voffA);
            PG8_WAIT_V(8); PG8_WAIT_L(0); PG8_BAR; PG8_MMA(1, 0, At, B0); PG8_MMA(1, 1, At, B1); PG8_BAR; PG8_SCHED;
            } else {
            PG8_LDB(B0, 0, 0); PG8_SCHED; PG8_LDA(At, 0, 0); PG8_STAGE(PG8_SA(1, 1), a1 + hstep, voffA);
            PG8_WAIT_L(8); PG8_BAR; PG8_WAIT_L(0); PG8_MMA(0, 0, At, B0); PG8_BAR; PG8_SCHED;
            PG8_LDB(B1, 0, 1); PG8_STAGE(PG8_SB(0, 0), b2, voffB);
            PG8_BAR; PG8_WAIT_L(0); PG8_MMA(0, 1, At, B1); PG8_BAR;
            PG8_LDA(At, 0, 1); PG8_STAGE(PG8_SA(0, 0), a2, voffA);
            PG8_BAR; PG8_WAIT_L(0); PG8_MMA(1, 0, At, B0); PG8_BAR; PG8_SCHED;
            PG8_STAGE(PG8_SB(0, 1), b2 + hstep, voffB);
            PG8_WAIT_V(6); PG8_BAR; PG8_MMA(1, 1, At, B1); PG8_BAR;
            PG8_LDB(B0, 1, 0); PG8_SCHED; PG8_LDA(At, 1, 0); PG8_STAGE(PG8_SA(0, 1), a2 + hstep, voffA);
            PG8_WAIT_L(8); PG8_BAR; PG8_WAIT_L(0); PG8_MMA(0, 0, At, B0); PG8_BAR; PG8_SCHED;
            PG8_LDB(B1, 1, 1); PG8_STAGE(PG8_SB(1, 0), b3, voffB);
            PG8_BAR; PG8_WAIT_L(0); PG8_MMA(0, 1, At, B1); PG8_BAR;
            PG8_LDA(At, 1, 1); PG8_STAGE(PG8_SA(1, 0), a3, voffA);
            PG8_BAR; PG8_WAIT_L(0); PG8_MMA(1, 0, At, B0); PG8_BAR; PG8_SCHED;
            PG8_STAGE(PG8_SB(1, 1), b3 + hstep, voffB);
            PG8_WAIT_V(6); PG8_BAR; PG8_MMA(1, 1, At, B1); PG8_BAR;
            }
        }
        if constexpr (ALIGN_EPI) { if (wr == 0) PG8_BAR; }
        if constexpr (!Epi::AFTER_DRAIN) { E(acc, cur, wr, wc, fr, fq); S.done(cur); }
        if (!has_next) break;
#pragma unroll
        for (int a = 0; a < 2; ++a)
#pragma unroll
            for (int b = 0; b < 2; ++b)
#pragma unroll
                for (int m = 0; m < 4; ++m)
#pragma unroll
                    for (int n = 0; n < 2; ++n) acc[a][b][m][n] = (f32x4){0.f, 0.f, 0.f, 0.f};
        cur = nxt; cA = nA; cB = nB; ++ui;
        if constexpr (ALIGN_EPI) { if (wr == 1) PG8_BAR; }
    }
    PG8_WAIT_V(0);
    if constexpr (!ALIGN_EPI) { if (wr == 0) PG8_BAR; }
    PG8_BAR;
    if constexpr (Epi::AFTER_DRAIN) { E.fused(acc, cur, wr, wc, fr, fq, lds, wid, lane); S.done(cur); }
#undef PG8_SA
#undef PG8_SB
#undef PG8_STAGE
#undef PG8_LDA
#undef PG8_LDB
#undef PG8_MMA
#undef PG8_WAIT_V
#undef PG8_WAIT_L
#undef PG8_BAR
#undef PG8_SCHED
}
}

constexpr int DM = 1024, NBATCH = 8, SEQ = 4096, DECB = 128, DECS = 8;
constexpr int MP = NBATCH * SEQ, MS = DECB * DECS, MT = MP + MS;
constexpr int HD = 64, NH = 16, NKV = 4, WIN = 128, KVW = 256;
constexpr int SHW = 3200, INC = 8832;
constexpr int N1A = 2560, N1B = 6400, N1 = N1A + N1B;
constexpr float NORM_EPS = 1e-6f, GN_EPS = 64e-5f;

constexpr size_t O_Y = 0;
constexpr size_t O_PKW = (size_t)MT * DM;
constexpr size_t O_PVW = O_PKW + (size_t)NBATCH * WIN * KVW;
constexpr size_t O_PWKV = O_PVW + (size_t)NBATCH * WIN * KVW;
constexpr size_t O_PSH = O_PWKV + (size_t)NBATCH * NH * HD * HD;
constexpr size_t O_SKW = O_PSH + (size_t)NBATCH * SHW;
constexpr size_t O_SVW = O_SKW + (size_t)DECB * WIN * KVW;
constexpr size_t O_SWKV = O_SVW + (size_t)DECB * WIN * KVW;
constexpr size_t O_SSH = O_SWKV + (size_t)DECB * NH * HD * HD;
constexpr size_t O_END = O_SSH + (size_t)DECB * SHW;
static_assert(O_END == 52864000, "output size");

constexpr size_t MiB = 1u << 20;
constexpr size_t WS_CTL = 0, CTL_ZERO_BYTES = 1 * MiB;
constexpr size_t WS_SS = 512 * 1024;
constexpr size_t WS_ZROW = 900 * 1024;
constexpr size_t WS_SROW = 1 * MiB;
constexpr size_t WS_W1T = 2 * MiB;
constexpr size_t WS_WAT = 20 * MiB, WS_WBT = 22 * MiB, WS_WOT = 24 * MiB;
constexpr size_t WS_XN = 26 * MiB;
constexpr size_t WS_Q = 92 * MiB;
constexpr size_t WS_K = 158 * MiB;
constexpr size_t WS_V = WS_K + (size_t)MT * KVW * 2;
constexpr size_t WS_GA = 191 * MiB;
constexpr size_t WS_PS = 257 * MiB;
constexpr size_t WS_RING = 464 * MiB;
constexpr size_t WS_END = 512 * MiB;
static_assert(WS_W1T + (size_t)N1 * DM * 2 <= WS_WAT && WS_V + (size_t)MT * KVW * 2 <= WS_GA && WS_PS + (size_t)MT * SHW * 2 <= WS_END, "ws map");

constexpr int CW_BAR = 4096;

constexpr int RING_BYTES = 131072;
constexpr int LDSCTL_OFF = RING_BYTES, MISC_OFF = LDSCTL_OFF + 320, SMALL_OFF = LDSCTL_OFF + 1024;
constexpr int LDS_BYTES = 163840;
constexpr int NWAVES = 8, NTHR = 512;

#define GAS __attribute__((address_space(1)))
#define LAS __attribute__((address_space(3)))
typedef unsigned short bf16;
typedef unsigned v4u __attribute__((ext_vector_type(4)));
typedef unsigned v2u __attribute__((ext_vector_type(2)));
typedef float f32x4 __attribute__((ext_vector_type(4)));
typedef float f32x16 __attribute__((ext_vector_type(16)));
typedef short bf16x8 __attribute__((ext_vector_type(8)));
typedef GAS unsigned gu32;
#define RLX_AGENT __ATOMIC_RELAXED, __HIP_MEMORY_SCOPE_AGENT
#define LDS_WAIT() asm volatile("s_waitcnt lgkmcnt(0)" ::: "memory")
#define VM_WAIT() asm volatile("s_waitcnt vmcnt(0)" ::: "memory")
__device__ __forceinline__ unsigned f2bf(float f) { unsigned u = __builtin_bit_cast(unsigned, f); return (u + 0x7fffu + ((u >> 16) & 1u)) >> 16; }
__device__ __forceinline__ unsigned pk2(float lo, float hi) { return f2bf(lo) | (f2bf(hi) << 16); }
__device__ __forceinline__ float bflo(unsigned u) { return __builtin_bit_cast(float, u << 16); }
__device__ __forceinline__ float bfhi(unsigned u) { return __builtin_bit_cast(float, u & 0xffff0000u); }
__device__ __forceinline__ float sigmoidf_(float x) { return __builtin_amdgcn_rcpf(1.0f + __expf(-x)); }

#define XB_TMO      128
#define XB_XCNT(j)  (256  + 64 * (j))
#define XB_XSUB(j)  (1280 + 64 * (j))
#define XB_XGEN(j)  (2304 + 64 * (j))
#define XB_TOP      3328
#define XB_TOPGEN   3392
#define XCD_BAR_WORDS 3456
#define XB_SPIN_CAP (1u << 23)
__device__ __forceinline__ unsigned xb_ld(unsigned* p)              { return __hip_atomic_load(p, __ATOMIC_RELAXED, __HIP_MEMORY_SCOPE_AGENT); }
__device__ __forceinline__ unsigned xb_add(unsigned* p, unsigned v) { return __hip_atomic_fetch_add(p, v, __ATOMIC_RELAXED, __HIP_MEMORY_SCOPE_AGENT); }
__device__ __forceinline__ unsigned xb_xcc_id() { return (unsigned)__builtin_amdgcn_s_getreg((3 << 11) | 20) & 0xFu; }
#define XB_SPIN(cond, bar) do { unsigned _sp = 0; while (cond) { __builtin_amdgcn_s_sleep(1); \
    if ((++_sp & 255u) == 0u) { if (xb_ld(&(bar)[XB_TMO])) break; if (_sp > XB_SPIN_CAP) { atomicAdd(&(bar)[XB_TMO], 1u); break; } } } } while (0)
struct XcdBarrier { unsigned* bar; unsigned x; volatile LAS unsigned* st; };
__device__ __forceinline__ XcdBarrier xcd_barrier_post(unsigned* bar, volatile LAS unsigned* st) {
    XcdBarrier b; b.bar = bar; b.x = xb_xcc_id(); b.st = st;
    if (threadIdx.x == 0) (void)xb_add(&bar[XB_XCNT(b.x)], 1u);
    return b;
}
__device__ __forceinline__ void xcd_barrier_complete(unsigned* bar, unsigned x, unsigned& nloc, unsigned& nx) {
    const unsigned G = gridDim.x * gridDim.y * gridDim.z;
    unsigned sum, cnt, mine, sp = 0u;
    for (;;) {
        sum = 0u; cnt = 0u; mine = 0u;
#pragma unroll
        for (unsigned j = 0; j < 16; ++j) { const unsigned c = xb_ld(&bar[XB_XCNT(j)]); sum += c; cnt += (c > 0u) ? 1u : 0u; mine = (j == x) ? c : mine; }
        if (sum == G) break;
        __builtin_amdgcn_s_sleep(1);
        if ((++sp & 255u) == 0u) { if (xb_ld(&bar[XB_TMO])) break; if (sp > XB_SPIN_CAP) { atomicAdd(&bar[XB_TMO], 1u); break; } }
    }
    nloc = mine > 0u ? mine : 1u; nx = cnt > 0u ? cnt : 1u;
}
__device__ __forceinline__ void xcd_barrier(const XcdBarrier& b) {
    asm volatile("s_waitcnt vmcnt(0)" ::: "memory");
    __syncthreads();
    if (threadIdx.x == 0) {
        unsigned* bar = b.bar;
        __builtin_amdgcn_s_waitcnt(0);
        unsigned nloc = b.st[0], nx = b.st[1];
        if (nloc == 0u) { xcd_barrier_complete(bar, b.x, nloc, nx); b.st[0] = nloc; b.st[1] = nx; }
        const unsigned old = xb_add(&bar[XB_XSUB(b.x)], 1u);
        const unsigned gen = old / nloc;
        if (old + 1u == (gen + 1u) * nloc) {
            __builtin_amdgcn_fence(__ATOMIC_RELEASE, "agent");
            asm volatile("s_waitcnt vmcnt(0)" ::: "memory");
            const unsigned og = xb_add(&bar[XB_TOP], 1u);
            const unsigned tg = og / nx;
            if (og + 1u == (tg + 1u) * nx) xb_add(&bar[XB_TOPGEN], 1u);
            else XB_SPIN(xb_ld(&bar[XB_TOPGEN]) == tg, bar);
            __builtin_amdgcn_fence(__ATOMIC_ACQUIRE, "agent");
            xb_add(&bar[XB_XGEN(b.x)], 1u);
            asm volatile("s_waitcnt vmcnt(0)" ::: "memory");
        } else {
            XB_SPIN(xb_ld(&bar[XB_XGEN(b.x)]) == gen, bar);
            __builtin_amdgcn_fence(__ATOMIC_ACQUIRE, "agent");
            asm volatile("s_waitcnt vmcnt(0)" ::: "memory");
        }
    }
    __syncthreads();
}

struct Args { const float* in[24]; float* out; unsigned char* ws; int ph_lo, ph_hi; };
static_assert(sizeof(Args) == 24 * 8 + 8 + 8 + 8, "no padding");
struct Frame {
    LAS unsigned char* lds;
    int wave, G, vcu;
    float* out; unsigned char* ws;
};
__device__ __forceinline__ int lane_id() { return (int)__builtin_amdgcn_mbcnt_hi(~0u, __builtin_amdgcn_mbcnt_lo(~0u, 0u)); }
enum { I_XP = 0, I_XS, I_CK, I_CV, I_SWKV, I_SSHIFT, I_RELB, I_NORMG, I_WIN, I_SINK, I_MU, I_W0, I_W2, I_A0, I_A2, I_KK, I_KA, I_RK, I_LNG, I_LNB, I_WOA, I_WOB, I_WO, I_FING };

__device__ __forceinline__ float wave_sum(float v) {
#pragma unroll
    for (int o = 1; o < 64; o <<= 1) v += __shfl_xor(v, o);
    return v;
}

__device__ __forceinline__ void p0_transpose_item(const float* W, int ldw, int srccol0, int K, bf16* WT, int dstrow0, LAS float* scr, int kb, int lane) {
    const int k0 = 64 * kb;
    if (srccol0 >= 0) {
#pragma unroll 8
        for (int i = 0; i < 32; ++i) { const int kk = 2 * i + (lane >> 5); scr[kk * 33 + (lane & 31)] = W[(size_t)(k0 + kk) * ldw + srccol0 + (lane & 31)]; }
    }
    LDS_WAIT(); asm volatile("" ::: "memory");
    const int c = lane & 7;
#pragma unroll
    for (int j = 0; j < 4; ++j) { const int n = (lane >> 3) + 8 * j; const LAS float* s = scr + (8 * c) * 33 + n;
        v4u o = (v4u){0u, 0u, 0u, 0u};
        if (srccol0 >= 0) { o.x = pk2(s[0 * 33], s[1 * 33]); o.y = pk2(s[2 * 33], s[3 * 33]); o.z = pk2(s[4 * 33], s[5 * 33]); o.w = pk2(s[6 * 33], s[7 * 33]); }
        *(GAS v4u*)(WT + (size_t)(dstrow0 + n) * K + k0 + 8 * c) = o; }
    LDS_WAIT(); asm volatile("" ::: "memory");
}
__device__ __forceinline__ void rms_row_to_bf16(const float* xrow, const float* g, bf16* orow, int lane) {
    const GAS f32x4* xr = (const GAS f32x4*)xrow + lane; const GAS f32x4* gr = (const GAS f32x4*)g + lane;
    f32x4 v[4]; float s = 0.f;
#pragma unroll
    for (int j = 0; j < 4; ++j) { v[j] = xr[64 * j]; s += (v[j].x * v[j].x + v[j].y * v[j].y) + (v[j].z * v[j].z + v[j].w * v[j].w); }
    const float sc = 1.0f / sqrtf(wave_sum(s) * (1.f / DM) + NORM_EPS);
    GAS v2u* o8 = (GAS v2u*)orow + lane;
#pragma unroll
    for (int j = 0; j < 4; ++j) { const f32x4 gv = gr[64 * j]; v2u o; o.x = pk2(v[j].x * sc * gv.x, v[j].y * sc * gv.y); o.y = pk2(v[j].z * sc * gv.z, v[j].w * sc * gv.w); o8[64 * j] = o; }
}
__device__ __forceinline__ void p0_prologue(const Frame& F, const Args& AR) {
    const int lane = lane_id();
    LAS float* scr = (LAS float*)(F.lds + F.wave * 16384);
    const int gw = F.vcu * NWAVES + F.wave, NGW = F.G * NWAVES;
    constexpr int I_1 = 16 * (N1 / 32), I_S = 16 * 32, NITEMS = I_1 + 3 * I_S;
    bf16* W1T = (bf16*)(F.ws + WS_W1T);
    for (int it = gw; it < NITEMS; it += NGW) {
        int r = it;
        if (r < I_1) { const int kb = r / (N1 / 32), nb = r % (N1 / 32), n0 = 32 * nb;
            const int src = n0 < 5760 ? n0 : (n0 < 5888 ? -1 : n0 - 128);
            p0_transpose_item(AR.in[I_WIN], INC, src, DM, W1T, n0, scr, kb, lane); continue; }
        r -= I_1;
        const int which = r / I_S; r -= which * I_S;
        const float* W = which == 0 ? AR.in[I_WOA] : (which == 1 ? AR.in[I_WOB] : AR.in[I_WO]);
        bf16* WT = (bf16*)(F.ws + (which == 0 ? WS_WAT : (which == 1 ? WS_WBT : WS_WOT)));
        p0_transpose_item(W, DM, 32 * (r % 32), DM, WT, 32 * (r % 32), scr, r / 32, lane);
    }
    { bf16* SR = (bf16*)(F.ws + WS_SROW); const float* ss = AR.in[I_SSHIFT];
      for (int i = gw * 64 + lane; i < DECB * SHW / 4; i += NGW * 64) { const f32x4 v = *(const f32x4*)(ss + (size_t)i * 4); v2u w; w.x = pk2(v.x, v.y); w.y = pk2(v.z, v.w); *(v2u*)(SR + (size_t)i * 4) = w; } }
    bf16* XN = (bf16*)(F.ws + WS_XN);
    for (int m = gw; m < MT; m += NGW) {
        const float* xr = m < MP ? AR.in[I_XP] + (size_t)m * DM : AR.in[I_XS] + (size_t)(m - MP) * DM;
        rms_row_to_bf16(xr, AR.in[I_NORMG], XN + (size_t)m * DM, lane);
    }
}

struct EpiG1 {
    static constexpr bool PERM = true, AFTER_DRAIN = false;
    int part; unsigned char* ws; float* out; int pn_off;
    __device__ __forceinline__ void operator()(const f32x4 (&acc)[2][2][4][2], const pg8::Unit& u, int wr, int wc, int fr, int fq) const {
        bf16* dst; int ld, act = 0, valid = 256, side = 0;
        const int pn = u.pn + pn_off;
        if (part == 0) {
            if (pn < 4) { dst = (bf16*)(ws + WS_Q) + pn * 256; ld = DM; }
            else if (pn == 4) { dst = (bf16*)(ws + WS_K); ld = KVW; side = 1; }
            else if (pn == 5) { dst = (bf16*)(ws + WS_V); ld = KVW; side = 2; }
            else { dst = (bf16*)(ws + WS_GA) + (pn - 6) * 256; ld = DM; act = 1; }
        } else {
            if (pn < 13) { dst = (bf16*)(ws + WS_PS) + pn * 256; ld = SHW; side = 3; if (pn == 12) valid = 128; }
            else if (pn < 17) { dst = (bf16*)(ws + WS_GA) + (pn - 13) * 256; ld = DM; act = 1; }
            else if (pn < 21) { dst = (bf16*)out + (pn - 17) * 256; ld = DM; act = 2; }
            else { dst = (bf16*)out + (size_t)MT * DM + (pn - 21) * 256; ld = DM; act = 2; }
        }
        const int rt0 = wr * 64 + fr, cit0 = wc * 32 + 8 * fq;
#pragma unroll
        for (int ai = 0; ai < 2; ++ai)
#pragma unroll
            for (int m = 0; m < 4; ++m) { bf16* rowp = dst + (size_t)(u.pm * 256 + rt0 + ai * 128 + m * 16) * ld + cit0;
#pragma unroll
                for (int bj = 0; bj < 2; ++bj) { if (bj * 128 >= valid) continue;
                    f32x4 v0 = acc[ai][bj][m][0], v1 = acc[ai][bj][m][1];
                    if (act) {
#pragma unroll
                        for (int e = 0; e < 4; ++e) { const float s0 = sigmoidf_(v0[e]), s1 = sigmoidf_(v1[e]); v0[e] = act == 1 ? v0[e] * s0 : s0; v1[e] = act == 1 ? v1[e] * s1 : s1; }
                    }
                    pg8::u32x4 w; w.x = pg8::cvt_pk_bf16(v0[0], v0[1]); w.y = pg8::cvt_pk_bf16(v0[2], v0[3]); w.z = pg8::cvt_pk_bf16(v1[0], v1[1]); w.w = pg8::cvt_pk_bf16(v1[2], v1[3]);
                    *(pg8::u32x4*)(rowp + bj * 128) = w; } }
        int r0 = rt0, c0 = cit0;
        if (side) asm volatile("" : "+v"(r0), "+v"(c0));
        if (side == 1 || side == 2) {
            if (u.pm < 128) {
                if ((u.pm & 15) == 15) { float* base = out + (side == 1 ? O_PKW : O_PVW) + (size_t)(u.pm >> 4) * WIN * KVW;
#pragma unroll
                    for (int m = 0; m < 4; ++m) { float* rp = base + (size_t)(r0 + m * 16) * KVW + c0;
#pragma unroll
                        for (int bj = 0; bj < 2; ++bj)
#pragma unroll
                            for (int n = 0; n < 2; ++n) *(f32x4*)(rp + bj * 128 + 4 * n) = acc[1][bj][m][n]; } }
            } else { float* base = out + (side == 1 ? O_SKW : O_SVW);
#pragma unroll
                for (int ai = 0; ai < 2; ++ai)
#pragma unroll
                    for (int m = 0; m < 4; ++m) { const int rs = (u.pm - 128) * 256 + r0 + ai * 128 + m * 16; float* rp = base + ((size_t)(rs >> 3) * WIN + 120 + (rs & 7)) * KVW + c0;
#pragma unroll
                        for (int bj = 0; bj < 2; ++bj)
#pragma unroll
                            for (int n = 0; n < 2; ++n) *(f32x4*)(rp + bj * 128 + 4 * n) = acc[ai][bj][m][n]; }
            }
        } else if (side == 3) {
            if (u.pm < 128) {
                if ((u.pm & 15) == 15 && wr == 1 && fr == 15) { float* rp = out + O_PSH + (size_t)(u.pm >> 4) * SHW + pn * 256 + c0;
#pragma unroll
                    for (int bj = 0; bj < 2; ++bj) { if (bj * 128 >= valid) continue;
#pragma unroll
                        for (int n = 0; n < 2; ++n) *(f32x4*)(rp + bj * 128 + 4 * n) = acc[1][bj][3][n]; } }
            } else if ((fr & 7) == 7) {
#pragma unroll
                for (int ai = 0; ai < 2; ++ai)
#pragma unroll
                    for (int m = 0; m < 4; ++m) { const int rs = (u.pm - 128) * 256 + r0 + ai * 128 + m * 16; float* rp = out + O_SSH + (size_t)(rs >> 3) * SHW + pn * 256 + c0;
#pragma unroll
                        for (int bj = 0; bj < 2; ++bj) { if (bj * 128 >= valid) continue;
#pragma unroll
                            for (int n = 0; n < 2; ++n) *(f32x4*)(rp + bj * 128 + 4 * n) = acc[ai][bj][m][n]; } }
            }
        }
    }
};
struct EpiGate {
    static constexpr bool PERM = true, AFTER_DRAIN = false;
    int mode; const bf16* gate; const bf16* tin; bf16* dst;
    __device__ __forceinline__ void operator()(const f32x4 (&acc)[2][2][4][2], const pg8::Unit& u, int wr, int wc, int fr, int fq) const {
        const int rt0 = u.pm * 256 + wr * 64 + fr, c0 = u.pn * 256 + wc * 32 + 8 * fq;
#pragma unroll
        for (int ai = 0; ai < 2; ++ai)
#pragma unroll
            for (int m = 0; m < 4; ++m) { const size_t ro = (size_t)(rt0 + ai * 128 + m * 16) * DM + c0;
#pragma unroll
                for (int bj = 0; bj < 2; ++bj) {
                    const v4u g = *(const v4u*)(gate + ro + bj * 128);
                    f32x4 v0 = acc[ai][bj][m][0], v1 = acc[ai][bj][m][1];
                    v0[0] *= bflo(g.x); v0[1] *= bfhi(g.x); v0[2] *= bflo(g.y); v0[3] *= bfhi(g.y); v1[0] *= bflo(g.z); v1[1] *= bfhi(g.z); v1[2] *= bflo(g.w); v1[3] *= bfhi(g.w);
                    if (mode == 1) { const v4u t = *(const v4u*)(tin + ro + bj * 128);
                        v0[0] += bflo(t.x); v0[1] += bfhi(t.x); v0[2] += bflo(t.y); v0[3] += bfhi(t.y); v1[0] += bflo(t.z); v1[1] += bfhi(t.z); v1[2] += bflo(t.w); v1[3] += bfhi(t.w); }
                    pg8::u32x4 w; w.x = pg8::cvt_pk_bf16(v0[0], v0[1]); w.y = pg8::cvt_pk_bf16(v0[2], v0[3]); w.z = pg8::cvt_pk_bf16(v1[0], v1[1]); w.w = pg8::cvt_pk_bf16(v1[2], v1[3]);
                    *(pg8::u32x4*)(dst + ro + bj * 128) = w; } }
    }
};
struct EpiOut {
    static constexpr bool PERM = false, AFTER_DRAIN = false;
    const float* xp; const float* xs; float* out; float* ss;
    __device__ __forceinline__ void operator()(const f32x4 (&acc)[2][2][4][2], const pg8::Unit& u, int wr, int wc, int fr, int fq) const {
        const int rt0 = u.pm * 256 + wr * 64 + fr, c0 = u.pn * 256 + wc * 32 + 4 * fq;
#pragma unroll
        for (int ai = 0; ai < 2; ++ai)
#pragma unroll
            for (int m = 0; m < 4; ++m) { const int row = rt0 + ai * 128 + m * 16;
                const float* xr = (row < MP ? xp + (size_t)row * DM : xs + (size_t)(row - MP) * DM) + c0; float* orow = out + (size_t)row * DM + c0; float s = 0.f;
#pragma unroll
                for (int bj = 0; bj < 2; ++bj)
#pragma unroll
                    for (int n = 0; n < 2; ++n) { const f32x4 xv = *(const f32x4*)(xr + bj * 128 + n * 16); const f32x4 o = xv + acc[ai][bj][m][n];
                        *(f32x4*)(orow + bj * 128 + n * 16) = o; s += (o[0] * o[0] + o[1] * o[1]) + (o[2] * o[2] + o[3] * o[3]); }
                s += __shfl_xor(s, 16); s += __shfl_xor(s, 32);
                if (fq == 0) atomicAdd(ss + row, s); }
    }
};

__device__ const unsigned char T5B[132] = {0, 1, 2, 3, 4, 5, 6, 7, 8, 9, 10, 11, 12, 13, 14, 15, 16, 16, 16, 17, 17, 18, 18, 18, 19, 19, 19, 20, 20, 20, 20, 21, 21, 21, 21, 22, 22, 22, 22, 22, 23, 23, 23, 23, 23, 23, 24, 24, 24, 24, 24, 24, 25, 25, 25, 25, 25, 25, 25, 26, 26, 26, 26, 26, 26, 26, 26, 27, 27, 27, 27, 27, 27, 27, 27, 27, 27, 28, 28, 28, 28, 28, 28, 28, 28, 28, 28, 29, 29, 29, 29, 29, 29, 29, 29, 29, 29, 29, 29, 30, 30, 30, 30, 30, 30, 30, 30, 30, 30, 30, 30, 30, 30, 31, 31, 31, 31, 31, 31, 31, 31, 31, 31, 31, 31, 31, 31, 31, 31, 31, 31, 31};
constexpr int AT_KP = 144, AT_VP = 520, AT_VT_OFF = 256 * AT_KP, AT_BT_OFF = AT_VT_OFF + 64 * AT_VP;
__device__ __forceinline__ int crow(int r, int hi) { return (r & 3) + 8 * (r >> 2) + 4 * hi; }

template <int MODE>
__device__ __forceinline__ void attn_task(const Frame& F, const Args& AR, bf16* OB_, int b, int kvh, int n, int g_, int i) {
    LAS unsigned char* KL = F.lds; LAS unsigned char* VT = F.lds + AT_VT_OFF; LAS float* BT = (LAS float*)(F.lds + AT_BT_OFF);
    const int lane = lane_id(), q = lane & 31, hi = lane >> 5;
    int g, mq, dq;
    if (MODE == 0) { g = g_; mq = b * SEQ + n * 128 + 32 * i + q; dq = 128 + q; }
    else { g = q >> 3; mq = MP + b * DECS + (q & 7); dq = 128 + (q & 7); }
    const int h = kvh * 4 + g;
    bf16* QO = (bf16*)(F.ws + WS_Q); const bf16* GA = (const bf16*)(F.ws + WS_GA);
    bf16x8 qf[4];
    { const bf16* qp = QO + (size_t)mq * DM + h * HD + 8 * hi;
#pragma unroll
      for (int s = 0; s < 4; ++s) qf[s] = *(const bf16x8*)(qp + 16 * s); }
    const int kt0 = MODE == 0 ? i : 0;
    f32x16 sc[5];
    const float sink = AR.in[I_SINK][h];
    const LAS float* bt = BT + g * 192 + 32 + dq - 4 * hi;
    float mx = sink;
#pragma unroll
    for (int t = 0; t < 5; ++t) { const LAS unsigned char* kp = KL + (32 * (kt0 + t) + q) * AT_KP + 16 * hi; f32x16 a = {0.f, 0.f, 0.f, 0.f, 0.f, 0.f, 0.f, 0.f, 0.f, 0.f, 0.f, 0.f, 0.f, 0.f, 0.f, 0.f};
#pragma unroll
        for (int s = 0; s < 4; ++s) { const bf16x8 kf = *(const LAS bf16x8*)(kp + 32 * s); a = __builtin_amdgcn_mfma_f32_32x32x16_bf16(kf, qf[s], a, 0, 0, 0); }
        const bool dead = (MODE == 0) && n == 0 && (i + t) < 4;
#pragma unroll
        for (int r = 0; r < 16; ++r) { const int kb0 = 32 * t + (r & 3) + 8 * (r >> 2);
            float sv = a[r] * 0.125f + bt[-kb0]; sv = dead ? -INFINITY : sv; a[r] = sv; mx = fmaxf(mx, sv); }
        sc[t] = a;
        __builtin_amdgcn_sched_barrier(0); }
    mx = fmaxf(mx, __shfl_xor(mx, 32));
    float sum = 0.f;
#pragma unroll
    for (int t = 0; t < 5; ++t)
#pragma unroll
        for (int r = 0; r < 16; ++r) { const float p = __expf(sc[t][r] - mx); sum += p; sc[t][r] = p; }
    sum += __shfl_xor(sum, 32); sum += __expf(sink - mx);
    const float inv = 1.0f / sum;
    f32x16 o[2];
#pragma unroll
    for (int d = 0; d < 2; ++d) o[d] = (f32x16){0.f, 0.f, 0.f, 0.f, 0.f, 0.f, 0.f, 0.f, 0.f, 0.f, 0.f, 0.f, 0.f, 0.f, 0.f, 0.f};
#pragma unroll
    for (int t = 0; t < 5; ++t)
#pragma unroll
        for (int s2 = 0; s2 < 2; ++s2) {
            v4u pw; pw.x = pk2(sc[t][8 * s2 + 0], sc[t][8 * s2 + 1]); pw.y = pk2(sc[t][8 * s2 + 2], sc[t][8 * s2 + 3]); pw.z = pk2(sc[t][8 * s2 + 4], sc[t][8 * s2 + 5]); pw.w = pk2(sc[t][8 * s2 + 6], sc[t][8 * s2 + 7]);
            const bf16x8 pb = __builtin_bit_cast(bf16x8, pw);
#pragma unroll
            for (int d = 0; d < 2; ++d) { const LAS unsigned char* vp = VT + (32 * d + q) * AT_VP + (32 * (kt0 + t) + 16 * s2 + 4 * hi) * 2;
                const v2u lo = *(const LAS v2u*)vp, hi2 = *(const LAS v2u*)(vp + 16);
                v4u aw; aw.x = lo.x; aw.y = lo.y; aw.z = hi2.x; aw.w = hi2.y;
                o[d] = __builtin_amdgcn_mfma_f32_32x32x16_bf16(__builtin_bit_cast(bf16x8, aw), pb, o[d], 0, 0, 0); }
            __builtin_amdgcn_sched_barrier(0); }
    bf16* op = OB_ + (size_t)mq * DM + h * HD; const bf16* gp = GA + (size_t)mq * DM + h * HD;
#pragma unroll
    for (int d = 0; d < 2; ++d)
#pragma unroll
        for (int rq = 0; rq < 4; ++rq) { const int dv0 = 32 * d + 8 * rq + 4 * hi; const v2u gv = *(const v2u*)(gp + dv0);
            v2u w; w.x = pk2(o[d][4 * rq + 0] * inv * bflo(gv.x), o[d][4 * rq + 1] * inv * bfhi(gv.x)); w.y = pk2(o[d][4 * rq + 2] * inv * bflo(gv.y), o[d][4 * rq + 3] * inv * bfhi(gv.y));
            *(v2u*)(op + dv0) = w; }
}

__device__ __forceinline__ void attn_unit(const Frame& F, const Args& AR, int unit, bf16* OB_) {
    LAS unsigned char* KL = F.lds; LAS unsigned char* VT = F.lds + AT_VT_OFF; LAS float* BT = (LAS float*)(F.lds + AT_BT_OFF);
    const bf16* Kb = (const bf16*)(F.ws + WS_K); const bf16* Vb = (const bf16*)(F.ws + WS_V);
    const int tid = F.wave * 64 + lane_id();
    __syncthreads();
    int b, kvh, n = 0;
    const bool sample = unit >= 1024;
    if (!sample) {
        kvh = unit & 3; n = (unit >> 2) & 31; b = unit >> 7;
        const int t0 = (n - 1) * 128;
#pragma unroll
        for (int it = 0; it < 4; ++it) { const int c = it * NTHR + tid, key = c >> 3, part = c & 7, tok = t0 + key; v4u val = (v4u){0u, 0u, 0u, 0u};
            if (tok >= 0) val = *(const v4u*)(Kb + (size_t)(b * SEQ + tok) * KVW + kvh * HD + part * 8);
            *(LAS v4u*)(KL + key * AT_KP + part * 16) = val; }
#pragma unroll
        for (int it = 0; it < 4; ++it) { const int c = it * NTHR + tid, key = c & 255, part = c >> 8, tok = t0 + key; v4u val = (v4u){0u, 0u, 0u, 0u};
            if (tok >= 0) val = *(const v4u*)(Vb + (size_t)(b * SEQ + tok) * KVW + kvh * HD + part * 8);
            LAS bf16* vt = (LAS bf16*)(VT + (part * 8) * AT_VP + key * 2);
            vt[0 * (AT_VP / 2)] = (bf16)val.x; vt[1 * (AT_VP / 2)] = (bf16)(val.x >> 16); vt[2 * (AT_VP / 2)] = (bf16)val.y; vt[3 * (AT_VP / 2)] = (bf16)(val.y >> 16);
            vt[4 * (AT_VP / 2)] = (bf16)val.z; vt[5 * (AT_VP / 2)] = (bf16)(val.z >> 16); vt[6 * (AT_VP / 2)] = (bf16)val.w; vt[7 * (AT_VP / 2)] = (bf16)(val.w >> 16); }
    } else {
        const int su = unit - 1024; kvh = su & 3; b = su >> 2;
        for (int c = tid; c < 160 * 8; c += NTHR) {
            { const int key = c >> 3, part = c & 7; v4u val = (v4u){0u, 0u, 0u, 0u};
              if (key < 128) { const float* src = AR.in[I_CK] + ((size_t)(b * WIN + key) * NKV + kvh) * HD + part * 8; const f32x4 a = *(const f32x4*)src, bb = *(const f32x4*)(src + 4);
                  val.x = pk2(a.x, a.y); val.y = pk2(a.z, a.w); val.z = pk2(bb.x, bb.y); val.w = pk2(bb.z, bb.w);
                  if (key >= 8) { float* d = F.out + O_SKW + ((size_t)(b * WIN + key - 8) * NKV + kvh) * HD + part * 8; *(f32x4*)d = a; *(f32x4*)(d + 4) = bb; } }
              else if (key < 136) val = *(const v4u*)(Kb + (size_t)(MP + b * DECS + key - 128) * KVW + kvh * HD + part * 8);
              *(LAS v4u*)(KL + key * AT_KP + part * 16) = val; }
            { const int key = c % 160, part = c / 160; v4u val = (v4u){0u, 0u, 0u, 0u};
              if (key < 128) { const float* src = AR.in[I_CV] + ((size_t)(b * WIN + key) * NKV + kvh) * HD + part * 8; const f32x4 a = *(const f32x4*)src, bb = *(const f32x4*)(src + 4);
                  val.x = pk2(a.x, a.y); val.y = pk2(a.z, a.w); val.z = pk2(bb.x, bb.y); val.w = pk2(bb.z, bb.w);
                  if (key >= 8) { float* d = F.out + O_SVW + ((size_t)(b * WIN + key - 8) * NKV + kvh) * HD + part * 8; *(f32x4*)d = a; *(f32x4*)(d + 4) = bb; } }
              else if (key < 136) val = *(const v4u*)(Vb + (size_t)(MP + b * DECS + key - 128) * KVW + kvh * HD + part * 8);
              LAS bf16* vt = (LAS bf16*)(VT + (part * 8) * AT_VP + key * 2);
              vt[0 * (AT_VP / 2)] = (bf16)val.x; vt[1 * (AT_VP / 2)] = (bf16)(val.x >> 16); vt[2 * (AT_VP / 2)] = (bf16)val.y; vt[3 * (AT_VP / 2)] = (bf16)(val.y >> 16);
              vt[4 * (AT_VP / 2)] = (bf16)val.z; vt[5 * (AT_VP / 2)] = (bf16)(val.z >> 16); vt[6 * (AT_VP / 2)] = (bf16)val.w; vt[7 * (AT_VP / 2)] = (bf16)(val.w >> 16); }
        }
    }
    for (int idx = tid; idx < 4 * 192; idx += NTHR) { const int g = idx / 192, d = idx - g * 192 - 32; BT[idx] = (d >= 0 && d <= 128) ? AR.in[I_RELB][(int)T5B[d] * NH + kvh * 4 + g] : -INFINITY; }
    __syncthreads();
    if (!sample) { for (int task = F.wave; task < 16; task += NWAVES) attn_task<0>(F, AR, OB_, b, kvh, n, task >> 2, task & 3); }
    else if (F.wave == 0) attn_task<1>(F, AR, OB_, b, kvh, 0, 0, 0);
}

namespace s3 {
constexpr int P68 = 136, P36 = 72;
constexpr int W2T = 0, A2T = W2T + 64 * P68, PAR = A2T + 64 * P68, YT = PAR + 12 * 256  , XCH = YT + 2 * 4608  , GCRK = XCH + 1280  , SCR = GCRK + 12 * 384;
constexpr int RM0 = 0, RM1 = 2304, IMGV = 4608, IMG2 = 9216, SCRW = 13824;
constexpr int END = SCR + 6 * SCRW;
static_assert(END <= RING_BYTES && (YT % 16) == 0 && (SCR % 16) == 0, "scan LDS map");
constexpr int R_R2 = 0, R_Y02 = 4096, R_G = 8192, R_H = 16384, R_V = 24576, R_GC = 28672, R_RK = 28928, R_SIZE = 29184, RING = 12;
constexpr size_t RING_BYTES_WG = (size_t)RING * R_SIZE;
static_assert(128 * RING_BYTES_WG <= 48 * MiB && 64 * RING_BYTES_WG <= 33 * MiB, "record rings: prompt workgroups at WS_RING, sample workgroups in the K/V region");
}
typedef float f32x2_t __attribute__((ext_vector_type(2))); typedef __bf16 bf16x2_t __attribute__((ext_vector_type(2)));
__device__ __forceinline__ unsigned cvtpk(float lo, float hi) { f32x2_t v = {lo, hi}; bf16x2_t b = __builtin_convertvector(v, bf16x2_t); return __builtin_bit_cast(unsigned, b); }
__device__ __forceinline__ bf16x8 frag_nat(LAS const unsigned char* base, int pitch, int row, int col0) {
    LAS const unsigned char* p = base + row * pitch + col0 * 2; const v2u a = *(LAS const v2u*)p, b = *(LAS const v2u*)(p + 8);
    v4u w; w.x = a.x; w.y = a.y; w.z = b.x; w.w = b.y; return __builtin_bit_cast(bf16x8, w); }
__device__ __forceinline__ bf16x8 frag_perm(LAS const unsigned char* base, int pitch, int row, int c0, int hi) {
    LAS const unsigned char* p = base + row * pitch + (c0 + 4 * hi) * 2; const v2u a = *(LAS const v2u*)p, b = *(LAS const v2u*)(p + 16);
    v4u w; w.x = a.x; w.y = a.y; w.z = b.x; w.w = b.y; return __builtin_bit_cast(bf16x8, w); }
__device__ __forceinline__ bf16x8 pk8(const f32x16& x, int s) {
    v4u w; w.x = cvtpk(x[8 * s + 0], x[8 * s + 1]); w.y = cvtpk(x[8 * s + 2], x[8 * s + 3]); w.z = cvtpk(x[8 * s + 4], x[8 * s + 5]); w.w = cvtpk(x[8 * s + 6], x[8 * s + 7]); return __builtin_bit_cast(bf16x8, w); }
__device__ __forceinline__ bf16x8 pk8f(const float* x) { v4u w; w.x = cvtpk(x[0], x[1]); w.y = cvtpk(x[2], x[3]); w.z = cvtpk(x[4], x[5]); w.w = cvtpk(x[6], x[7]); return __builtin_bit_cast(bf16x8, w); }
__device__ __forceinline__ void store_rm(LAS unsigned char* base, int pitch, const f32x16& x, int q, int hi) {
#pragma unroll
    for (int r = 0; r < 16; r += 2) { const unsigned w = cvtpk(x[r], x[r + 1]);
        *(LAS bf16*)(base + crow(r, hi) * pitch + 2 * q) = (bf16)w; *(LAS bf16*)(base + crow(r + 1, hi) * pitch + 2 * q) = (bf16)(w >> 16); }
}
__device__ __forceinline__ void store16bf(unsigned char* p, const f32x16& x) {
    v4u a, b; a.x = cvtpk(x[0], x[1]); a.y = cvtpk(x[2], x[3]); a.z = cvtpk(x[4], x[5]); a.w = cvtpk(x[6], x[7]); b.x = cvtpk(x[8], x[9]); b.y = cvtpk(x[10], x[11]); b.z = cvtpk(x[12], x[13]); b.w = cvtpk(x[14], x[15]);
    *(v4u*)p = a; *(v4u*)(p + 16) = b; }
__device__ __forceinline__ f32x16 load16bf(const unsigned char* p) {
    const v4u a = *(const v4u*)p, b = *(const v4u*)(p + 16);
    return (f32x16){bflo(a.x), bfhi(a.x), bflo(a.y), bfhi(a.y), bflo(a.z), bfhi(a.z), bflo(a.w), bfhi(a.w), bflo(b.x), bfhi(b.x), bflo(b.y), bfhi(b.y), bflo(b.z), bfhi(b.z), bflo(b.w), bfhi(b.w)}; }
#define MFMA32(a, b, c) __builtin_amdgcn_mfma_f32_32x32x16_bf16((a), (b), (c), 0, 0, 0)
#define ZERO16 ((f32x16){0.f, 0.f, 0.f, 0.f, 0.f, 0.f, 0.f, 0.f, 0.f, 0.f, 0.f, 0.f, 0.f, 0.f, 0.f, 0.f})
#define DPPV(x, ctrl, rowmask) __builtin_bit_cast(float, __builtin_amdgcn_update_dpp(0, __builtin_bit_cast(int, (x)), (ctrl), (rowmask), 0xF, true))
__device__ __forceinline__ float tanh_fast(float x) { return 1.0f - 2.0f * __builtin_amdgcn_rcpf(__expf(2.0f * x) + 1.0f); }
__device__ __forceinline__ float xhalf_sum(float x) { return x + __shfl_xor(x, 32); }

__device__ __forceinline__ void s1_stage(LAS unsigned char* stg, const bf16* PS, size_t row0, const bf16* vrow, int col0, int nrows, int lane) {
    v4u x[5];
#pragma unroll
    for (int i = 0; i < 5; ++i) { const int p = lane + 64 * i; int row = p >> 3; const int piece = p & 7; if (row > nrows) row = nrows;
        const bf16* rp = (row == 0 && vrow) ? vrow : PS + (row0 + row - 1) * SHW;
        if (i < 4 || lane < 8) x[i] = *(const v4u*)(rp + col0 + piece * 8); }
#pragma unroll
    for (int i = 0; i < 5; ++i) { const int p = lane + 64 * i; const int row = p >> 3, piece = p & 7;
        if (i < 4 || lane < 8) { LAS unsigned char* d = stg + row * 136 + piece * 16; *(LAS v2u*)d = (v2u){x[i].x, x[i].y}; *(LAS v2u*)(d + 8) = (v2u){x[i].z, x[i].w}; } }
}
__device__ __forceinline__ f32x4 s1_z4(LAS const unsigned char* stg, int t, int off, f32x4 mu, bool act) {
    const v2u cu = *(LAS const v2u*)(stg + (t + 1) * 136 + off), pu = *(LAS const v2u*)(stg + t * 136 + off);
    const f32x4 cur = {bflo(cu.x), bfhi(cu.x), bflo(cu.y), bfhi(cu.y)}, prv = {bflo(pu.x), bfhi(pu.x), bflo(pu.y), bfhi(pu.y)};
    f32x4 z = cur + (prv - cur) * mu;
    if (!act) z = (f32x4){0.f, 0.f, 0.f, 0.f};
    return z;
}

__device__ __forceinline__ void s1_chunk(const Args& AR, LAS unsigned char* L, LAS unsigned char* scr, unsigned char* rec, LAS float* gcrk, const bf16* PS, size_t row0, const bf16* vrow  , int h, int ntok, int lane_) {
    int lane = lane_; asm volatile("" : "+v"(lane));
    const int t = lane & 31, hh = lane >> 5;
    const bool act = t < ntok;
    LAS unsigned char* stg = scr + s3::RM0;
    float lw[32]; unsigned asgp[16];
    {
        bf16x8 TWf[4], ALf[4];
        s1_stage(stg, PS, row0, vrow, 3072, ntok, lane);
#pragma unroll
        for (int s = 0; s < 4; ++s) { const int jb = 16 * s + 8 * hh;
            const f32x4 w0 = s1_z4(stg, t, jb * 2, *(LAS const f32x4*)(L + s3::PAR + 10 * 256 + jb * 4), act), w1 = s1_z4(stg, t, jb * 2 + 8, *(LAS const f32x4*)(L + s3::PAR + 10 * 256 + (jb + 4) * 4), act);
            const float tw[8] = {tanh_fast(w0[0]), tanh_fast(w0[1]), tanh_fast(w0[2]), tanh_fast(w0[3]), tanh_fast(w1[0]), tanh_fast(w1[1]), tanh_fast(w1[2]), tanh_fast(w1[3])};
            TWf[s] = pk8f(tw); }
        __builtin_amdgcn_sched_barrier(0);
        s1_stage(stg, PS, row0, vrow, 3136, ntok, lane);
#pragma unroll
        for (int s = 0; s < 4; ++s) { const int jb = 16 * s + 8 * hh;
            const f32x4 a0 = s1_z4(stg, t, jb * 2, *(LAS const f32x4*)(L + s3::PAR + 11 * 256 + jb * 4), act), a1 = s1_z4(stg, t, jb * 2 + 8, *(LAS const f32x4*)(L + s3::PAR + 11 * 256 + (jb + 4) * 4), act);
            const float al[8] = {a0[0], a0[1], a0[2], a0[3], a1[0], a1[1], a1[2], a1[3]};
            ALf[s] = pk8f(al); }
        __builtin_amdgcn_sched_barrier(0);
        f32x16 uw[2] = {ZERO16, ZERO16}, ua[2] = {ZERO16, ZERO16};
#pragma unroll
        for (int ct = 0; ct < 2; ++ct)
#pragma unroll
            for (int s = 0; s < 4; ++s) { uw[ct] = MFMA32(frag_nat(L + s3::W2T, s3::P68, 32 * ct + t, 16 * s + 8 * hh), TWf[s], uw[ct]);
                                          ua[ct] = MFMA32(frag_nat(L + s3::A2T, s3::P68, 32 * ct + t, 16 * s + 8 * hh), ALf[s], ua[ct]);
                                          if (s & 1) __builtin_amdgcn_sched_barrier(0); }
#pragma unroll
        for (int u = 0; u < 8; ++u) { const int chb = 8 * u + 4 * hh; const f32x4 w0 = *(LAS const f32x4*)(L + s3::PAR + 0 * 256 + chb * 4), a0 = *(LAS const f32x4*)(L + s3::PAR + 1 * 256 + chb * 4);
            float ag[4];
#pragma unroll
            for (int j = 0; j < 4; ++j) { const int sl = 4 * u + j;
                lw[sl] = act ? -0.6065306597126334f * sigmoidf_(uw[sl >> 4][sl & 15] + w0[j]) : 0.f; ag[j] = sigmoidf_(ua[sl >> 4][sl & 15] + a0[j]); }
            asgp[2 * u] = cvtpk(ag[0], ag[1]); asgp[2 * u + 1] = cvtpk(ag[2], ag[3]);
            if (u & 1) __builtin_amdgcn_sched_barrier(0); }
    }
    __builtin_amdgcn_sched_barrier(0);
#define Lc lw
#pragma unroll
    for (int sl = 0; sl < 32; ++sl) { float x = lw[sl];
        x += DPPV(x, 0x111, 0xF); x += DPPV(x, 0x112, 0xF); x += DPPV(x, 0x114, 0xF); x += DPPV(x, 0x118, 0xF);
        x += __builtin_bit_cast(float, __builtin_amdgcn_update_dpp(0, __builtin_bit_cast(int, x), 0x142, 0xA, 0xF, false));
        Lc[sl] = x; }
    __builtin_amdgcn_sched_barrier(0);
    {
        float zv[32]; bf16x8 Vf[4];
        s1_stage(stg, PS, row0, vrow, 2 * 1024 + h * HD, ntok, lane);
#pragma unroll
        for (int u = 0; u < 8; ++u) { const int chb = 8 * u + 4 * hh;
            const f32x4 c = s1_z4(stg, t, chb * 2, *(LAS const f32x4*)(L + s3::PAR + 9 * 256 + chb * 4), act);
#pragma unroll
            for (int j = 0; j < 4; ++j) zv[4 * u + j] = c[j]; }
#pragma unroll
        for (int s = 0; s < 4; ++s) Vf[s] = pk8f(zv + 8 * s);
#pragma unroll
        for (int u = 0; u < 8; ++u)
#pragma unroll
            for (int j = 0; j < 4; j += 2) { const unsigned w = cvtpk(zv[4 * u + j], zv[4 * u + j + 1]);
                *(LAS bf16*)(scr + s3::IMGV + (8 * u + 4 * hh + j) * s3::P36 + 2 * t) = (bf16)w; *(LAS bf16*)(scr + s3::IMGV + (8 * u + 4 * hh + j + 1) * s3::P36 + 2 * t) = (bf16)(w >> 16); }
#pragma unroll
        for (int s = 0; s < 4; ++s) *(bf16x8*)(rec + s3::R_V + (s * 64 + lane) * 16) = Vf[s];
    }
    __builtin_amdgcn_sched_barrier(0);
    float rk = 0.f;
    f32x16 Mab = ZERO16, Mak = ZERO16, Mrk = ZERO16, Mrb = ZERO16;
    {
        unsigned zkp[16]; float ss = 0.f;
        s1_stage(stg, PS, row0, vrow, 1 * 1024 + h * HD, ntok, lane);
#pragma unroll
        for (int u = 0; u < 8; ++u) { const int chb = 8 * u + 4 * hh;
            const f32x4 b = s1_z4(stg, t, chb * 2, *(LAS const f32x4*)(L + s3::PAR + 8 * 256 + chb * 4), act);
            const f32x4 kkw = *(LAS const f32x4*)(L + s3::PAR + 2 * 256 + chb * 4);
#pragma unroll
            for (int j = 0; j < 4; ++j) { const float kk = b[j] * kkw[j]; ss += kk * kk; }
            zkp[2 * u] = cvtpk(b[0], b[1]); zkp[2 * u + 1] = cvtpk(b[2], b[3]); }
        ss = xhalf_sum(ss);
        const float invn = 1.0f / fmaxf(sqrtf(ss), 1e-12f);
        const int last = (lane & 32) | 31;
        __builtin_amdgcn_sched_barrier(0);
        s1_stage(stg, PS, row0, vrow, 0 * 1024 + h * HD, ntok, lane);
#pragma unroll
        for (int s = 0; s < 4; ++s) {
            unsigned aw[4], rw[4], bw[4], kw[4], hw[4];
#pragma unroll
            for (int e = 0; e < 2; ++e) { const int u = 2 * s + e, chb = 8 * u + 4 * hh;
                const f32x4 zr = s1_z4(stg, t, chb * 2, *(LAS const f32x4*)(L + s3::PAR + 7 * 256 + chb * 4), act);
                const f32x4 kkw = *(LAS const f32x4*)(L + s3::PAR + 2 * 256 + chb * 4), kaw = *(LAS const f32x4*)(L + s3::PAR + 3 * 256 + chb * 4), rkw = *(LAS const f32x4*)(L + s3::PAR + 4 * 256 + chb * 4);
                float at[4], rt[4], bt[4], kt[4], bh[4], kh[4];
                const float zk4[4] = {bflo(zkp[2 * u]), bfhi(zkp[2 * u]), bflo(zkp[2 * u + 1]), bfhi(zkp[2 * u + 1])}, as4[4] = {bflo(asgp[2 * u]), bfhi(asgp[2 * u]), bflo(asgp[2 * u + 1]), bfhi(asgp[2 * u + 1])};
#pragma unroll
                for (int j = 0; j < 4; ++j) { const int sl = 4 * u + j;
                    const float lp = __shfl_up(Lc[sl], 1); const float e2 = __expf(Lc[sl]), e1 = __expf(t == 0 ? 0.f : lp), e3 = __builtin_amdgcn_rcpf(e2), gcv = __shfl(e2, last), e4 = gcv * e3;
                    const float kn = zk4[j] * kkw[j] * invn, kp = zk4[j] * (1.0f + (as4[j] - 1.0f) * kaw[j]), bb = kn * as4[j];
                    at[j] = -kn * e1; rt[j] = zr[j] * e2; bt[j] = bb * e3; kt[j] = kp * e3; bh[j] = bb * e4; kh[j] = kp * e4; rk += zr[j] * kp * rkw[j]; }
#pragma unroll
                for (int p = 0; p < 2; ++p) { aw[2 * e + p] = cvtpk(at[2 * p], at[2 * p + 1]); rw[2 * e + p] = cvtpk(rt[2 * p], rt[2 * p + 1]); bw[2 * e + p] = cvtpk(bt[2 * p], bt[2 * p + 1]); kw[2 * e + p] = cvtpk(kt[2 * p], kt[2 * p + 1]); hw[2 * e + p] = cvtpk(bh[2 * p], bh[2 * p + 1]);
                    const unsigned w = cvtpk(kh[2 * p], kh[2 * p + 1]); const int ch = chb + 2 * p;
                    *(LAS bf16*)(scr + s3::IMG2 + ch * s3::P36 + 2 * t) = (bf16)w; *(LAS bf16*)(scr + s3::IMG2 + (ch + 1) * s3::P36 + 2 * t) = (bf16)(w >> 16); } }
            const bf16x8 Af = __builtin_bit_cast(bf16x8, (v4u){aw[0], aw[1], aw[2], aw[3]}), Rf = __builtin_bit_cast(bf16x8, (v4u){rw[0], rw[1], rw[2], rw[3]}), Bf = __builtin_bit_cast(bf16x8, (v4u){bw[0], bw[1], bw[2], bw[3]}), Kf = __builtin_bit_cast(bf16x8, (v4u){kw[0], kw[1], kw[2], kw[3]});
            Mab = MFMA32(Af, Bf, Mab); Mak = MFMA32(Af, Kf, Mak); Mrk = MFMA32(Rf, Kf, Mrk); Mrb = MFMA32(Rf, Bf, Mrb);
            *(bf16x8*)(rec + s3::R_G + 4096 + (s * 64 + lane) * 16) = Af; *(bf16x8*)(rec + s3::R_R2 + (s * 64 + lane) * 16) = Rf; *(v4u*)(rec + s3::R_G + (s * 64 + lane) * 16) = (v4u){hw[0], hw[1], hw[2], hw[3]};
            __builtin_amdgcn_sched_barrier(0);
        }
        rk = xhalf_sum(rk);
        if (hh == 0) gcrk[64 + t] = rk;
        if (t == 31) {
#pragma unroll
            for (int u = 0; u < 8; ++u) *(LAS f32x4*)(gcrk + 8 * u + 4 * hh) = (f32x4){__expf(Lc[4 * u]), __expf(Lc[4 * u + 1]), __expf(Lc[4 * u + 2]), __expf(Lc[4 * u + 3])}; }
    }
#pragma unroll
    for (int r = 0; r < 16; ++r) { const int rr = crow(r, hh); Mab[r] = (t < rr) ? Mab[r] : 0.f; Mak[r] = (t < rr) ? Mak[r] : 0.f; Mrk[r] = (t <= rr) ? Mrk[r] : 0.f; Mrb[r] = (t <= rr) ? Mrb[r] : 0.f; }
#pragma unroll
    for (int kt = 0; kt < 2; ++kt)
#pragma unroll
        for (int vt = 0; vt < 2; ++vt) { f32x16 Hh = ZERO16;
#pragma unroll
            for (int s = 0; s < 2; ++s) Hh = MFMA32(frag_nat(scr + s3::IMG2, s3::P36, 32 * kt + t, 16 * s + 8 * hh), frag_nat(scr + s3::IMGV, s3::P36, 32 * vt + t, 16 * s + 8 * hh), Hh);
            store16bf(rec + s3::R_H + ((kt * 2 + vt) * 64 + lane) * 32, Hh); }
    __builtin_amdgcn_sched_barrier(0);
#define S1_IMG(img, f) do { _Pragma("unroll") for (int s_ = 0; s_ < 4; ++s_) { const v4u w_ = __builtin_bit_cast(v4u, (f)[s_]); _Pragma("unroll") for (int e_ = 0; e_ < 4; ++e_) { const unsigned x_ = e_ == 0 ? w_.x : (e_ == 1 ? w_.y : (e_ == 2 ? w_.z : w_.w)); \
        const int ch_ = 8 * (2 * s_ + (e_ >> 1)) + 4 * hh + 2 * (e_ & 1); *(LAS bf16*)(scr + (img) + ch_ * s3::P36 + 2 * t) = (bf16)x_; *(LAS bf16*)(scr + (img) + (ch_ + 1) * s3::P36 + 2 * t) = (bf16)(x_ >> 16); } } } while (0)
    f32x16 Tm;
    {
        f32x16 Pm = Mab;
        Tm = Pm;
#pragma unroll
        for (int r = 0; r < 16; ++r) Tm[r] += (crow(r, hh) == t) ? 1.0f : 0.0f;
#pragma unroll
        for (int lv = 0; lv < 4; ++lv) {
            store_rm(scr + s3::RM0, s3::P36, Pm, t, hh); store_rm(scr + s3::RM1, s3::P36, Tm, t, hh);
            const bf16x8 p0 = pk8(Pm, 0), p1 = pk8(Pm, 1);
            f32x16 Pn = MFMA32(frag_perm(scr + s3::RM0, s3::P36, t, 0, hh), p0, ZERO16); Pn = MFMA32(frag_perm(scr + s3::RM0, s3::P36, t, 16, hh), p1, Pn);
            const bf16x8 n0 = pk8(Pn, 0), n1 = pk8(Pn, 1);
            Tm = MFMA32(frag_perm(scr + s3::RM1, s3::P36, t, 0, hh), n0, Tm); Tm = MFMA32(frag_perm(scr + s3::RM1, s3::P36, t, 16, hh), n1, Tm);
            Pm = Pn;
        }
        store_rm(scr + s3::RM0, s3::P36, Tm, t, hh);
    }
    f32x16 W1[2];
    asm volatile("s_waitcnt vmcnt(0)" ::: "memory");
    { bf16x8 Atf[4];
#pragma unroll
      for (int s = 0; s < 4; ++s) Atf[s] = *(const bf16x8*)(rec + s3::R_G + 4096 + (s * 64 + lane) * 16);
      S1_IMG(s3::IMG2, Atf); }
#pragma unroll
    for (int nt = 0; nt < 2; ++nt) { W1[nt] = ZERO16;
#pragma unroll
        for (int s = 0; s < 2; ++s) W1[nt] = MFMA32(frag_nat(scr + s3::RM0, s3::P36, t, 16 * s + 8 * hh), frag_nat(scr + s3::IMG2, s3::P36, 32 * nt + t, 16 * s + 8 * hh), W1[nt]); }
    f32x16 W2[2];
    {
        store_rm(scr + s3::RM1, s3::P36, Mak, t, hh);
#pragma unroll
        for (int vt = 0; vt < 2; ++vt) { f32x16 X = ZERO16;
#pragma unroll
            for (int s = 0; s < 2; ++s) X = MFMA32(frag_nat(scr + s3::RM1, s3::P36, t, 16 * s + 8 * hh), frag_nat(scr + s3::IMGV, s3::P36, 32 * vt + t, 16 * s + 8 * hh), X);
            W2[vt] = MFMA32(frag_perm(scr + s3::RM0, s3::P36, t, 0, hh), pk8(X, 0), ZERO16); W2[vt] = MFMA32(frag_perm(scr + s3::RM0, s3::P36, t, 16, hh), pk8(X, 1), W2[vt]); }
    }
    f32x16 Y02[2];
    {
        store_rm(scr + s3::RM1, s3::P36, Mrk, t, hh);
#pragma unroll
        for (int vt = 0; vt < 2; ++vt) { Y02[vt] = ZERO16;
#pragma unroll
            for (int s = 0; s < 2; ++s) Y02[vt] = MFMA32(frag_nat(scr + s3::RM1, s3::P36, t, 16 * s + 8 * hh), frag_nat(scr + s3::IMGV, s3::P36, 32 * vt + t, 16 * s + 8 * hh), Y02[vt]); }
    }
    {
        store_rm(scr + s3::RM1, s3::P36, Mrb, t, hh);
        const bf16x8 mb0 = frag_perm(scr + s3::RM1, s3::P36, t, 0, hh), mb1 = frag_perm(scr + s3::RM1, s3::P36, t, 16, hh);
#pragma unroll
        for (int vt = 0; vt < 2; ++vt) { Y02[vt] = MFMA32(mb0, pk8(W2[vt], 0), Y02[vt]); Y02[vt] = MFMA32(mb1, pk8(W2[vt], 1), Y02[vt]);
            store16bf(rec + s3::R_Y02 + (vt * 64 + lane) * 32, Y02[vt]); }
#pragma unroll
        for (int kt = 0; kt < 2; ++kt) { f32x16 R2 = MFMA32(pk8(W1[kt], 0), mb0, ZERO16); R2 = MFMA32(pk8(W1[kt], 1), mb1, R2);
#pragma unroll
            for (int sx = 0; sx < 2; ++sx) { const v4u rw = *(const v4u*)(rec + s3::R_R2 + ((2 * kt + sx) * 64 + lane) * 16);
                R2[8 * sx + 0] += bflo(rw.x); R2[8 * sx + 1] += bfhi(rw.x); R2[8 * sx + 2] += bflo(rw.y); R2[8 * sx + 3] += bfhi(rw.y); R2[8 * sx + 4] += bflo(rw.z); R2[8 * sx + 5] += bfhi(rw.z); R2[8 * sx + 6] += bflo(rw.w); R2[8 * sx + 7] += bfhi(rw.w); }
            *(bf16x8*)(rec + s3::R_R2 + ((2 * kt + 0) * 64 + lane) * 16) = pk8(R2, 0); *(bf16x8*)(rec + s3::R_R2 + ((2 * kt + 1) * 64 + lane) * 16) = pk8(R2, 1); }
    }
    asm volatile("s_waitcnt vmcnt(0)" ::: "memory");
    { bf16x8 Bhf[4];
#pragma unroll
      for (int s = 0; s < 4; ++s) Bhf[s] = *(const bf16x8*)(rec + s3::R_G + (s * 64 + lane) * 16);
      S1_IMG(s3::IMG2, Bhf); }
#pragma unroll
    for (int kt = 0; kt < 2; ++kt) { const bf16x8 b0 = frag_perm(scr + s3::IMG2, s3::P36, 32 * kt + t, 0, hh), b1 = frag_perm(scr + s3::IMG2, s3::P36, 32 * kt + t, 16, hh);
#pragma unroll
        for (int vt = 0; vt < 2; ++vt) { f32x16 Hh = load16bf(rec + s3::R_H + ((kt * 2 + vt) * 64 + lane) * 32); Hh = MFMA32(b0, pk8(W2[vt], 0), Hh); Hh = MFMA32(b1, pk8(W2[vt], 1), Hh);
            store16bf(rec + s3::R_H + ((kt * 2 + vt) * 64 + lane) * 32, Hh); }
#pragma unroll
        for (int kp = 0; kp < 2; ++kp) { f32x16 G = MFMA32(pk8(W1[kp], 0), b0, ZERO16); G = MFMA32(pk8(W1[kp], 1), b1, G);
            *(bf16x8*)(rec + s3::R_G + (((kt * 2 + kp) * 2 + 0) * 64 + lane) * 16) = pk8(G, 0); *(bf16x8*)(rec + s3::R_G + (((kt * 2 + kp) * 2 + 1) * 64 + lane) * 16) = pk8(G, 1); } }
#undef S1_IMG
#undef Lc
}

struct S2Pre { bf16x8 R2p[4]; v4u Y02a, Y02b; };
__device__ __forceinline__ void s2_prefetch(S2Pre& p, const unsigned char* rec, int vt, int lane) {
#pragma unroll
    for (int s = 0; s < 4; ++s) p.R2p[s] = *(const bf16x8*)(rec + s3::R_R2 + (s * 64 + lane) * 16);
    p.Y02a = *(const v4u*)(rec + s3::R_Y02 + (vt * 64 + lane) * 32); p.Y02b = *(const v4u*)(rec + s3::R_Y02 + (vt * 64 + lane) * 32 + 16);
}
__device__ __forceinline__ f32x16 unpack16(v4u a, v4u b) {
    return (f32x16){bflo(a.x), bfhi(a.x), bflo(a.y), bfhi(a.y), bflo(a.z), bfhi(a.z), bflo(a.w), bfhi(a.w), bflo(b.x), bfhi(b.x), bflo(b.y), bfhi(b.y), bflo(b.z), bfhi(b.z), bflo(b.w), bfhi(b.w)}; }
__device__ __forceinline__ void s2_chunk(LAS unsigned char* L, const unsigned char* rec, const S2Pre& p, LAS const float* gcrk, f32x16 (&ST)[2], const bf16* GB, bf16* OB, size_t row0, int h, int ntok, int vt, unsigned cnt, int lane_) {
    int lane = lane_; asm volatile("" : "+v"(lane));
    const int q = lane & 31, hi = lane >> 5;
    bf16x8 Gp[2][2][2];
#pragma unroll
    for (int mt = 0; mt < 2; ++mt)
#pragma unroll
        for (int kp = 0; kp < 2; ++kp) { Gp[mt][kp][0] = *(const bf16x8*)(rec + s3::R_G + (((mt * 2 + kp) * 2 + 0) * 64 + lane) * 16); Gp[mt][kp][1] = *(const bf16x8*)(rec + s3::R_G + (((mt * 2 + kp) * 2 + 1) * 64 + lane) * 16); }
    v4u Ha[2], Hb[2];
#pragma unroll
    for (int mt = 0; mt < 2; ++mt) { Ha[mt] = *(const v4u*)(rec + s3::R_H + ((mt * 2 + vt) * 64 + lane) * 32); Hb[mt] = *(const v4u*)(rec + s3::R_H + ((mt * 2 + vt) * 64 + lane) * 32 + 16); }
    const int tq = q < ntok ? q : 0;
    const bf16* gp = GB + (row0 + tq) * DM + h * HD + 32 * vt + 4 * hi; bf16* op = OB + (row0 + tq) * DM + h * HD + 32 * vt + 4 * hi;
    v4u Vp[2]; v2u gv[4];
#pragma unroll
    for (int e = 0; e < 2; ++e) Vp[e] = *(const v4u*)(rec + s3::R_V + ((2 * vt + e) * 64 + lane) * 16);
#pragma unroll
    for (int u = 0; u < 4; ++u) gv[u] = *(const v2u*)(gp + 8 * u);
    bf16x8 Sb[2][2];
#pragma unroll
    for (int kt = 0; kt < 2; ++kt) { Sb[kt][0] = pk8(ST[kt], 0); Sb[kt][1] = pk8(ST[kt], 1); }
    LAS float* YT = (LAS float*)(L + s3::YT + vt * 4608);
    {
        f32x16 Y = unpack16(p.Y02a, p.Y02b);
#pragma unroll
        for (int kt = 0; kt < 2; ++kt) { Y = MFMA32(p.R2p[2 * kt + 0], Sb[kt][0], Y); Y = MFMA32(p.R2p[2 * kt + 1], Sb[kt][1], Y); }
#pragma unroll
        for (int r = 0; r < 16; ++r) YT[crow(r, hi) * 36 + q] = Y[r];
    }
    {
        const int t = q, hh = hi;
        float y[16]; float s1 = 0.f, s2 = 0.f;
#pragma unroll
        for (int u = 0; u < 4; ++u) { const f32x4 v = *(LAS const f32x4*)(YT + t * 36 + 8 * u + 4 * hh); y[4 * u] = v.x; y[4 * u + 1] = v.y; y[4 * u + 2] = v.z; y[4 * u + 3] = v.w;
            s1 += (v.x + v.y) + (v.z + v.w); s2 += (v.x * v.x + v.y * v.y) + (v.z * v.z + v.w * v.w); }
        s1 = xhalf_sum(s1); s2 = xhalf_sum(s2);
        volatile LAS float* XCH = (volatile LAS float*)(L + s3::XCH);
        volatile LAS unsigned* FLG = (volatile LAS unsigned*)(L + s3::XCH + 1024);
        const int par = cnt & 1;
        if (hh == 0) { XCH[((par * 2 + vt) * 32 + t) * 2] = s1; XCH[((par * 2 + vt) * 32 + t) * 2 + 1] = s2; }
        asm volatile("s_waitcnt lgkmcnt(0)" ::: "memory");
        if (lane == 0) FLG[vt] = cnt + 1u;
        { unsigned spin = 0; while (FLG[vt ^ 1] < cnt + 1u) { __builtin_amdgcn_s_sleep(1); if (++spin > (1u << 22)) break; } }
        asm volatile("" ::: "memory");
        const float o1 = XCH[((par * 2 + (vt ^ 1)) * 32 + t) * 2], o2 = XCH[((par * 2 + (vt ^ 1)) * 32 + t) * 2 + 1];
        const float mean = (s1 + o1) * (1.0f / 64.0f), var = fmaxf((s2 + o2) * (1.0f / 64.0f) - mean * mean, 0.f);
        const float rstd = 1.0f / sqrtf(var + GN_EPS);
        const float rk = gcrk[64 + t];
        if (q < ntok) {
#pragma unroll
            for (int e = 0; e < 2; ++e) { const v4u vv = Vp[e];
                const float vf[8] = {bflo(vv.x), bfhi(vv.x), bflo(vv.y), bfhi(vv.y), bflo(vv.z), bfhi(vv.z), bflo(vv.w), bfhi(vv.w)};
#pragma unroll
                for (int e2 = 0; e2 < 2; ++e2) { const int u = 2 * e + e2, chb = 32 * vt + 8 * u + 4 * hh;
                    const f32x4 lg = *(LAS const f32x4*)(L + s3::PAR + 5 * 256 + chb * 4), lb = *(LAS const f32x4*)(L + s3::PAR + 6 * 256 + chb * 4);
                    const float gt[4] = {bflo(gv[u].x), bfhi(gv[u].x), bflo(gv[u].y), bfhi(gv[u].y)};
                    float o[4];
#pragma unroll
                    for (int j = 0; j < 4; ++j) o[j] = ((y[4 * u + j] - mean) * rstd * lg[j] + lb[j] + rk * vf[4 * e2 + j]) * gt[j];
                    v2u w; w.x = cvtpk(o[0], o[1]); w.y = cvtpk(o[2], o[3]); *(v2u*)(op + 8 * u) = w; } }
        }
    }
#pragma unroll
    for (int mt = 0; mt < 2; ++mt) { f32x16 acc = unpack16(Ha[mt], Hb[mt]);
#pragma unroll
        for (int g = 0; g < 4; ++g) { const f32x4 gc = *(LAS const f32x4*)(gcrk + 32 * mt + 8 * g + 4 * hi);
            acc[4 * g + 0] += gc.x * ST[mt][4 * g + 0]; acc[4 * g + 1] += gc.y * ST[mt][4 * g + 1]; acc[4 * g + 2] += gc.z * ST[mt][4 * g + 2]; acc[4 * g + 3] += gc.w * ST[mt][4 * g + 3]; }
#pragma unroll
        for (int kp = 0; kp < 2; ++kp) { acc = MFMA32(Gp[mt][kp][0], Sb[kp][0], acc); acc = MFMA32(Gp[mt][kp][1], Sb[kp][1], acc); }
        ST[mt] = acc; }
}

__device__ __forceinline__ void scan_wg(const Frame& F, const Args& AR, int w, bf16* OB_, unsigned& s2cnt) {
    LAS unsigned char* L = F.lds;
    int lane = lane_id(); asm volatile("" : "+v"(lane));
    const int wave = F.wave, tid = wave * 64 + lane;
    const bool sample = w >= 128;
    const int h = sample ? ((w - 128) * 32) >> 7 : (w & 15);
    const int nch = sample ? 1 : SEQ / 32, nitems = sample ? 32 : nch, ntok = sample ? DECS : 32;
    const bf16* PS = (const bf16*)(F.ws + WS_PS); const bf16* GB = (const bf16*)(F.ws + WS_GA);
    unsigned char* ring = F.ws + (sample ? WS_K + (size_t)(w - 128) * s3::RING_BYTES_WG : WS_RING + (size_t)w * s3::RING_BYTES_WG);
    __syncthreads();
    if (tid < 2) ((LAS unsigned*)(L + s3::XCH + 1024))[tid] = 0u;
    {
        const int j = tid >> 3, cb = (tid & 7) * 8;
        const float* p = AR.in[I_W2] + (size_t)j * DM + h * HD + cb; const f32x4 a0 = *(const f32x4*)p, a1 = *(const f32x4*)(p + 4);
        const float* p2 = AR.in[I_A2] + (size_t)j * DM + h * HD + cb; const f32x4 b0 = *(const f32x4*)p2, b1 = *(const f32x4*)(p2 + 4);
        const float wv[8] = {a0.x, a0.y, a0.z, a0.w, a1.x, a1.y, a1.z, a1.w}, av[8] = {b0.x, b0.y, b0.z, b0.w, b1.x, b1.y, b1.z, b1.w};
#pragma unroll
        for (int i = 0; i < 8; ++i) { *(LAS bf16*)(L + s3::W2T + (cb + i) * s3::P68 + 2 * j) = (bf16)cvtpk(wv[i], 0.f); *(LAS bf16*)(L + s3::A2T + (cb + i) * s3::P68 + 2 * j) = (bf16)cvtpk(av[i], 0.f); }
        for (int idx = tid; idx < 12 * 64; idx += NTHR) { const int arr = idx >> 6, c = idx & 63; const float* src;
            switch (arr) { case 0: src = AR.in[I_W0] + h * HD; break; case 1: src = AR.in[I_A0] + h * HD; break; case 2: src = AR.in[I_KK] + h * HD; break; case 3: src = AR.in[I_KA] + h * HD; break;
                case 4: src = AR.in[I_RK] + h * HD; break; case 5: src = AR.in[I_LNG] + h * HD; break; case 6: src = AR.in[I_LNB] + h * HD; break;
                case 7: src = AR.in[I_MU] + h * HD; break; case 8: src = AR.in[I_MU] + 1024 + h * HD; break; case 9: src = AR.in[I_MU] + 2048 + h * HD; break; case 10: src = AR.in[I_MU] + 3072; break; default: src = AR.in[I_MU] + 3136; break; }
            ((LAS float*)(L + s3::PAR))[idx] = src[c]; }
    }
    __syncthreads();
    const int nb = (nitems + 5) / 6;
    for (int j = 0; j <= nb; ++j) {
        int ln = lane; asm volatile("" : "+v"(ln));
        if (wave < 6) {
            const int item = 6 * j + wave;
            if (item < nitems) {
                int b, c; if (sample) { b = ((w - 128) * 32 + item) & 127; c = 0; } else { b = w >> 4; c = item; }
                const size_t row0 = sample ? (size_t)MP + (size_t)b * DECS : (size_t)b * SEQ + (size_t)c * 32;
                s1_chunk(AR, L, L + s3::SCR + wave * s3::SCRW, ring + (size_t)(item % s3::RING) * s3::R_SIZE, (LAS float*)(L + s3::GCRK) + (item % s3::RING) * 96, PS, row0, c == 0 ? (sample ? (const bf16*)(F.ws + WS_SROW) + (size_t)b * SHW : (const bf16*)(F.ws + WS_ZROW)) : nullptr, h, ntok, ln);
            }
        } else if (j >= 1) {
            const int vt = wave - 6;
            LAS f32x4* STS = (LAS f32x4*)(L + SMALL_OFF) + vt * 512 + ln;
            f32x16 ST[2];
#pragma unroll
            for (int a = 0; a < 2; ++a)
#pragma unroll
                for (int g = 0; g < 4; ++g) { const f32x4 x = STS[(a * 4 + g) * 64]; ST[a][4 * g + 0] = x.x; ST[a][4 * g + 1] = x.y; ST[a][4 * g + 2] = x.z; ST[a][4 * g + 3] = x.w; }
            const int i0 = 6 * (j - 1);
            for (int i = 0; i < 6; ++i) { const int item = i0 + i; if (item >= nitems) break;
                int b, c; if (sample) { b = ((w - 128) * 32 + item) & 127; c = 0; } else { b = w >> 4; c = item; }
                const size_t row0 = sample ? (size_t)MP + (size_t)b * DECS : (size_t)b * SEQ + (size_t)c * 32;
                const int q = ln & 31, hi = ln >> 5;
                if (c == 0) {
#pragma unroll
                    for (int kt = 0; kt < 2; ++kt) { ST[kt] = ZERO16;
                        if (sample) { const float* sp = AR.in[I_SWKV] + ((size_t)(b * NH + h) * HD + 32 * vt + q) * HD + 32 * kt + 4 * hi;
#pragma unroll
                            for (int g = 0; g < 4; ++g) { const f32x4 x = *(const f32x4*)(sp + 8 * g); ST[kt][4 * g + 0] = x.x; ST[kt][4 * g + 1] = x.y; ST[kt][4 * g + 2] = x.z; ST[kt][4 * g + 3] = x.w; } } }
                }
                S2Pre cur; s2_prefetch(cur, ring + (size_t)(item % s3::RING) * s3::R_SIZE, vt, ln);
                s2_chunk(L, ring + (size_t)(item % s3::RING) * s3::R_SIZE, cur, (LAS const float*)(L + s3::GCRK) + (item % s3::RING) * 96, ST, GB, OB_, row0, h, ntok, vt, (unsigned)item, ln);
                if (c == nch - 1) {
                    float* dp = F.out + (sample ? O_SWKV : O_PWKV) + (size_t)(b * NH + h) * HD * HD;
#pragma unroll
                    for (int kt = 0; kt < 2; ++kt)
#pragma unroll
                        for (int g = 0; g < 4; ++g) *(f32x4*)(dp + (size_t)(32 * vt + q) * HD + 32 * kt + 8 * g + 4 * hi) = (f32x4){ST[kt][4 * g + 0], ST[kt][4 * g + 1], ST[kt][4 * g + 2], ST[kt][4 * g + 3]};
                }
            }
#pragma unroll
            for (int a = 0; a < 2; ++a)
#pragma unroll
                for (int g = 0; g < 4; ++g) STS[(a * 4 + g) * 64] = (f32x4){ST[a][4 * g + 0], ST[a][4 * g + 1], ST[a][4 * g + 2], ST[a][4 * g + 3]};
        }
        asm volatile("s_waitcnt vmcnt(0)" ::: "memory");
        __syncthreads();
    }
}
__device__ __forceinline__ void final_norm(const Frame& F, const Args& AR, float* dst) {
    const int gw = F.vcu * NWAVES + F.wave, NGW = F.G * NWAVES;
    const float* ss = (const float*)(F.ws + WS_SS); const int lane = lane_id(); const GAS f32x4* gr = (const GAS f32x4*)AR.in[I_FING] + lane;
    for (int m = gw; m < MT; m += NGW) {
        const float sc = 1.0f / sqrtf(ss[m] * (1.f / DM) + NORM_EPS);
        GAS f32x4* xr = (GAS f32x4*)(F.out + (size_t)m * DM) + lane;
        GAS f32x4* yr = (GAS f32x4*)(dst + (size_t)m * DM) + lane;
#pragma unroll
        for (int j = 0; j < 4; ++j) { const f32x4 v = xr[64 * j], g = gr[64 * j]; yr[64 * j] = v * sc * g; }
    }
}

#ifndef MK_PER_PHASE
#define MK_PER_PHASE 0
#endif
constexpr int N_PHASES = 9;
__global__ void __launch_bounds__(NTHR, 2) hybrid_fwd(Args args) {
    extern __shared__ __attribute__((aligned(16))) unsigned char lds[];
    Frame F;
    F.lds = (LAS unsigned char*)lds;
    F.wave = __builtin_amdgcn_readfirstlane(threadIdx.x >> 6);
    F.G = gridDim.x; { const int bx = blockIdx.x; F.vcu = (F.G % 8 == 0) ? (bx % 8) * (F.G / 8) + bx / 8 : bx; }
    F.out = args.out; F.ws = args.ws;
    volatile LAS unsigned* MISC = (volatile LAS unsigned*)(F.lds + MISC_OFF);
    for (int u = threadIdx.x; u < (LDS_BYTES - LDSCTL_OFF) / 4; u += NTHR) ((LAS unsigned*)(F.lds + LDSCTL_OFF))[u] = 0u;
    __syncthreads();
    XcdBarrier bar; bar.bar = (unsigned*)(F.ws + WS_CTL) + CW_BAR; bar.x = 0; bar.st = nullptr;
    if (!MK_PER_PHASE) bar = xcd_barrier_post((unsigned*)(F.ws + WS_CTL) + CW_BAR, MISC + 8);
    const int lo = args.ph_lo, hi = args.ph_hi;
#ifndef DUP
#define DUP 0
#endif
#define REP(k) for (int rep_ = ((DUP >> (k)) & 1) ? 0 : 1; rep_ < 2; ++rep_)
#ifndef PHMASK
#define PHMASK 0x1ff
#endif
#define IN(k) ((((PHMASK) >> (k)) & 1) && lo <= (k) && (k) < hi)
#define SEAM(k) do { if (IN(k) && IN((k) + 1)) xcd_barrier(bar); } while (0)

    if (IN(0)) { REP(0) p0_prologue(F, args); }
    SEAM(0);
    if (IN(1)) {
        pg8::Gemm g{(const bf16*)(F.ws + WS_XN), (const bf16*)(F.ws + WS_W1T), MT, N1A, DM}; pg8::StaticOrder S; S.init(MT, N1A, F.G, (int)blockIdx.x);
        EpiG1 E{0, F.ws, F.out, 0};
        REP(1) pg8::gemm_phase<EpiG1, pg8::StaticOrder, true, true>(F.lds, g, S, E);
    }
    SEAM(1);
    if (IN(2)) { REP(2) { bf16* ob = (bf16*)(F.ws + (rep_ ? WS_Q : WS_PS)); for (int u = F.vcu; u < 1024 + 512; u += F.G) attn_unit(F, args, u, ob); } }
    SEAM(2);
    if (IN(3)) {
        pg8::Gemm g{(const bf16*)(F.ws + WS_XN), (const bf16*)(F.ws + WS_W1T) + (size_t)N1A * DM, MT, 17 * 256, DM}; pg8::StaticOrder S; S.init(MT, 17 * 256, F.G, (int)blockIdx.x);
        EpiG1 E{1, F.ws, F.out, 0};
        REP(3) pg8::gemm_phase<EpiG1, pg8::StaticOrder, true, true>(F.lds, g, S, E);
    }
    SEAM(3);
    if (IN(4)) { unsigned s2cnt = 0; const int bx = (int)blockIdx.x;
        REP(4) { bf16* ob = (bf16*)(F.ws + (rep_ ? WS_GA : WS_PS + (size_t)MT * SHW * 2 - (size_t)MT * DM * 2)); for (int w = bx; w < 192; w += F.G) scan_wg(F, args, w, ob, s2cnt); }
        if (F.G >= 256 ? bx >= 128 : true) {
            const int gg = F.G >= 256 ? F.G - 128 : F.G, cc = F.G >= 256 ? bx - 128 : bx;
            pg8::StaticOrder S; S.init(MT, DM, gg, cc);
            { pg8::Gemm g{(const bf16*)(F.ws + WS_XN), (const bf16*)(F.ws + WS_W1T) + (size_t)6912 * DM, MT, DM, DM}; EpiG1 E{1, F.ws, F.out, 17};
              pg8::gemm_phase<EpiG1, pg8::StaticOrder, true, true>(F.lds, g, S, E); }
            { pg8::Gemm g{(const bf16*)(F.ws + WS_Q), (const bf16*)(F.ws + WS_WAT), MT, DM, DM}; EpiGate E{0, (const bf16*)F.out, nullptr, (bf16*)F.out};
              REP(5) pg8::gemm_phase<EpiGate, pg8::StaticOrder, true, true>(F.lds, g, S, E); }
            { pg8::Gemm g{(const bf16*)(F.ws + WS_XN), (const bf16*)(F.ws + WS_W1T) + (size_t)7936 * DM, MT, DM, DM}; EpiG1 E{1, F.ws, F.out, 21};
              pg8::gemm_phase<EpiG1, pg8::StaticOrder, true, true>(F.lds, g, S, E); }
        } }
    SEAM(4);
    if (IN(6)) {
        pg8::Gemm g{(const bf16*)(F.ws + WS_GA), (const bf16*)(F.ws + WS_WBT), MT, DM, DM}; pg8::StaticOrder S; S.init(MT, DM, F.G, (int)blockIdx.x);
        EpiGate E{1, (const bf16*)F.out + (size_t)MT * DM, (const bf16*)F.out, (bf16*)(F.ws + WS_XN)};
        REP(6) pg8::gemm_phase<EpiGate, pg8::StaticOrder, true, true>(F.lds, g, S, E);
    }
    SEAM(6);
    if (IN(7)) {
        pg8::Gemm g{(const bf16*)(F.ws + WS_XN), (const bf16*)(F.ws + WS_WOT), MT, DM, DM}; pg8::StaticOrder S; S.init(MT, DM, F.G, (int)blockIdx.x);
        REP(7) { EpiOut E{args.in[I_XP], args.in[I_XS], F.out, (float*)(F.ws + WS_SS + (rep_ ? 0 : 192 * 1024))};
        pg8::gemm_phase<EpiOut, pg8::StaticOrder, true, true>(F.lds, g, S, E); }
    }
    SEAM(7);
    if (IN(8)) { REP(8) final_norm(F, args, rep_ ? F.out : (float*)(F.ws + WS_PS)); }
#undef IN
#undef SEAM
}

extern "C" void kernel_launch(void* const* d_in, const int* in_sizes, int n_in, void* d_out, int out_size, void* d_ws, size_t ws_size, hipStream_t stream) {
    static int grid = 0;
    if (grid == 0) {
        if (n_in != 24 || (size_t)out_size != O_END || ws_size < WS_END) { fprintf(stderr, "kernel_launch: unexpected sizes: n_in %d out %d ws %zu (need %zu)\n", n_in, out_size, ws_size, (size_t)WS_END); grid = -1; return; }
        int dev = 0, cus = 0;
        if (hipGetDevice(&dev) != hipSuccess || hipDeviceGetAttribute(&cus, hipDeviceAttributeMultiprocessorCount, dev) != hipSuccess) { grid = -1; return; }
        if (hipFuncSetAttribute((const void*)hybrid_fwd, hipFuncAttributeMaxDynamicSharedMemorySize, LDS_BYTES) != hipSuccess) { fprintf(stderr, "kernel_launch: hipFuncSetAttribute failed\n"); grid = -1; return; }
        int per_cu = 0;
        if (hipOccupancyMaxActiveBlocksPerMultiprocessor(&per_cu, (const void*)hybrid_fwd, NTHR, LDS_BYTES) != hipSuccess || per_cu < 1) fprintf(stderr, "kernel_launch: occupancy query says %d\n", per_cu);
        (void)hipGetLastError();
        grid = cus;
    }
    if (grid < 0) return;
    (void)hipMemsetAsync((char*)d_ws + WS_CTL, 0, CTL_ZERO_BYTES, stream);
    Args a{};
    for (int i = 0; i < 24; ++i) a.in[i] = (const float*)d_in[i];
    a.out = (float*)d_out; a.ws = (unsigned char*)d_ws;
#if MK_PER_PHASE
    for (int p = 0; p < N_PHASES; ++p) { a.ph_lo = p; a.ph_hi = p + 1; hipLaunchKernelGGL(hybrid_fwd, dim3(grid), dim3(NTHR), LDS_BYTES, stream, a); }
#else
    a.ph_lo = 0; a.ph_hi = N_PHASES; hipLaunchKernelGGL(hybrid_fwd, dim3(grid), dim3(NTHR), LDS_BYTES, stream, a);
#endif
}
```

```cpp
#include <hip/hip_runtime.h>
#include <cstdio>
#include <cstdint>
#include <cmath>
namespace pg8 {
#define PG8_LAS __attribute__((address_space(3)))
typedef unsigned short bf16_t;
typedef short bf16x8 __attribute__((ext_vector_type(8)));
typedef float f32x4 __attribute__((ext_vector_type(4)));
typedef unsigned u32x4 __attribute__((ext_vector_type(4)));
constexpr int BM = 256, BK = 64, HALF = 128, HTB = HALF * BK * 2  , STAGE_BYTES = 8 * HTB, NXCD = 8, WGM = 8;

__host__ __device__ __forceinline__ int lds_byte(int r, int c) { const int st = (r >> 4) * 2 + (c >> 5), rr = r & 15, cc = c & 31, ob = rr * 64 + cc * 2; return st * 1024 + (ob ^ (((ob >> 9) & 1) << 5)); }
__host__ __device__ __forceinline__ void stage_rc(int b, int& R, int& C) { const int st = b / 1024, sb = b % 1024, swz = sb ^ (((sb >> 9) & 1) << 5); R = (st >> 1) * 16 + swz / 64; C = (st & 1) * 32 + (swz % 64) / 2; }
__host__ __device__ __forceinline__ int perm32(int rho) { const int n = rho >> 4, i = rho & 15; return 8 * (i >> 2) + 4 * n + (i & 3); }

struct Unit { int pm, pn; };
struct Gemm { const bf16_t* A; const bf16_t* Bt; int M, N, K; };

struct StaticOrder {
    int nM, nN, nwg, G, c;
    __host__ __device__ void init(int M, int N, int G_, int c_) { nM = M / BM; nN = N / BM; nwg = nM * nN; G = G_; c = c_; }
    __host__ __device__ bool next(int i, Unit& u) const {
        const long L = (long)i * G + c; if (L >= nwg) return false;
        int wgid = (int)L; { const int q = nwg / NXCD, r = nwg % NXCD, xcd = wgid % NXCD, off = wgid / NXCD; wgid = (xcd < r ? xcd * (q + 1) : r * (q + 1) + (xcd - r) * q) + off; }
        const int nig = WGM * nN, gid = wgid / nig, fm = gid * WGM, gsz = (nM - fm) < WGM ? (nM - fm) : WGM;
        u.pm = fm + ((wgid % nig) % gsz); u.pn = (wgid % nig) / gsz; return true;
    }
    __device__ __forceinline__ void a_ready(const Unit&) const {}
    __device__ __forceinline__ void done(const Unit&) const {}
};

__device__ __forceinline__ unsigned cvt_pk_bf16(float lo, float hi) { unsigned r; asm volatile("v_cvt_pk_bf16_f32 %0, %1, %2" : "=v"(r) : "v"(lo), "v"(hi)); return r; }
typedef float f32x2 __attribute__((ext_vector_type(2)));
template <class Epi, class Sched, bool ALIGN_EPI = false, bool SP2 = false>
__device__ __forceinline__ void gemm_phase(PG8_LAS unsigned char* lds, const Gemm g, const Sched& S, const Epi& E, int wave_) {
    const int wid = wave_, lane = (int)__builtin_amdgcn_mbcnt_hi(~0u, __builtin_amdgcn_mbcnt_lo(~0u, 0u)), tid = wid * 64 + lane,     wr = wid >> 2, wc = wid & 3, fr = lane & 15, fq = lane >> 4;
    const int K = g.K, nt = K / BK;
    unsigned voffA[2], voffB[2];
#pragma unroll
    for (int i = 0; i < 2; ++i) { int R, C; stage_rc(tid * 16 + i * 8192, R, C); const int Rb = Epi::PERM ? ((R & ~31) + perm32(R & 31)) : R;
        voffA[i] = (unsigned)(R * K + C) * 2u; voffB[i] = (unsigned)(Rb * K + C) * 2u; }
    const size_t kstep = (size_t)(BK * 2);
    const size_t hstep = (size_t)HALF * K * 2;
    const size_t tstep = 2 * hstep;
    const unsigned ldsw = (unsigned)wid * 1024u;
    const int aoff = lds_byte(wr * 64 + fr, fq * 8), boff = lds_byte(wc * 32 + fr, fq * 8);
#define PG8_SA(b, h) (((b) * 2 + (h)) * HTB)
#define PG8_SB(b, h) ((4 + (b) * 2 + (h)) * HTB)
#define PG8_STAGE(bufoff, gbase, voff) do { _Pragma("unroll") for (int _i = 0; _i < 2; ++_i) \
        __builtin_amdgcn_global_load_lds((const unsigned*)((const char*)(gbase) + (voff)[_i]), (PG8_LAS unsigned*)(lds + (bufoff) + ldsw + _i * 8192), 16, 0, 0); } while (0)
#define PG8_LDA(dst, b, h) do { _Pragma("unroll") for (int m = 0; m < 4; ++m) _Pragma("unroll") for (int k = 0; k < 2; ++k) dst[m][k] = *(const PG8_LAS bf16x8*)(lds + PG8_SA(b, h) + aoff + m * 2048 + k * 1024); } while (0)
#define PG8_LDB(dst, b, h) do { _Pragma("unroll") for (int n = 0; n < 2; ++n) _Pragma("unroll") for (int k = 0; k < 2; ++k) dst[n][k] = *(const PG8_LAS bf16x8*)(lds + PG8_SB(b, h) + boff + n * 2048 + k * 1024); } while (0)
#define PG8_MMA(ai, bj, At, Bt) do { __builtin_amdgcn_s_setprio(1); _Pragma("unroll") for (int m = 0; m < 4; ++m) _Pragma("unroll") for (int n = 0; n < 2; ++n) _Pragma("unroll") for (int k = 0; k < 2; ++k) \
        acc[ai][bj][m][n] = __builtin_amdgcn_mfma_f32_16x16x32_bf16(Bt[n][k], At[m][k], acc[ai][bj][m][n], 0, 0, 0); __builtin_amdgcn_s_setprio(0); } while (0)
#define PG8_WAIT_V(n) asm volatile("s_waitcnt vmcnt(" #n ")" ::: "memory")
#define PG8_WAIT_L(n) asm volatile("s_waitcnt lgkmcnt(" #n ")" ::: "memory")
#define PG8_BAR __builtin_amdgcn_s_barrier()
#define PG8_SCHED __builtin_amdgcn_sched_barrier(0)
    Unit cur, nxt; int ui = 0;
    if (!S.next(0, cur)) return;
    f32x4 acc[2][2][4][2];
#pragma unroll
    for (int a = 0; a < 2; ++a)
#pragma unroll
        for (int b = 0; b < 2; ++b)
#pragma unroll
            for (int m = 0; m < 4; ++m)
#pragma unroll
                for (int n = 0; n < 2; ++n) acc[a][b][m][n] = (f32x4){0.f, 0.f, 0.f, 0.f};
    bf16x8 At[4][2], B0[2][2], B1[2][2];
    const char* cA = (const char*)g.A + (size_t)cur.pm * tstep; const char* cB = (const char*)g.Bt + (size_t)cur.pn * tstep;
    S.a_ready(cur);
    if constexpr (SP2) {
        PG8_STAGE(PG8_SB(0, 0), cB, voffB); PG8_STAGE(PG8_SB(0, 1), cB + hstep, voffB); PG8_STAGE(PG8_SA(0, 0), cA, voffA); PG8_STAGE(PG8_SA(0, 1), cA + hstep, voffA);
        if (wr == 1) PG8_BAR;
        PG8_WAIT_V(2); PG8_BAR;
        PG8_STAGE(PG8_SB(1, 0), cB + kstep, voffB); PG8_STAGE(PG8_SA(1, 0), cA + kstep, voffA); PG8_STAGE(PG8_SB(1, 1), cB + hstep + kstep, voffB);
        PG8_WAIT_V(6); PG8_BAR;
    } else {
        PG8_STAGE(PG8_SB(0, 0), cB, voffB); PG8_STAGE(PG8_SA(0, 0), cA, voffA); PG8_STAGE(PG8_SB(0, 1), cB + hstep, voffB); PG8_STAGE(PG8_SA(0, 1), cA + hstep, voffA);
        if (wr == 1) PG8_BAR;
        PG8_WAIT_V(4); PG8_BAR;
        PG8_STAGE(PG8_SB(1, 0), cB + kstep, voffB); PG8_STAGE(PG8_SA(1, 0), cA + kstep, voffA); PG8_STAGE(PG8_SB(1, 1), cB + hstep + kstep, voffB);
        PG8_WAIT_V(6); PG8_BAR;
    }
    for (;;) {
        const bool has_next = S.next(ui + 1, nxt);
        const char* nA = has_next ? (const char*)g.A + (size_t)nxt.pm * tstep : cA; const char* nB = has_next ? (const char*)g.Bt + (size_t)nxt.pn * tstep : cB;
        for (int t = 0; t < nt; t += 2) {
            const bool last = (t == nt - 2);
            const char* a1 = cA + (size_t)(t + 1) * kstep;
            const char* a2 = last ? nA : cA + (size_t)(t + 2) * kstep; const char* b2 = last ? nB : cB + (size_t)(t + 2) * kstep;
            const char* a3 = a2 + kstep; const char* b3 = b2 + kstep;
            if (last && has_next) S.a_ready(nxt);
            if constexpr (SP2) {
            PG8_LDB(B0, 0, 0); PG8_LDB(B1, 0, 1); PG8_SCHED; PG8_LDA(At, 0, 0); PG8_STAGE(PG8_SA(1, 1), a1 + hstep, voffA);
            PG8_WAIT_V(8); PG8_WAIT_L(0); PG8_BAR; PG8_MMA(0, 0, At, B0); PG8_MMA(0, 1, At, B1); PG8_BAR; PG8_SCHED;
            PG8_LDA(At, 0, 1); PG8_STAGE(PG8_SB(0, 0), b2, voffB); PG8_STAGE(PG8_SB(0, 1), b2 + hstep, voffB); PG8_STAGE(PG8_SA(0, 0), a2, voffA);
            PG8_WAIT_V(8); PG8_WAIT_L(0); PG8_BAR; PG8_MMA(1, 0, At, B0); PG8_MMA(1, 1, At, B1); PG8_BAR; PG8_SCHED;
            PG8_LDB(B0, 1, 0); PG8_LDB(B1, 1, 1); PG8_SCHED; PG8_LDA(At, 1, 0); PG8_STAGE(PG8_SA(0, 1), a2 + hstep, voffA);
            PG8_WAIT_V(8); PG8_WAIT_L(0); PG8_BAR; PG8_MMA(0, 0, At, B0); PG8_MMA(0, 1, At, B1); PG8_BAR; PG8_SCHED;
            PG8_LDA(At, 1, 1); PG8_STAGE(PG8_SB(1, 0), b3, voffB); PG8_STAGE(PG8_SB(1, 1), b3 + hstep, voffB); PG8_STAGE(PG8_SA(1, 0), a3, voffA);
            PG8_WAIT_V(8); PG8_WAIT_L(0); PG8_BAR; PG8_MMA(1, 0, At, B0); PG8_MMA(1, 1, At, B1); PG8_BAR; PG8_SCHED;
            } else {
            PG8_LDB(B0, 0, 0); PG8_SCHED; PG8_LDA(At, 0, 0); PG8_STAGE(PG8_SA(1, 1), a1 + hstep, voffA);
            PG8_WAIT_L(8); PG8_BAR; PG8_WAIT_L(0); PG8_MMA(0, 0, At, B0); PG8_BAR; PG8_SCHED;
            PG8_LDB(B1, 0, 1); PG8_STAGE(PG8_SB(0, 0), b2, voffB);
            PG8_BAR; PG8_WAIT_L(0); PG8_MMA(0, 1, At, B1); PG8_BAR;
            PG8_LDA(At, 0, 1); PG8_STAGE(PG8_SA(0, 0), a2, voffA);
            PG8_BAR; PG8_WAIT_L(0); PG8_MMA(1, 0, At, B0); PG8_BAR; PG8_SCHED;
            PG8_STAGE(PG8_SB(0, 1), b2 + hstep, voffB);
            PG8_WAIT_V(6); PG8_BAR; PG8_MMA(1, 1, At, B1); PG8_BAR;
            PG8_LDB(B0, 1, 0); PG8_SCHED; PG8_LDA(At, 1, 0); PG8_STAGE(PG8_SA(0, 1), a2 + hstep, voffA);
            PG8_WAIT_L(8); PG8_BAR; PG8_WAIT_L(0); PG8_MMA(0, 0, At, B0); PG8_BAR; PG8_SCHED;
            PG8_LDB(B1, 1, 1); PG8_STAGE(PG8_SB(1, 0), b3, voffB);
            PG8_BAR; PG8_WAIT_L(0); PG8_MMA(0, 1, At, B1); PG8_BAR;
            PG8_LDA(At, 1, 1); PG8_STAGE(PG8_SA(1, 0), a3, voffA);
            PG8_BAR; PG8_WAIT_L(0); PG8_MMA(1, 0, At, B0); PG8_BAR; PG8_SCHED;
            PG8_STAGE(PG8_SB(1, 1), b3 + hstep, voffB);
            PG8_WAIT_V(6); PG8_BAR; PG8_MMA(1, 1, At, B1); PG8_BAR;
            }
        }
        if constexpr (ALIGN_EPI) { if (wr == 0) PG8_BAR; }
        if constexpr (!Epi::AFTER_DRAIN) { E(acc, cur, wr, wc, fr, fq); S.done(cur); }
        if (!has_next) break;
#pragma unroll
        for (int a = 0; a < 2; ++a)
#pragma unroll
            for (int b = 0; b < 2; ++b)
#pragma unroll
                for (int m = 0; m < 4; ++m)
#pragma unroll
                    for (int n = 0; n < 2; ++n) acc[a][b][m][n] = (f32x4){0.f, 0.f, 0.f, 0.f};
        cur = nxt; cA = nA; cB = nB; ++ui;
        if constexpr (ALIGN_EPI) { if (wr == 1) PG8_BAR; }
    }
    PG8_WAIT_V(0);
    if constexpr (!ALIGN_EPI) { if (wr == 0) PG8_BAR; }
    PG8_BAR;
    if constexpr (Epi::AFTER_DRAIN) { E.fused(acc, cur, wr, wc, fr, fq, lds, wid, lane); S.done(cur); }
#undef PG8_SA
#undef PG8_SB
#undef PG8_STAGE
#undef PG8_LDA
#undef PG8_LDB
#undef PG8_MMA
#undef PG8_WAIT_V
#undef PG8_WAIT_L
#undef PG8_BAR
#undef PG8_SCHED
}
}

constexpr int DM = 1024, NBATCH = 8, SEQ = 4096, DECB = 128, DECS = 8;
constexpr int MP = NBATCH * SEQ, MS = DECB * DECS, MT = MP + MS;
constexpr int HD = 64, NH = 16, NKV = 4, WIN = 128, KVW = 256;
constexpr int SHW = 3200, INC = 8832;
constexpr int N1A = 2560, N1B = 6400, N1 = N1A + N1B;
constexpr float NORM_EPS = 1e-6f, GN_EPS = 64e-5f;

constexpr size_t O_Y = 0;
constexpr size_t O_PKW = (size_t)MT * DM;
constexpr size_t O_PVW = O_PKW + (size_t)NBATCH * WIN * KVW;
constexpr size_t O_PWKV = O_PVW + (size_t)NBATCH * WIN * KVW;
constexpr size_t O_PSH = O_PWKV + (size_t)NBATCH * NH * HD * HD;
constexpr size_t O_SKW = O_PSH + (size_t)NBATCH * SHW;
constexpr size_t O_SVW = O_SKW + (size_t)DECB * WIN * KVW;
constexpr size_t O_SWKV = O_SVW + (size_t)DECB * WIN * KVW;
constexpr size_t O_SSH = O_SWKV + (size_t)DECB * NH * HD * HD;
constexpr size_t O_END = O_SSH + (size_t)DECB * SHW;
static_assert(O_END == 52864000, "output size");

constexpr size_t MiB = 1u << 20;
constexpr size_t WS_CTL = 0, CTL_ZERO_BYTES = 1 * MiB;
constexpr size_t WS_SS = 512 * 1024;
constexpr size_t WS_ZROW = 900 * 1024;
constexpr size_t WS_SROW = 1 * MiB;
constexpr size_t WS_W1T = 2 * MiB;
constexpr size_t WS_WAT = 20 * MiB, WS_WBT = 22 * MiB, WS_WOT = 24 * MiB;
constexpr size_t WS_XN = 26 * MiB;
constexpr size_t WS_Q = 92 * MiB;
constexpr size_t WS_K = 158 * MiB;
constexpr size_t WS_V = WS_K + (size_t)MT * KVW * 2;
constexpr size_t WS_GA = 191 * MiB;
constexpr size_t WS_PS = 257 * MiB;
constexpr size_t WS_RING = 464 * MiB;
constexpr size_t WS_END = 512 * MiB;
static_assert(WS_W1T + (size_t)N1 * DM * 2 <= WS_WAT && WS_V + (size_t)MT * KVW * 2 <= WS_GA && WS_PS + (size_t)MT * SHW * 2 <= WS_END, "ws map");

constexpr int CW_BAR = 4096;

constexpr int RING_BYTES = 131072;
constexpr int LDSCTL_OFF = RING_BYTES, MISC_OFF = LDSCTL_OFF + 320, SMALL_OFF = LDSCTL_OFF + 1024;
constexpr int LDS_BYTES = 163840;
constexpr int NWAVES = 8, NTHR = 512;

#define GAS __attribute__((address_space(1)))
#define LAS __attribute__((address_space(3)))
typedef unsigned short bf16;
typedef unsigned v4u __attribute__((ext_vector_type(4)));
typedef unsigned v2u __attribute__((ext_vector_type(2)));
typedef float f32x4 __attribute__((ext_vector_type(4)));
typedef float f32x16 __attribute__((ext_vector_type(16)));
typedef short bf16x8 __attribute__((ext_vector_type(8)));
typedef GAS unsigned gu32;
#define RLX_AGENT __ATOMIC_RELAXED, __HIP_MEMORY_SCOPE_AGENT
#define LDS_WAIT() asm volatile("s_waitcnt lgkmcnt(0)" ::: "memory")
#define VM_WAIT() asm volatile("s_waitcnt vmcnt(0)" ::: "memory")
__device__ __forceinline__ unsigned f2bf(float f) { unsigned u = __builtin_bit_cast(unsigned, f); return (u + 0x7fffu + ((u >> 16) & 1u)) >> 16; }
__device__ __forceinline__ unsigned pk2(float lo, float hi) { return f2bf(lo) | (f2bf(hi) << 16); }
__device__ __forceinline__ float bflo(unsigned u) { return __builtin_bit_cast(float, u << 16); }
__device__ __forceinline__ float bfhi(unsigned u) { return __builtin_bit_cast(float, u & 0xffff0000u); }
__device__ __forceinline__ float sigmoidf_(float x) { return __builtin_amdgcn_rcpf(1.0f + __expf(-x)); }

#define XB_TMO      128
#define XB_XCNT(j)  (256  + 64 * (j))
#define XB_XSUB(j)  (1280 + 64 * (j))
#define XB_XGEN(j)  (2304 + 64 * (j))
#define XB_TOP      3328
#define XB_TOPGEN   3392
#define XCD_BAR_WORDS 3456
#define XB_SPIN_CAP (1u << 23)
__device__ __forceinline__ unsigned xb_ld(unsigned* p)              { return __hip_atomic_load(p, __ATOMIC_RELAXED, __HIP_MEMORY_SCOPE_AGENT); }
__device__ __forceinline__ unsigned xb_add(unsigned* p, unsigned v) { return __hip_atomic_fetch_add(p, v, __ATOMIC_RELAXED, __HIP_MEMORY_SCOPE_AGENT); }
__device__ __forceinline__ unsigned xb_xcc_id() { return (unsigned)__builtin_amdgcn_s_getreg((3 << 11) | 20) & 0xFu; }
#define XB_SPIN(cond, bar) do { unsigned _sp = 0; while (cond) { __builtin_amdgcn_s_sleep(1); \
    if ((++_sp & 255u) == 0u) { if (xb_ld(&(bar)[XB_TMO])) break; if (_sp > XB_SPIN_CAP) { atomicAdd(&(bar)[XB_TMO], 1u); break; } } } } while (0)
struct XcdBarrier { unsigned* bar; unsigned x; volatile LAS unsigned* st; };
__device__ __forceinline__ XcdBarrier xcd_barrier_post(unsigned* bar, volatile LAS unsigned* st) {
    XcdBarrier b; b.bar = bar; b.x = xb_xcc_id(); b.st = st;
    if (threadIdx.x == 0) (void)xb_add(&bar[XB_XCNT(b.x)], 1u);
    return b;
}
__device__ __forceinline__ void xcd_barrier_complete(unsigned* bar, unsigned x, unsigned& nloc, unsigned& nx) {
    const unsigned G = gridDim.x * gridDim.y * gridDim.z;
    unsigned sum, cnt, mine, sp = 0u;
    for (;;) {
        sum = 0u; cnt = 0u; mine = 0u;
#pragma unroll
        for (unsigned j = 0; j < 16; ++j) { const unsigned c = xb_ld(&bar[XB_XCNT(j)]); sum += c; cnt += (c > 0u) ? 1u : 0u; mine = (j == x) ? c : mine; }
        if (sum == G) break;
        __builtin_amdgcn_s_sleep(1);
        if ((++sp & 255u) == 0u) { if (xb_ld(&bar[XB_TMO])) break; if (sp > XB_SPIN_CAP) { atomicAdd(&bar[XB_TMO], 1u); break; } }
    }
    nloc = mine > 0u ? mine : 1u; nx = cnt > 0u ? cnt : 1u;
}
__device__ __forceinline__ void xcd_barrier(const XcdBarrier& b, bool leader) {
    asm volatile("s_waitcnt vmcnt(0)" ::: "memory");
    __syncthreads();
    if (leader) {
        unsigned* bar = b.bar;
        __builtin_amdgcn_s_waitcnt(0);
        unsigned nloc = b.st[0], nx = b.st[1];
        if (nloc == 0u) { xcd_barrier_complete(bar, b.x, nloc, nx); b.st[0] = nloc; b.st[1] = nx; }
        const unsigned old = xb_add(&bar[XB_XSUB(b.x)], 1u);
        const unsigned gen = old / nloc;
        if (old + 1u == (gen + 1u) * nloc) {
            __builtin_amdgcn_fence(__ATOMIC_RELEASE, "agent");
            asm volatile("s_waitcnt vmcnt(0)" ::: "memory");
            const unsigned og = xb_add(&bar[XB_TOP], 1u);
            const unsigned tg = og / nx;
            if (og + 1u == (tg + 1u) * nx) xb_add(&bar[XB_TOPGEN], 1u);
            else XB_SPIN(xb_ld(&bar[XB_TOPGEN]) == tg, bar);
            __builtin_amdgcn_fence(__ATOMIC_ACQUIRE, "agent");
            xb_add(&bar[XB_XGEN(b.x)], 1u);
            asm volatile("s_waitcnt vmcnt(0)" ::: "memory");
        } else {
            XB_SPIN(xb_ld(&bar[XB_XGEN(b.x)]) == gen, bar);
            __builtin_amdgcn_fence(__ATOMIC_ACQUIRE, "agent");
            asm volatile("s_waitcnt vmcnt(0)" ::: "memory");
        }
    }
    __syncthreads();
}

struct Args { const float* in[24]; float* out; unsigned char* ws; int ph_lo, ph_hi; };
static_assert(sizeof(Args) == 24 * 8 + 8 + 8 + 8, "no padding");
struct Frame {
    LAS unsigned char* lds;
    int wave, G, vcu;
    float* out; unsigned char* ws;
};
__device__ __forceinline__ int lane_id() { return (int)__builtin_amdgcn_mbcnt_hi(~0u, __builtin_amdgcn_mbcnt_lo(~0u, 0u)); }
enum { I_XP = 0, I_XS, I_CK, I_CV, I_SWKV, I_SSHIFT, I_RELB, I_NORMG, I_WIN, I_SINK, I_MU, I_W0, I_W2, I_A0, I_A2, I_KK, I_KA, I_RK, I_LNG, I_LNB, I_WOA, I_WOB, I_WO, I_FING };

__device__ __forceinline__ float wave_sum(float v) {
#pragma unroll
    for (int o = 1; o < 64; o <<= 1) v += __shfl_xor(v, o);
    return v;
}

__device__ __forceinline__ void p0_transpose_item(const float* W, int ldw, int srccol0, int K, bf16* WT, int dstrow0, LAS float* scr, int kb, int lane) {
    const int k0 = 64 * kb;
    if (srccol0 >= 0) {
#pragma unroll 8
        for (int i = 0; i < 32; ++i) { const int kk = 2 * i + (lane >> 5); scr[kk * 33 + (lane & 31)] = W[(size_t)(k0 + kk) * ldw + srccol0 + (lane & 31)]; }
    }
    LDS_WAIT(); asm volatile("" ::: "memory");
    const int c = lane & 7;
#pragma unroll
    for (int j = 0; j < 4; ++j) { const int n = (lane >> 3) + 8 * j; const LAS float* s = scr + (8 * c) * 33 + n;
        v4u o = (v4u){0u, 0u, 0u, 0u};
        if (srccol0 >= 0) { o.x = pk2(s[0 * 33], s[1 * 33]); o.y = pk2(s[2 * 33], s[3 * 33]); o.z = pk2(s[4 * 33], s[5 * 33]); o.w = pk2(s[6 * 33], s[7 * 33]); }
        *(GAS v4u*)(WT + (size_t)(dstrow0 + n) * K + k0 + 8 * c) = o; }
    LDS_WAIT(); asm volatile("" ::: "memory");
}
__device__ __forceinline__ void rms_row_to_bf16(const float* xrow, const float* g, bf16* orow, int lane) {
    const GAS f32x4* xr = (const GAS f32x4*)xrow + lane; const GAS f32x4* gr = (const GAS f32x4*)g + lane;
    f32x4 v[4]; float s = 0.f;
#pragma unroll
    for (int j = 0; j < 4; ++j) { v[j] = xr[64 * j]; s += (v[j].x * v[j].x + v[j].y * v[j].y) + (v[j].z * v[j].z + v[j].w * v[j].w); }
    const float sc = 1.0f / sqrtf(wave_sum(s) * (1.f / DM) + NORM_EPS);
    GAS v2u* o8 = (GAS v2u*)orow + lane;
#pragma unroll
    for (int j = 0; j < 4; ++j) { const f32x4 gv = gr[64 * j]; v2u o; o.x = pk2(v[j].x * sc * gv.x, v[j].y * sc * gv.y); o.y = pk2(v[j].z * sc * gv.z, v[j].w * sc * gv.w); o8[64 * j] = o; }
}
__device__ __forceinline__ void p0_prologue(const Frame& F, const Args& AR) {
    const int lane = lane_id();
    LAS float* scr = (LAS float*)(F.lds + F.wave * 16384);
    const int gw = F.vcu * NWAVES + F.wave, NGW = F.G * NWAVES;
    constexpr int I_1 = 16 * (N1 / 32), I_S = 16 * 32, NITEMS = I_1 + 3 * I_S;
    bf16* W1T = (bf16*)(F.ws + WS_W1T);
    for (int it = gw; it < NITEMS; it += NGW) {
        int r = it;
        if (r < I_1) { const int kb = r / (N1 / 32), nb = r % (N1 / 32), n0 = 32 * nb;
            const int src = n0 < 5760 ? n0 : (n0 < 5888 ? -1 : n0 - 128);
            p0_transpose_item(AR.in[I_WIN], INC, src, DM, W1T, n0, scr, kb, lane); continue; }
        r -= I_1;
        const int which = r / I_S; r -= which * I_S;
        const float* W = which == 0 ? AR.in[I_WOA] : (which == 1 ? AR.in[I_WOB] : AR.in[I_WO]);
        bf16* WT = (bf16*)(F.ws + (which == 0 ? WS_WAT : (which == 1 ? WS_WBT : WS_WOT)));
        p0_transpose_item(W, DM, 32 * (r % 32), DM, WT, 32 * (r % 32), scr, r / 32, lane);
    }
    { bf16* SR = (bf16*)(F.ws + WS_SROW); const float* ss = AR.in[I_SSHIFT];
      for (int i = gw * 64 + lane; i < DECB * SHW / 4; i += NGW * 64) { const f32x4 v = *(const f32x4*)(ss + (size_t)i * 4); v2u w; w.x = pk2(v.x, v.y); w.y = pk2(v.z, v.w); *(v2u*)(SR + (size_t)i * 4) = w; } }
    bf16* XN = (bf16*)(F.ws + WS_XN);
    for (int m = gw; m < MT; m += NGW) {
        const float* xr = m < MP ? AR.in[I_XP] + (size_t)m * DM : AR.in[I_XS] + (size_t)(m - MP) * DM;
        rms_row_to_bf16(xr, AR.in[I_NORMG], XN + (size_t)m * DM, lane);
    }
}

struct EpiG1 {
    static constexpr bool PERM = true, AFTER_DRAIN = false;
    int part; unsigned char* ws; float* out; int pn_off;
    __device__ __forceinline__ void operator()(const f32x4 (&acc)[2][2][4][2], const pg8::Unit& u, int wr, int wc, int fr, int fq) const {
        bf16* dst; int ld, act = 0, valid = 256, side = 0;
        const int pn = u.pn + pn_off;
        if (part == 0) {
            if (pn < 4) { dst = (bf16*)(ws + WS_Q) + pn * 256; ld = DM; }
            else if (pn == 4) { dst = (bf16*)(ws + WS_K); ld = KVW; side = 1; }
            else if (pn == 5) { dst = (bf16*)(ws + WS_V); ld = KVW; side = 2; }
            else { dst = (bf16*)(ws + WS_GA) + (pn - 6) * 256; ld = DM; act = 1; }
        } else {
            if (pn < 13) { dst = (bf16*)(ws + WS_PS) + pn * 256; ld = SHW; side = 3; if (pn == 12) valid = 128; }
            else if (pn < 17) { dst = (bf16*)(ws + WS_GA) + (pn - 13) * 256; ld = DM; act = 1; }
            else if (pn < 21) { dst = (bf16*)out + (pn - 17) * 256; ld = DM; act = 2; }
            else { dst = (bf16*)out + (size_t)MT * DM + (pn - 21) * 256; ld = DM; act = 2; }
        }
        const int rt0 = wr * 64 + fr, cit0 = wc * 32 + 8 * fq;
#pragma unroll
        for (int ai = 0; ai < 2; ++ai)
#pragma unroll
            for (int m = 0; m < 4; ++m) { bf16* rowp = dst + (size_t)(u.pm * 256 + rt0 + ai * 128 + m * 16) * ld + cit0;
#pragma unroll
                for (int bj = 0; bj < 2; ++bj) { if (bj * 128 >= valid) continue;
                    f32x4 v0 = acc[ai][bj][m][0], v1 = acc[ai][bj][m][1];
                    if (act) {
#pragma unroll
                        for (int e = 0; e < 4; ++e) { const float s0 = sigmoidf_(v0[e]), s1 = sigmoidf_(v1[e]); v0[e] = act == 1 ? v0[e] * s0 : s0; v1[e] = act == 1 ? v1[e] * s1 : s1; }
                    }
                    pg8::u32x4 w; w.x = pg8::cvt_pk_bf16(v0[0], v0[1]); w.y = pg8::cvt_pk_bf16(v0[2], v0[3]); w.z = pg8::cvt_pk_bf16(v1[0], v1[1]); w.w = pg8::cvt_pk_bf16(v1[2], v1[3]);
                    *(pg8::u32x4*)(rowp + bj * 128) = w; } }
        int r0 = rt0, c0 = cit0;
        if (side) asm volatile("" : "+v"(r0), "+v"(c0));
        if (side == 1 || side == 2) {
            if (u.pm < 128) {
                if ((u.pm & 15) == 15) { float* base = out + (side == 1 ? O_PKW : O_PVW) + (size_t)(u.pm >> 4) * WIN * KVW;
#pragma unroll
                    for (int m = 0; m < 4; ++m) { float* rp = base + (size_t)(r0 + m * 16) * KVW + c0;
#pragma unroll
                        for (int bj = 0; bj < 2; ++bj)
#pragma unroll
                            for (int n = 0; n < 2; ++n) *(f32x4*)(rp + bj * 128 + 4 * n) = acc[1][bj][m][n]; } }
            } else { float* base = out + (side == 1 ? O_SKW : O_SVW);
#pragma unroll
                for (int ai = 0; ai < 2; ++ai)
#pragma unroll
                    for (int m = 0; m < 4; ++m) { const int rs = (u.pm - 128) * 256 + r0 + ai * 128 + m * 16; float* rp = base + ((size_t)(rs >> 3) * WIN + 120 + (rs & 7)) * KVW + c0;
#pragma unroll
                        for (int bj = 0; bj < 2; ++bj)
#pragma unroll
                            for (int n = 0; n < 2; ++n) *(f32x4*)(rp + bj * 128 + 4 * n) = acc[ai][bj][m][n]; }
            }
        } else if (side == 3) {
            if (u.pm < 128) {
                if ((u.pm & 15) == 15 && wr == 1 && fr == 15) { float* rp = out + O_PSH + (size_t)(u.pm >> 4) * SHW + pn * 256 + c0;
#pragma unroll
                    for (int bj = 0; bj < 2; ++bj) { if (bj * 128 >= valid) continue;
#pragma unroll
                        for (int n = 0; n < 2; ++n) *(f32x4*)(rp + bj * 128 + 4 * n) = acc[1][bj][3][n]; } }
            } else if ((fr & 7) == 7) {
#pragma unroll
                for (int ai = 0; ai < 2; ++ai)
#pragma unroll
                    for (int m = 0; m < 4; ++m) { const int rs = (u.pm - 128) * 256 + r0 + ai * 128 + m * 16; float* rp = out + O_SSH + (size_t)(rs >> 3) * SHW + pn * 256 + c0;
#pragma unroll
                        for (int bj = 0; bj < 2; ++bj) { if (bj * 128 >= valid) continue;
#pragma unroll
                            for (int n = 0; n < 2; ++n) *(f32x4*)(rp + bj * 128 + 4 * n) = acc[ai][bj][m][n]; } }
            }
        }
    }
};
struct EpiGate {
    static constexpr bool PERM = true, AFTER_DRAIN = false;
    int mode; const bf16* gate; const bf16* tin; bf16* dst;
    __device__ __forceinline__ void operator()(const f32x4 (&acc)[2][2][4][2], const pg8::Unit& u, int wr, int wc, int fr, int fq) const {
        const int rt0 = u.pm * 256 + wr * 64 + fr, c0 = u.pn * 256 + wc * 32 + 8 * fq;
#pragma unroll
        for (int ai = 0; ai < 2; ++ai)
#pragma unroll
            for (int m = 0; m < 4; ++m) { const size_t ro = (size_t)(rt0 + ai * 128 + m * 16) * DM + c0;
#pragma unroll
                for (int bj = 0; bj < 2; ++bj) {
                    const v4u g = *(const v4u*)(gate + ro + bj * 128);
                    f32x4 v0 = acc[ai][bj][m][0], v1 = acc[ai][bj][m][1];
                    v0[0] *= bflo(g.x); v0[1] *= bfhi(g.x); v0[2] *= bflo(g.y); v0[3] *= bfhi(g.y); v1[0] *= bflo(g.z); v1[1] *= bfhi(g.z); v1[2] *= bflo(g.w); v1[3] *= bfhi(g.w);
                    if (mode == 1) { const v4u t = *(const v4u*)(tin + ro + bj * 128);
                        v0[0] += bflo(t.x); v0[1] += bfhi(t.x); v0[2] += bflo(t.y); v0[3] += bfhi(t.y); v1[0] += bflo(t.z); v1[1] += bfhi(t.z); v1[2] += bflo(t.w); v1[3] += bfhi(t.w); }
                    pg8::u32x4 w; w.x = pg8::cvt_pk_bf16(v0[0], v0[1]); w.y = pg8::cvt_pk_bf16(v0[2], v0[3]); w.z = pg8::cvt_pk_bf16(v1[0], v1[1]); w.w = pg8::cvt_pk_bf16(v1[2], v1[3]);
                    *(pg8::u32x4*)(dst + ro + bj * 128) = w; } }
    }
};
struct EpiOut {
    static constexpr bool PERM = false, AFTER_DRAIN = false;
    const float* xp; const float* xs; float* out; float* ss;
    __device__ __forceinline__ void operator()(const f32x4 (&acc)[2][2][4][2], const pg8::Unit& u, int wr, int wc, int fr, int fq) const {
        const int rt0 = u.pm * 256 + wr * 64 + fr, c0 = u.pn * 256 + wc * 32 + 4 * fq;
#pragma unroll
        for (int ai = 0; ai < 2; ++ai)
#pragma unroll
            for (int m = 0; m < 4; ++m) { const int row = rt0 + ai * 128 + m * 16;
                const float* xr = (row < MP ? xp + (size_t)row * DM : xs + (size_t)(row - MP) * DM) + c0; float* orow = out + (size_t)row * DM + c0; float s = 0.f;
#pragma unroll
                for (int bj = 0; bj < 2; ++bj)
#pragma unroll
                    for (int n = 0; n < 2; ++n) { const f32x4 xv = *(const f32x4*)(xr + bj * 128 + n * 16); const f32x4 o = xv + acc[ai][bj][m][n];
                        *(f32x4*)(orow + bj * 128 + n * 16) = o; s += (o[0] * o[0] + o[1] * o[1]) + (o[2] * o[2] + o[3] * o[3]); }
                s += __shfl_xor(s, 16); s += __shfl_xor(s, 32);
                if (fq == 0) atomicAdd(ss + row, s); }
    }
};

struct ShareOrder {
    int nM, nN, nwg, G, c0, ns;
    __device__ void init(int M, int N, int G_, int c0_, int ns_) { nM = M / pg8::BM; nN = N / pg8::BM; nwg = nM * nN; G = G_; c0 = c0_; ns = ns_; }
    __device__ bool next(int i, pg8::Unit& u) const {
        const long L = (long)(i / ns) * G + c0 + (i % ns); if (L >= nwg) return false;
        int wgid = (int)L; { const int q = nwg / pg8::NXCD, r = nwg % pg8::NXCD, xcd = wgid % pg8::NXCD, off = wgid / pg8::NXCD; wgid = (xcd < r ? xcd * (q + 1) : r * (q + 1) + (xcd - r) * q) + off; }
        const int nig = pg8::WGM * nN, gid = wgid / nig, fm = gid * pg8::WGM, gsz = (nM - fm) < pg8::WGM ? (nM - fm) : pg8::WGM;
        u.pm = fm + ((wgid % nig) % gsz); u.pn = (wgid % nig) / gsz; return true;
    }
    __device__ __forceinline__ void a_ready(const pg8::Unit&) const {}
    __device__ __forceinline__ void done(const pg8::Unit&) const {}
};

__device__ const unsigned char T5B[132] = {0, 1, 2, 3, 4, 5, 6, 7, 8, 9, 10, 11, 12, 13, 14, 15, 16, 16, 16, 17, 17, 18, 18, 18, 19, 19, 19, 20, 20, 20, 20, 21, 21, 21, 21, 22, 22, 22, 22, 22, 23, 23, 23, 23, 23, 23, 24, 24, 24, 24, 24, 24, 25, 25, 25, 25, 25, 25, 25, 26, 26, 26, 26, 26, 26, 26, 26, 27, 27, 27, 27, 27, 27, 27, 27, 27, 27, 28, 28, 28, 28, 28, 28, 28, 28, 28, 28, 29, 29, 29, 29, 29, 29, 29, 29, 29, 29, 29, 29, 30, 30, 30, 30, 30, 30, 30, 30, 30, 30, 30, 30, 30, 30, 31, 31, 31, 31, 31, 31, 31, 31, 31, 31, 31, 31, 31, 31, 31, 31, 31, 31, 31};
constexpr int AT_KP = 144, AT_VP = 520, AT_VT_OFF = 256 * AT_KP, AT_BT_OFF = AT_VT_OFF + 64 * AT_VP;
__device__ __forceinline__ int crow(int r, int hi) { return (r & 3) + 8 * (r >> 2) + 4 * hi; }

template <int MODE>
__device__ __forceinline__ void attn_task(const Frame& F, const Args& AR, bf16* OB_, int b, int kvh, int n, int g_, int i) {
    LAS unsigned char* KL = F.lds; LAS unsigned char* VT = F.lds + AT_VT_OFF; LAS float* BT = (LAS float*)(F.lds + AT_BT_OFF);
    const int lane = lane_id(), q = lane & 31, hi = lane >> 5;
    int g, mq, dq;
    if (MODE == 0) { g = g_; mq = b * SEQ + n * 128 + 32 * i + q; dq = 128 + q; }
    else { g = q >> 3; mq = MP + b * DECS + (q & 7); dq = 128 + (q & 7); }
    const int h = kvh * 4 + g;
    bf16* QO = (bf16*)(F.ws + WS_Q); const bf16* GA = (const bf16*)(F.ws + WS_GA);
    bf16x8 qf[4];
    { const bf16* qp = QO + (size_t)mq * DM + h * HD + 8 * hi;
#pragma unroll
      for (int s = 0; s < 4; ++s) qf[s] = *(const bf16x8*)(qp + 16 * s); }
    const int kt0 = MODE == 0 ? i : 0;
    f32x16 sc[5];
    const float sink = AR.in[I_SINK][h];
    const LAS float* bt = BT + h * 192 + 32 + dq - 4 * hi;
    float mx = sink;
#pragma unroll
    for (int t = 0; t < 5; ++t) { const LAS unsigned char* kp = KL + (32 * (kt0 + t) + q) * AT_KP + 16 * hi; f32x16 a = {0.f, 0.f, 0.f, 0.f, 0.f, 0.f, 0.f, 0.f, 0.f, 0.f, 0.f, 0.f, 0.f, 0.f, 0.f, 0.f};
#pragma unroll
        for (int s = 0; s < 4; ++s) { const bf16x8 kf = *(const LAS bf16x8*)(kp + 32 * s); a = __builtin_amdgcn_mfma_f32_32x32x16_bf16(kf, qf[s], a, 0, 0, 0); }
        const bool dead = (MODE == 0) && n == 0 && (i + t) < 4;
#pragma unroll
        for (int r = 0; r < 16; ++r) { const int kb0 = 32 * t + (r & 3) + 8 * (r >> 2);
            float sv = a[r] * 0.125f + bt[-kb0]; sv = dead ? -INFINITY : sv; a[r] = sv; mx = fmaxf(mx, sv); }
        sc[t] = a;
        __builtin_amdgcn_sched_barrier(0); }
    mx = fmaxf(mx, __shfl_xor(mx, 32));
    float sum = 0.f;
#pragma unroll
    for (int t = 0; t < 5; ++t)
#pragma unroll
        for (int r = 0; r < 16; ++r) { const float p = __expf(sc[t][r] - mx); sum += p; sc[t][r] = p; }
    sum += __shfl_xor(sum, 32); sum += __expf(sink - mx);
    const float inv = 1.0f / sum;
    f32x16 o[2];
#pragma unroll
    for (int d = 0; d < 2; ++d) o[d] = (f32x16){0.f, 0.f, 0.f, 0.f, 0.f, 0.f, 0.f, 0.f, 0.f, 0.f, 0.f, 0.f, 0.f, 0.f, 0.f, 0.f};
#pragma unroll
    for (int t = 0; t < 5; ++t)
#pragma unroll
        for (int s2 = 0; s2 < 2; ++s2) {
            v4u pw; pw.x = pk2(sc[t][8 * s2 + 0], sc[t][8 * s2 + 1]); pw.y = pk2(sc[t][8 * s2 + 2], sc[t][8 * s2 + 3]); pw.z = pk2(sc[t][8 * s2 + 4], sc[t][8 * s2 + 5]); pw.w = pk2(sc[t][8 * s2 + 6], sc[t][8 * s2 + 7]);
            const bf16x8 pb = __builtin_bit_cast(bf16x8, pw);
#pragma unroll
            for (int d = 0; d < 2; ++d) { const LAS unsigned char* vp = VT + (32 * d + q) * AT_VP + (32 * (kt0 + t) + 16 * s2 + 4 * hi) * 2;
                const v2u lo = *(const LAS v2u*)vp, hi2 = *(const LAS v2u*)(vp + 16);
                v4u aw; aw.x = lo.x; aw.y = lo.y; aw.z = hi2.x; aw.w = hi2.y;
                o[d] = __builtin_amdgcn_mfma_f32_32x32x16_bf16(__builtin_bit_cast(bf16x8, aw), pb, o[d], 0, 0, 0); }
            __builtin_amdgcn_sched_barrier(0); }
    bf16* op = OB_ + (size_t)mq * DM + h * HD; const bf16* gp = GA + (size_t)mq * DM + h * HD;
#pragma unroll
    for (int d = 0; d < 2; ++d)
#pragma unroll
        for (int rq = 0; rq < 4; ++rq) { const int dv0 = 32 * d + 8 * rq + 4 * hi; const v2u gv = *(const v2u*)(gp + dv0);
            v2u w; w.x = pk2(o[d][4 * rq + 0] * inv * bflo(gv.x), o[d][4 * rq + 1] * inv * bfhi(gv.x)); w.y = pk2(o[d][4 * rq + 2] * inv * bflo(gv.y), o[d][4 * rq + 3] * inv * bfhi(gv.y));
            *(v2u*)(op + dv0) = w; }
}

struct AttnStage { v4u kx[4], vx[4]; };
__device__ __forceinline__ void attn_stage_load(AttnStage& st, const Frame& F, int unit, int tid) {
    const bf16* Kb = (const bf16*)(F.ws + WS_K); const bf16* Vb = (const bf16*)(F.ws + WS_V);
    const int kvh = unit & 3, n = (unit >> 2) & 31, b = unit >> 7, t0 = (n - 1) * 128;
#pragma unroll
    for (int it = 0; it < 4; ++it) { const int c = it * NTHR + tid, key = c >> 3, part = c & 7, tok = t0 + key; st.kx[it] = (v4u){0u, 0u, 0u, 0u};
        if (tok >= 0) st.kx[it] = *(const v4u*)(Kb + (size_t)(b * SEQ + tok) * KVW + kvh * HD + part * 8); }
#pragma unroll
    for (int it = 0; it < 4; ++it) { const int c = it * NTHR + tid, key = c & 255, part = c >> 8, tok = t0 + key; st.vx[it] = (v4u){0u, 0u, 0u, 0u};
        if (tok >= 0) st.vx[it] = *(const v4u*)(Vb + (size_t)(b * SEQ + tok) * KVW + kvh * HD + part * 8); }
}
__device__ __forceinline__ void attn_stage_write(const AttnStage& st, const Frame& F, int tid) {
    LAS unsigned char* KL = F.lds; LAS unsigned char* VT = F.lds + AT_VT_OFF;
#pragma unroll
    for (int it = 0; it < 4; ++it) { const int c = it * NTHR + tid, key = c >> 3, part = c & 7; *(LAS v4u*)(KL + key * AT_KP + part * 16) = st.kx[it]; }
#pragma unroll
    for (int it = 0; it < 4; ++it) { const int c = it * NTHR + tid, key = c & 255, part = c >> 8; const v4u val = st.vx[it];
        LAS bf16* vt = (LAS bf16*)(VT + (part * 8) * AT_VP + key * 2);
        vt[0 * (AT_VP / 2)] = (bf16)val.x; vt[1 * (AT_VP / 2)] = (bf16)(val.x >> 16); vt[2 * (AT_VP / 2)] = (bf16)val.y; vt[3 * (AT_VP / 2)] = (bf16)(val.y >> 16);
        vt[4 * (AT_VP / 2)] = (bf16)val.z; vt[5 * (AT_VP / 2)] = (bf16)(val.z >> 16); vt[6 * (AT_VP / 2)] = (bf16)val.w; vt[7 * (AT_VP / 2)] = (bf16)(val.w >> 16); }
}
__device__ __forceinline__ void attn_stage_sample(const Frame& F, const Args& AR, int su, int tid) {
    LAS unsigned char* KL = F.lds; LAS unsigned char* VT = F.lds + AT_VT_OFF;
    const bf16* Kb = (const bf16*)(F.ws + WS_K); const bf16* Vb = (const bf16*)(F.ws + WS_V);
    const int kvh = su & 3, b = su >> 2;
    for (int c = tid; c < 160 * 8; c += NTHR) {
        { const int key = c >> 3, part = c & 7; v4u val = (v4u){0u, 0u, 0u, 0u};
          if (key < 128) { const float* src = AR.in[I_CK] + ((size_t)(b * WIN + key) * NKV + kvh) * HD + part * 8; const f32x4 a = *(const f32x4*)src, bb = *(const f32x4*)(src + 4);
              val.x = pk2(a.x, a.y); val.y = pk2(a.z, a.w); val.z = pk2(bb.x, bb.y); val.w = pk2(bb.z, bb.w);
              if (key >= 8) { float* d = F.out + O_SKW + ((size_t)(b * WIN + key - 8) * NKV + kvh) * HD + part * 8; *(f32x4*)d = a; *(f32x4*)(d + 4) = bb; } }
          else if (key < 136) val = *(const v4u*)(Kb + (size_t)(MP + b * DECS + key - 128) * KVW + kvh * HD + part * 8);
          *(LAS v4u*)(KL + key * AT_KP + part * 16) = val; }
        { const int key = c % 160, part = c / 160; v4u val = (v4u){0u, 0u, 0u, 0u};
          if (key < 128) { const float* src = AR.in[I_CV] + ((size_t)(b * WIN + key) * NKV + kvh) * HD + part * 8; const f32x4 a = *(const f32x4*)src, bb = *(const f32x4*)(src + 4);
              val.x = pk2(a.x, a.y); val.y = pk2(a.z, a.w); val.z = pk2(bb.x, bb.y); val.w = pk2(bb.z, bb.w);
              if (key >= 8) { float* d = F.out + O_SVW + ((size_t)(b * WIN + key - 8) * NKV + kvh) * HD + part * 8; *(f32x4*)d = a; *(f32x4*)(d + 4) = bb; } }
          else if (key < 136) val = *(const v4u*)(Vb + (size_t)(MP + b * DECS + key - 128) * KVW + kvh * HD + part * 8);
          LAS bf16* vt = (LAS bf16*)(VT + (part * 8) * AT_VP + key * 2);
          vt[0 * (AT_VP / 2)] = (bf16)val.x; vt[1 * (AT_VP / 2)] = (bf16)(val.x >> 16); vt[2 * (AT_VP / 2)] = (bf16)val.y; vt[3 * (AT_VP / 2)] = (bf16)(val.y >> 16);
          vt[4 * (AT_VP / 2)] = (bf16)val.z; vt[5 * (AT_VP / 2)] = (bf16)(val.z >> 16); vt[6 * (AT_VP / 2)] = (bf16)val.w; vt[7 * (AT_VP / 2)] = (bf16)(val.w >> 16); }
    }
}
__device__ __forceinline__ void attn_phase(const Frame& F, const Args& AR, bf16* OB_) {
    LAS float* BT = (LAS float*)(F.lds + AT_BT_OFF);
    int lane = lane_id(); asm volatile("" : "+v"(lane));
    const int tid = F.wave * 64 + lane;
    __syncthreads();
    for (int idx = tid; idx < 16 * 192; idx += NTHR) { const int hh_ = idx / 192, d = idx - hh_ * 192 - 32; BT[idx] = (d >= 0 && d <= 128) ? AR.in[I_RELB][(int)T5B[d] * NH + hh_] : -INFINITY; }
    AttnStage st;
    int u = F.vcu;
    if (u < 1024) attn_stage_load(st, F, u, tid);
    for (; u < 1024 + 512; u += F.G) {
        __syncthreads();
        const bool sample = u >= 1024;
        if (!sample) attn_stage_write(st, F, tid); else attn_stage_sample(F, AR, u - 1024, tid);
        __syncthreads();
        const int un = u + F.G;
        if (un < 1024) attn_stage_load(st, F, un, tid);
        if (!sample) { const int kvh = u & 3, n = (u >> 2) & 31, b = u >> 7; for (int task = F.wave; task < 16; task += NWAVES) attn_task<0>(F, AR, OB_, b, kvh, n, task >> 2, task & 3); }
        else if (F.wave == 0) { const int su = u - 1024; attn_task<1>(F, AR, OB_, su >> 2, su & 3, 0, 0, 0); }
    }
}

namespace s3 {
constexpr int P68 = 136, P36 = 72;
constexpr int W2T = 0, A2T = W2T + 64 * P68, PAR = A2T + 64 * P68, YT = PAR + 12 * 256  , XCH = YT + 2 * 4608  , GCRK = XCH + 1280  , SCR = GCRK + 12 * 384;
constexpr int RM0 = 0, RM1 = 2304, IMGV = 4608, IMG2 = 9216, SCRW = 13824;
constexpr int END = SCR + 6 * SCRW;
static_assert(END <= RING_BYTES && (YT % 16) == 0 && (SCR % 16) == 0, "scan LDS map");
constexpr int R_R2 = 0, R_Y02 = 4096, R_G = 8192, R_H = 16384, R_V = 24576, R_GC = 28672, R_RK = 28928, R_SIZE = 29184, RING = 12;
constexpr size_t RING_BYTES_WG = (size_t)RING * R_SIZE;
static_assert(128 * RING_BYTES_WG <= 48 * MiB && 64 * RING_BYTES_WG <= 33 * MiB, "record rings: prompt workgroups at WS_RING, sample workgroups in the K/V region");
}
typedef float f32x2_t __attribute__((ext_vector_type(2))); typedef __bf16 bf16x2_t __attribute__((ext_vector_type(2)));
__device__ __forceinline__ unsigned cvtpk(float lo, float hi) { f32x2_t v = {lo, hi}; bf16x2_t b = __builtin_convertvector(v, bf16x2_t); return __builtin_bit_cast(unsigned, b); }
__device__ __forceinline__ bf16x8 frag_nat(LAS const unsigned char* base, int pitch, int row, int col0) {
    LAS const unsigned char* p = base + row * pitch + col0 * 2; const v2u a = *(LAS const v2u*)p, b = *(LAS const v2u*)(p + 8);
    v4u w; w.x = a.x; w.y = a.y; w.z = b.x; w.w = b.y; return __builtin_bit_cast(bf16x8, w); }
__device__ __forceinline__ bf16x8 frag_perm(LAS const unsigned char* base, int pitch, int row, int c0, int hi) {
    LAS const unsigned char* p = base + row * pitch + (c0 + 4 * hi) * 2; const v2u a = *(LAS const v2u*)p, b = *(LAS const v2u*)(p + 16);
    v4u w; w.x = a.x; w.y = a.y; w.z = b.x; w.w = b.y; return __builtin_bit_cast(bf16x8, w); }
__device__ __forceinline__ bf16x8 pk8(const f32x16& x, int s) {
    v4u w; w.x = cvtpk(x[8 * s + 0], x[8 * s + 1]); w.y = cvtpk(x[8 * s + 2], x[8 * s + 3]); w.z = cvtpk(x[8 * s + 4], x[8 * s + 5]); w.w = cvtpk(x[8 * s + 6], x[8 * s + 7]); return __builtin_bit_cast(bf16x8, w); }
__device__ __forceinline__ bf16x8 pk8f(const float* x) { v4u w; w.x = cvtpk(x[0], x[1]); w.y = cvtpk(x[2], x[3]); w.z = cvtpk(x[4], x[5]); w.w = cvtpk(x[6], x[7]); return __builtin_bit_cast(bf16x8, w); }
__device__ __forceinline__ void store_rm(LAS unsigned char* base, int pitch, const f32x16& x, int q, int hi) {
#pragma unroll
    for (int r = 0; r < 16; r += 2) { const unsigned w = cvtpk(x[r], x[r + 1]);
        *(LAS bf16*)(base + crow(r, hi) * pitch + 2 * q) = (bf16)w; *(LAS bf16*)(base + crow(r + 1, hi) * pitch + 2 * q) = (bf16)(w >> 16); }
}
__device__ __forceinline__ void store16bf(unsigned char* p, const f32x16& x) {
    v4u a, b; a.x = cvtpk(x[0], x[1]); a.y = cvtpk(x[2], x[3]); a.z = cvtpk(x[4], x[5]); a.w = cvtpk(x[6], x[7]); b.x = cvtpk(x[8], x[9]); b.y = cvtpk(x[10], x[11]); b.z = cvtpk(x[12], x[13]); b.w = cvtpk(x[14], x[15]);
    *(v4u*)p = a; *(v4u*)(p + 16) = b; }
__device__ __forceinline__ f32x16 load16bf(const unsigned char* p) {
    const v4u a = *(const v4u*)p, b = *(const v4u*)(p + 16);
    return (f32x16){bflo(a.x), bfhi(a.x), bflo(a.y), bfhi(a.y), bflo(a.z), bfhi(a.z), bflo(a.w), bfhi(a.w), bflo(b.x), bfhi(b.x), bflo(b.y), bfhi(b.y), bflo(b.z), bfhi(b.z), bflo(b.w), bfhi(b.w)}; }
#define MFMA32(a, b, c) __builtin_amdgcn_mfma_f32_32x32x16_bf16((a), (b), (c), 0, 0, 0)
#define ZERO16 ((f32x16){0.f, 0.f, 0.f, 0.f, 0.f, 0.f, 0.f, 0.f, 0.f, 0.f, 0.f, 0.f, 0.f, 0.f, 0.f, 0.f})
#define DPPV(x, ctrl, rowmask) __builtin_bit_cast(float, __builtin_amdgcn_update_dpp(0, __builtin_bit_cast(int, (x)), (ctrl), (rowmask), 0xF, true))
__device__ __forceinline__ float tanh_fast(float x) { return 1.0f - 2.0f * __builtin_amdgcn_rcpf(__expf(2.0f * x) + 1.0f); }
__device__ __forceinline__ float xhalf_sum(float x) { return x + __shfl_xor(x, 32); }

__device__ __forceinline__ f32x16 unpack16(v4u a, v4u b) {
    return (f32x16){bflo(a.x), bfhi(a.x), bflo(a.y), bfhi(a.y), bflo(a.z), bfhi(a.z), bflo(a.w), bfhi(a.w), bflo(b.x), bfhi(b.x), bflo(b.y), bfhi(b.y), bflo(b.z), bfhi(b.z), bflo(b.w), bfhi(b.w)}; }
struct S1Rows { v4u x[5]; };
__device__ __forceinline__ void s1_stage_load(S1Rows& r, const bf16* PS, size_t row0, const bf16* vrow, int col0, int nrows, int lane) {
    const unsigned char* base = (const unsigned char*)(PS + row0 * SHW + col0);
    const unsigned char* vb = (const unsigned char*)(vrow ? vrow + col0 : PS + row0 * SHW + col0);
#pragma unroll
    for (int i = 0; i < 5; ++i) { const int p = lane + 64 * i; int row = p >> 3; const int piece = p & 7; if (row > nrows) row = nrows;
        const int off = (row - 1) * (SHW * 2) + piece * 16;
        const unsigned char* src = (row == 0 && vrow) ? vb + piece * 16 : base + off;
        if (i < 4 || lane < 8) r.x[i] = *(const v4u*)src; }
}
__device__ __forceinline__ void s1_stage_write(LAS unsigned char* stg, const S1Rows& r, int lane) {
#pragma unroll
    for (int i = 0; i < 5; ++i) { const int p = lane + 64 * i; const int row = p >> 3, piece = p & 7;
        if (i < 4 || lane < 8) { LAS unsigned char* d = stg + row * 136 + piece * 16; *(LAS v2u*)d = (v2u){r.x[i].x, r.x[i].y}; *(LAS v2u*)(d + 8) = (v2u){r.x[i].z, r.x[i].w}; } }
}
__device__ __forceinline__ f32x4 s1_z4(LAS const unsigned char* stg, int t, int off, f32x4 mu, bool act) {
    const v2u cu = *(LAS const v2u*)(stg + (t + 1) * 136 + off), pu = *(LAS const v2u*)(stg + t * 136 + off);
    const f32x4 cur = {bflo(cu.x), bfhi(cu.x), bflo(cu.y), bfhi(cu.y)}, prv = {bflo(pu.x), bfhi(pu.x), bflo(pu.y), bfhi(pu.y)};
    f32x4 z = cur + (prv - cur) * mu;
    if (!act) z = (f32x4){0.f, 0.f, 0.f, 0.f};
    return z;
}

template <bool FULL  >
__device__ __forceinline__ void s1_chunk(const Args& AR, LAS unsigned char* L, LAS unsigned char* scr, unsigned char* rec, LAS float* gcrk, const bf16* PS, size_t row0, const bf16* vrow  , int h, int ntok, int lane_) {
    int lane = lane_; asm volatile("" : "+v"(lane));
    const int t = lane & 31, hh = lane >> 5;
    const bool act = FULL ? true : (t < ntok);
    LAS unsigned char* stg = scr + s3::RM0;
    float lw[32]; unsigned asgp[16];
    {
        bf16x8 TWf[4], ALf[4];
        S1Rows rw_, ra_; s1_stage_load(rw_, PS, row0, vrow, 3072, ntok, lane); s1_stage_load(ra_, PS, row0, vrow, 3136, ntok, lane);
        s1_stage_write(stg, rw_, lane);
#pragma unroll
        for (int s = 0; s < 4; ++s) { const int jb = 16 * s + 8 * hh;
            const f32x4 w0 = s1_z4(stg, t, jb * 2, *(LAS const f32x4*)(L + s3::PAR + 10 * 256 + jb * 4), act), w1 = s1_z4(stg, t, jb * 2 + 8, *(LAS const f32x4*)(L + s3::PAR + 10 * 256 + (jb + 4) * 4), act);
            const float tw[8] = {tanh_fast(w0[0]), tanh_fast(w0[1]), tanh_fast(w0[2]), tanh_fast(w0[3]), tanh_fast(w1[0]), tanh_fast(w1[1]), tanh_fast(w1[2]), tanh_fast(w1[3])};
            TWf[s] = pk8f(tw); }
        __builtin_amdgcn_sched_barrier(0);
        s1_stage_write(stg, ra_, lane);
#pragma unroll
        for (int s = 0; s < 4; ++s) { const int jb = 16 * s + 8 * hh;
            const f32x4 a0 = s1_z4(stg, t, jb * 2, *(LAS const f32x4*)(L + s3::PAR + 11 * 256 + jb * 4), act), a1 = s1_z4(stg, t, jb * 2 + 8, *(LAS const f32x4*)(L + s3::PAR + 11 * 256 + (jb + 4) * 4), act);
            const float al[8] = {a0[0], a0[1], a0[2], a0[3], a1[0], a1[1], a1[2], a1[3]};
            ALf[s] = pk8f(al); }
        __builtin_amdgcn_sched_barrier(0);
        f32x16 uw[2] = {ZERO16, ZERO16}, ua[2] = {ZERO16, ZERO16};
#pragma unroll
        for (int ct = 0; ct < 2; ++ct)
#pragma unroll
            for (int s = 0; s < 4; ++s) { uw[ct] = MFMA32(frag_nat(L + s3::W2T, s3::P68, 32 * ct + t, 16 * s + 8 * hh), TWf[s], uw[ct]);
                                          ua[ct] = MFMA32(frag_nat(L + s3::A2T, s3::P68, 32 * ct + t, 16 * s + 8 * hh), ALf[s], ua[ct]);
                                          if (s & 1) __builtin_amdgcn_sched_barrier(0); }
#pragma unroll
        for (int u = 0; u < 8; ++u) { const int chb = 8 * u + 4 * hh; const f32x4 w0 = *(LAS const f32x4*)(L + s3::PAR + 0 * 256 + chb * 4), a0 = *(LAS const f32x4*)(L + s3::PAR + 1 * 256 + chb * 4);
            float ag[4];
#pragma unroll
            for (int j = 0; j < 4; ++j) { const int sl = 4 * u + j;
                lw[sl] = act ? -0.6065306597126334f * sigmoidf_(uw[sl >> 4][sl & 15] + w0[j]) : 0.f; ag[j] = sigmoidf_(ua[sl >> 4][sl & 15] + a0[j]); }
            asgp[2 * u] = cvtpk(ag[0], ag[1]); asgp[2 * u + 1] = cvtpk(ag[2], ag[3]);
            if (u & 1) __builtin_amdgcn_sched_barrier(0); }
    }
    __builtin_amdgcn_sched_barrier(0);
#define Lc lw
#pragma unroll
    for (int sl = 0; sl < 32; ++sl) { float x = lw[sl];
        x += DPPV(x, 0x111, 0xF); x += DPPV(x, 0x112, 0xF); x += DPPV(x, 0x114, 0xF); x += DPPV(x, 0x118, 0xF);
        x += __builtin_bit_cast(float, __builtin_amdgcn_update_dpp(0, __builtin_bit_cast(int, x), 0x142, 0xA, 0xF, false));
        Lc[sl] = x; }
    __builtin_amdgcn_sched_barrier(0);
    S1Rows rv_, rk_, rr_;
    s1_stage_load(rv_, PS, row0, vrow, 2 * 1024 + h * HD, ntok, lane); s1_stage_load(rk_, PS, row0, vrow, 1 * 1024 + h * HD, ntok, lane); s1_stage_load(rr_, PS, row0, vrow, 0 * 1024 + h * HD, ntok, lane);
    {
        float zv[32]; bf16x8 Vf[4];
        s1_stage_write(stg, rv_, lane);
#pragma unroll
        for (int u = 0; u < 8; ++u) { const int chb = 8 * u + 4 * hh;
            const f32x4 c = s1_z4(stg, t, chb * 2, *(LAS const f32x4*)(L + s3::PAR + 9 * 256 + chb * 4), act);
#pragma unroll
            for (int j = 0; j < 4; ++j) zv[4 * u + j] = c[j]; }
#pragma unroll
        for (int s = 0; s < 4; ++s) Vf[s] = pk8f(zv + 8 * s);
#pragma unroll
        for (int u = 0; u < 8; ++u)
#pragma unroll
            for (int j = 0; j < 4; j += 2) { const unsigned w = cvtpk(zv[4 * u + j], zv[4 * u + j + 1]);
                *(LAS bf16*)(scr + s3::IMGV + (8 * u + 4 * hh + j) * s3::P36 + 2 * t) = (bf16)w; *(LAS bf16*)(scr + s3::IMGV + (8 * u + 4 * hh + j + 1) * s3::P36 + 2 * t) = (bf16)(w >> 16); }
#pragma unroll
        for (int s = 0; s < 4; ++s) *(bf16x8*)(rec + s3::R_V + (s * 64 + lane) * 16) = Vf[s];
    }
    __builtin_amdgcn_sched_barrier(0);
    float rk = 0.f;
    f32x16 Mab = ZERO16, Mak = ZERO16, Mrk = ZERO16, Mrb = ZERO16;
    {
        unsigned zkp[16]; float ss = 0.f;
        s1_stage_write(stg, rk_, lane);
#pragma unroll
        for (int u = 0; u < 8; ++u) { const int chb = 8 * u + 4 * hh;
            const f32x4 b = s1_z4(stg, t, chb * 2, *(LAS const f32x4*)(L + s3::PAR + 8 * 256 + chb * 4), act);
            const f32x4 kkw = *(LAS const f32x4*)(L + s3::PAR + 2 * 256 + chb * 4);
#pragma unroll
            for (int j = 0; j < 4; ++j) { const float kk = b[j] * kkw[j]; ss += kk * kk; }
            zkp[2 * u] = cvtpk(b[0], b[1]); zkp[2 * u + 1] = cvtpk(b[2], b[3]); }
        ss = xhalf_sum(ss);
        const float invn = 1.0f / fmaxf(sqrtf(ss), 1e-12f);
        const int last = (lane & 32) | 31;
        __builtin_amdgcn_sched_barrier(0);
        s1_stage_write(stg, rr_, lane);
#pragma unroll
        for (int s = 0; s < 4; ++s) {
            unsigned aw[4], rw[4], bw[4], kw[4], hw[4];
#pragma unroll
            for (int e = 0; e < 2; ++e) { const int u = 2 * s + e, chb = 8 * u + 4 * hh;
                const f32x4 zr = s1_z4(stg, t, chb * 2, *(LAS const f32x4*)(L + s3::PAR + 7 * 256 + chb * 4), act);
                const f32x4 kkw = *(LAS const f32x4*)(L + s3::PAR + 2 * 256 + chb * 4), kaw = *(LAS const f32x4*)(L + s3::PAR + 3 * 256 + chb * 4), rkw = *(LAS const f32x4*)(L + s3::PAR + 4 * 256 + chb * 4);
                float at[4], rt[4], bt[4], kt[4], bh[4], kh[4];
                const float zk4[4] = {bflo(zkp[2 * u]), bfhi(zkp[2 * u]), bflo(zkp[2 * u + 1]), bfhi(zkp[2 * u + 1])}, as4[4] = {bflo(asgp[2 * u]), bfhi(asgp[2 * u]), bflo(asgp[2 * u + 1]), bfhi(asgp[2 * u + 1])};
#pragma unroll
                for (int j = 0; j < 4; ++j) { const int sl = 4 * u + j;
                    const float e2 = __expf(Lc[sl]); const float e2lo = __shfl_up(e2, 1); const float e1 = t == 0 ? 1.0f : e2lo  , e3 = __builtin_amdgcn_rcpf(e2), gcv = __shfl(e2, last), e4 = gcv * e3;
                    const float kn = zk4[j] * kkw[j] * invn, kp = zk4[j] * (1.0f + (as4[j] - 1.0f) * kaw[j]), bb = kn * as4[j];
                    at[j] = -kn * e1; rt[j] = zr[j] * e2; bt[j] = bb * e3; kt[j] = kp * e3; bh[j] = bb * e4; kh[j] = kp * e4; rk += zr[j] * kp * rkw[j]; }
#pragma unroll
                for (int p = 0; p < 2; ++p) { aw[2 * e + p] = cvtpk(at[2 * p], at[2 * p + 1]); rw[2 * e + p] = cvtpk(rt[2 * p], rt[2 * p + 1]); bw[2 * e + p] = cvtpk(bt[2 * p], bt[2 * p + 1]); kw[2 * e + p] = cvtpk(kt[2 * p], kt[2 * p + 1]); hw[2 * e + p] = cvtpk(bh[2 * p], bh[2 * p + 1]);
                    const unsigned w = cvtpk(kh[2 * p], kh[2 * p + 1]); const int ch = chb + 2 * p;
                    *(LAS bf16*)(scr + s3::IMG2 + ch * s3::P36 + 2 * t) = (bf16)w; *(LAS bf16*)(scr + s3::IMG2 + (ch + 1) * s3::P36 + 2 * t) = (bf16)(w >> 16); } }
            const bf16x8 Af = __builtin_bit_cast(bf16x8, (v4u){aw[0], aw[1], aw[2], aw[3]}), Rf = __builtin_bit_cast(bf16x8, (v4u){rw[0], rw[1], rw[2], rw[3]}), Bf = __builtin_bit_cast(bf16x8, (v4u){bw[0], bw[1], bw[2], bw[3]}), Kf = __builtin_bit_cast(bf16x8, (v4u){kw[0], kw[1], kw[2], kw[3]});
            Mab = MFMA32(Af, Bf, Mab); Mak = MFMA32(Af, Kf, Mak); Mrk = MFMA32(Rf, Kf, Mrk); Mrb = MFMA32(Rf, Bf, Mrb);
            *(bf16x8*)(rec + s3::R_G + 4096 + (s * 64 + lane) * 16) = Af; *(bf16x8*)(rec + s3::R_R2 + (s * 64 + lane) * 16) = Rf; *(v4u*)(rec + s3::R_G + (s * 64 + lane) * 16) = (v4u){hw[0], hw[1], hw[2], hw[3]};
            __builtin_amdgcn_sched_barrier(0);
        }
        rk = xhalf_sum(rk);
        if (hh == 0) gcrk[64 + t] = rk;
        if (t == 31) {
#pragma unroll
            for (int u = 0; u < 8; ++u) *(LAS f32x4*)(gcrk + 8 * u + 4 * hh) = (f32x4){__expf(Lc[4 * u]), __expf(Lc[4 * u + 1]), __expf(Lc[4 * u + 2]), __expf(Lc[4 * u + 3])}; }
    }
#pragma unroll
    for (int r = 0; r < 16; ++r) { const int rr = crow(r, hh); Mab[r] = (t < rr) ? Mab[r] : 0.f; Mak[r] = (t < rr) ? Mak[r] : 0.f; Mrk[r] = (t <= rr) ? Mrk[r] : 0.f; Mrb[r] = (t <= rr) ? Mrb[r] : 0.f; }
    bf16x8 Atf[4];
#pragma unroll
    for (int kt = 0; kt < 2; ++kt)
#pragma unroll
        for (int vt = 0; vt < 2; ++vt) { f32x16 Hh = ZERO16;
#pragma unroll
            for (int s = 0; s < 2; ++s) Hh = MFMA32(frag_nat(scr + s3::IMG2, s3::P36, 32 * kt + t, 16 * s + 8 * hh), frag_nat(scr + s3::IMGV, s3::P36, 32 * vt + t, 16 * s + 8 * hh), Hh);
            store16bf(rec + s3::R_H + ((kt * 2 + vt) * 64 + lane) * 32, Hh); }
    __builtin_amdgcn_sched_barrier(0);
#define S1_IMG(img, f) do { _Pragma("unroll") for (int s_ = 0; s_ < 4; ++s_) { const v4u w_ = __builtin_bit_cast(v4u, (f)[s_]); _Pragma("unroll") for (int e_ = 0; e_ < 4; ++e_) { const unsigned x_ = e_ == 0 ? w_.x : (e_ == 1 ? w_.y : (e_ == 2 ? w_.z : w_.w)); \
        const int ch_ = 8 * (2 * s_ + (e_ >> 1)) + 4 * hh + 2 * (e_ & 1); *(LAS bf16*)(scr + (img) + ch_ * s3::P36 + 2 * t) = (bf16)x_; *(LAS bf16*)(scr + (img) + (ch_ + 1) * s3::P36 + 2 * t) = (bf16)(x_ >> 16); } } } while (0)
    f32x16 Tm;
    {
        f32x16 Pm = Mab;
        Tm = Pm;
#pragma unroll
        for (int r = 0; r < 16; ++r) Tm[r] += (crow(r, hh) == t) ? 1.0f : 0.0f;
#pragma unroll
        for (int lv = 0; lv < 4; ++lv) {
            store_rm(scr + s3::RM0, s3::P36, Pm, t, hh); store_rm(scr + s3::RM1, s3::P36, Tm, t, hh);
            const bf16x8 p0 = pk8(Pm, 0), p1 = pk8(Pm, 1);
            f32x16 Pn = MFMA32(frag_perm(scr + s3::RM0, s3::P36, t, 0, hh), p0, ZERO16); Pn = MFMA32(frag_perm(scr + s3::RM0, s3::P36, t, 16, hh), p1, Pn);
            const bf16x8 n0 = pk8(Pn, 0), n1 = pk8(Pn, 1);
            Tm = MFMA32(frag_perm(scr + s3::RM1, s3::P36, t, 0, hh), n0, Tm); Tm = MFMA32(frag_perm(scr + s3::RM1, s3::P36, t, 16, hh), n1, Tm);
            Pm = Pn;
            if (lv == 1) {
#pragma unroll
                for (int s = 0; s < 4; ++s) Atf[s] = *(const bf16x8*)(rec + s3::R_G + 4096 + (s * 64 + lane) * 16); }
        }
        store_rm(scr + s3::RM0, s3::P36, Tm, t, hh);
    }
    f32x16 W1[2];
    S1_IMG(s3::IMG2, Atf);
#pragma unroll
    for (int nt = 0; nt < 2; ++nt) { W1[nt] = ZERO16;
#pragma unroll
        for (int s = 0; s < 2; ++s) W1[nt] = MFMA32(frag_nat(scr + s3::RM0, s3::P36, t, 16 * s + 8 * hh), frag_nat(scr + s3::IMG2, s3::P36, 32 * nt + t, 16 * s + 8 * hh), W1[nt]); }
    v4u Rtp[4], H0a[4], H0b[4]; bf16x8 Bhf[4];
#pragma unroll
    for (int s = 0; s < 4; ++s) Rtp[s] = *(const v4u*)(rec + s3::R_R2 + (s * 64 + lane) * 16);
    f32x16 W2[2];
    {
        store_rm(scr + s3::RM1, s3::P36, Mak, t, hh);
#pragma unroll
        for (int vt = 0; vt < 2; ++vt) { f32x16 X = ZERO16;
#pragma unroll
            for (int s = 0; s < 2; ++s) X = MFMA32(frag_nat(scr + s3::RM1, s3::P36, t, 16 * s + 8 * hh), frag_nat(scr + s3::IMGV, s3::P36, 32 * vt + t, 16 * s + 8 * hh), X);
            W2[vt] = MFMA32(frag_perm(scr + s3::RM0, s3::P36, t, 0, hh), pk8(X, 0), ZERO16); W2[vt] = MFMA32(frag_perm(scr + s3::RM0, s3::P36, t, 16, hh), pk8(X, 1), W2[vt]); }
    }
    f32x16 Y02[2];
    {
        store_rm(scr + s3::RM1, s3::P36, Mrk, t, hh);
#pragma unroll
        for (int vt = 0; vt < 2; ++vt) { Y02[vt] = ZERO16;
#pragma unroll
            for (int s = 0; s < 2; ++s) Y02[vt] = MFMA32(frag_nat(scr + s3::RM1, s3::P36, t, 16 * s + 8 * hh), frag_nat(scr + s3::IMGV, s3::P36, 32 * vt + t, 16 * s + 8 * hh), Y02[vt]); }
    }
#pragma unroll
    for (int s = 0; s < 4; ++s) { if (s < 2) { H0a[s] = *(const v4u*)(rec + s3::R_H + (s * 64 + lane) * 32); H0b[s] = *(const v4u*)(rec + s3::R_H + (s * 64 + lane) * 32 + 16); } Bhf[s] = *(const bf16x8*)(rec + s3::R_G + (s * 64 + lane) * 16); }
    {
        store_rm(scr + s3::RM1, s3::P36, Mrb, t, hh);
        const bf16x8 mb0 = frag_perm(scr + s3::RM1, s3::P36, t, 0, hh), mb1 = frag_perm(scr + s3::RM1, s3::P36, t, 16, hh);
#pragma unroll
        for (int vt = 0; vt < 2; ++vt) { Y02[vt] = MFMA32(mb0, pk8(W2[vt], 0), Y02[vt]); Y02[vt] = MFMA32(mb1, pk8(W2[vt], 1), Y02[vt]);
            store16bf(rec + s3::R_Y02 + (vt * 64 + lane) * 32, Y02[vt]); }
#pragma unroll
        for (int kt = 0; kt < 2; ++kt) { f32x16 R2 = MFMA32(pk8(W1[kt], 0), mb0, ZERO16); R2 = MFMA32(pk8(W1[kt], 1), mb1, R2);
#pragma unroll
            for (int sx = 0; sx < 2; ++sx) { const v4u rw = Rtp[2 * kt + sx];
                R2[8 * sx + 0] += bflo(rw.x); R2[8 * sx + 1] += bfhi(rw.x); R2[8 * sx + 2] += bflo(rw.y); R2[8 * sx + 3] += bfhi(rw.y); R2[8 * sx + 4] += bflo(rw.z); R2[8 * sx + 5] += bfhi(rw.z); R2[8 * sx + 6] += bflo(rw.w); R2[8 * sx + 7] += bfhi(rw.w); }
            *(bf16x8*)(rec + s3::R_R2 + ((2 * kt + 0) * 64 + lane) * 16) = pk8(R2, 0); *(bf16x8*)(rec + s3::R_R2 + ((2 * kt + 1) * 64 + lane) * 16) = pk8(R2, 1); }
    }
    S1_IMG(s3::IMG2, Bhf);
#pragma unroll
    for (int s = 2; s < 4; ++s) { H0a[s] = *(const v4u*)(rec + s3::R_H + (s * 64 + lane) * 32); H0b[s] = *(const v4u*)(rec + s3::R_H + (s * 64 + lane) * 32 + 16); }
#pragma unroll
    for (int kt = 0; kt < 2; ++kt) { const bf16x8 b0 = frag_perm(scr + s3::IMG2, s3::P36, 32 * kt + t, 0, hh), b1 = frag_perm(scr + s3::IMG2, s3::P36, 32 * kt + t, 16, hh);
#pragma unroll
        for (int vt = 0; vt < 2; ++vt) { f32x16 Hh = unpack16(H0a[kt * 2 + vt], H0b[kt * 2 + vt]); Hh = MFMA32(b0, pk8(W2[vt], 0), Hh); Hh = MFMA32(b1, pk8(W2[vt], 1), Hh);
            store16bf(rec + s3::R_H + ((kt * 2 + vt) * 64 + lane) * 32, Hh); }
#pragma unroll
        for (int kp = 0; kp < 2; ++kp) { f32x16 G = MFMA32(pk8(W1[kp], 0), b0, ZERO16); G = MFMA32(pk8(W1[kp], 1), b1, G);
            *(bf16x8*)(rec + s3::R_G + (((kt * 2 + kp) * 2 + 0) * 64 + lane) * 16) = pk8(G, 0); *(bf16x8*)(rec + s3::R_G + (((kt * 2 + kp) * 2 + 1) * 64 + lane) * 16) = pk8(G, 1); } }
#undef S1_IMG
#undef Lc
}

struct S2Pre { bf16x8 R2p[4]; v4u Y02a, Y02b; };
__device__ __forceinline__ void s2_prefetch(S2Pre& p, const unsigned char* rec, int vt, int lane) {
#pragma unroll
    for (int s = 0; s < 4; ++s) p.R2p[s] = *(const bf16x8*)(rec + s3::R_R2 + (s * 64 + lane) * 16);
    p.Y02a = *(const v4u*)(rec + s3::R_Y02 + (vt * 64 + lane) * 32); p.Y02b = *(const v4u*)(rec + s3::R_Y02 + (vt * 64 + lane) * 32 + 16);
}
__device__ __forceinline__ void s2_chunk(LAS unsigned char* L, const unsigned char* rec, const S2Pre& p, LAS const float* gcrk, f32x16 (&ST)[2], const bf16* GB, bf16* OB, size_t row0, int h, int ntok, int vt, unsigned cnt, int lane_) {
    int lane = lane_; asm volatile("" : "+v"(lane));
    const int q = lane & 31, hi = lane >> 5;
    bf16x8 Gp[2][2][2];
#pragma unroll
    for (int mt = 0; mt < 2; ++mt)
#pragma unroll
        for (int kp = 0; kp < 2; ++kp) { Gp[mt][kp][0] = *(const bf16x8*)(rec + s3::R_G + (((mt * 2 + kp) * 2 + 0) * 64 + lane) * 16); Gp[mt][kp][1] = *(const bf16x8*)(rec + s3::R_G + (((mt * 2 + kp) * 2 + 1) * 64 + lane) * 16); }
    v4u Ha[2], Hb[2];
#pragma unroll
    for (int mt = 0; mt < 2; ++mt) { Ha[mt] = *(const v4u*)(rec + s3::R_H + ((mt * 2 + vt) * 64 + lane) * 32); Hb[mt] = *(const v4u*)(rec + s3::R_H + ((mt * 2 + vt) * 64 + lane) * 32 + 16); }
    const int tq = q < ntok ? q : 0;
    const bf16* gp = GB + (row0 + tq) * DM + h * HD + 32 * vt + 4 * hi; bf16* op = OB + (row0 + tq) * DM + h * HD + 32 * vt + 4 * hi;
    v4u Vp[2]; v2u gv[4];
#pragma unroll
    for (int e = 0; e < 2; ++e) Vp[e] = *(const v4u*)(rec + s3::R_V + ((2 * vt + e) * 64 + lane) * 16);
#pragma unroll
    for (int u = 0; u < 4; ++u) gv[u] = *(const v2u*)(gp + 8 * u);
    bf16x8 Sb[2][2];
#pragma unroll
    for (int kt = 0; kt < 2; ++kt) { Sb[kt][0] = pk8(ST[kt], 0); Sb[kt][1] = pk8(ST[kt], 1); }
    LAS float* YT = (LAS float*)(L + s3::YT + vt * 4608);
    {
        f32x16 Y = unpack16(p.Y02a, p.Y02b);
#pragma unroll
        for (int kt = 0; kt < 2; ++kt) { Y = MFMA32(p.R2p[2 * kt + 0], Sb[kt][0], Y); Y = MFMA32(p.R2p[2 * kt + 1], Sb[kt][1], Y); }
#pragma unroll
        for (int r = 0; r < 16; ++r) YT[crow(r, hi) * 36 + q] = Y[r];
    }
    {
        const int t = q, hh = hi;
        float y[16]; float s1 = 0.f, s2 = 0.f;
#pragma unroll
        for (int u = 0; u < 4; ++u) { const f32x4 v = *(LAS const f32x4*)(YT + t * 36 + 8 * u + 4 * hh); y[4 * u] = v.x; y[4 * u + 1] = v.y; y[4 * u + 2] = v.z; y[4 * u + 3] = v.w;
            s1 += (v.x + v.y) + (v.z + v.w); s2 += (v.x * v.x + v.y * v.y) + (v.z * v.z + v.w * v.w); }
        s1 = xhalf_sum(s1); s2 = xhalf_sum(s2);
        volatile LAS float* XCH = (volatile LAS float*)(L + s3::XCH);
        volatile LAS unsigned* FLG = (volatile LAS unsigned*)(L + s3::XCH + 1024);
        const int par = cnt & 1;
        if (hh == 0) { XCH[((par * 2 + vt) * 32 + t) * 2] = s1; XCH[((par * 2 + vt) * 32 + t) * 2 + 1] = s2; }
        asm volatile("s_waitcnt lgkmcnt(0)" ::: "memory");
        if (lane == 0) FLG[vt] = cnt + 1u;
        { unsigned spin = 0; while (FLG[vt ^ 1] < cnt + 1u) { __builtin_amdgcn_s_sleep(1); if (++spin > (1u << 22)) break; } }
        asm volatile("" ::: "memory");
        const float o1 = XCH[((par * 2 + (vt ^ 1)) * 32 + t) * 2], o2 = XCH[((par * 2 + (vt ^ 1)) * 32 + t) * 2 + 1];
        const float mean = (s1 + o1) * (1.0f / 64.0f), var = fmaxf((s2 + o2) * (1.0f / 64.0f) - mean * mean, 0.f);
        const float rstd = 1.0f / sqrtf(var + GN_EPS);
        const float rk = gcrk[64 + t];
        if (q < ntok) {
#pragma unroll
            for (int e = 0; e < 2; ++e) { const v4u vv = Vp[e];
                const float vf[8] = {bflo(vv.x), bfhi(vv.x), bflo(vv.y), bfhi(vv.y), bflo(vv.z), bfhi(vv.z), bflo(vv.w), bfhi(vv.w)};
#pragma unroll
                for (int e2 = 0; e2 < 2; ++e2) { const int u = 2 * e + e2, chb = 32 * vt + 8 * u + 4 * hh;
                    const f32x4 lg = *(LAS const f32x4*)(L + s3::PAR + 5 * 256 + chb * 4), lb = *(LAS const f32x4*)(L + s3::PAR + 6 * 256 + chb * 4);
                    const float gt[4] = {bflo(gv[u].x), bfhi(gv[u].x), bflo(gv[u].y), bfhi(gv[u].y)};
                    float o[4];
#pragma unroll
                    for (int j = 0; j < 4; ++j) o[j] = ((y[4 * u + j] - mean) * rstd * lg[j] + lb[j] + rk * vf[4 * e2 + j]) * gt[j];
                    v2u w; w.x = cvtpk(o[0], o[1]); w.y = cvtpk(o[2], o[3]); *(v2u*)(op + 8 * u) = w; } }
        }
    }
#pragma unroll
    for (int mt = 0; mt < 2; ++mt) { f32x16 acc = unpack16(Ha[mt], Hb[mt]);
#pragma unroll
        for (int g = 0; g < 4; ++g) { const f32x4 gc = *(LAS const f32x4*)(gcrk + 32 * mt + 8 * g + 4 * hi);
            acc[4 * g + 0] += gc.x * ST[mt][4 * g + 0]; acc[4 * g + 1] += gc.y * ST[mt][4 * g + 1]; acc[4 * g + 2] += gc.z * ST[mt][4 * g + 2]; acc[4 * g + 3] += gc.w * ST[mt][4 * g + 3]; }
#pragma unroll
        for (int kp = 0; kp < 2; ++kp) { acc = MFMA32(Gp[mt][kp][0], Sb[kp][0], acc); acc = MFMA32(Gp[mt][kp][1], Sb[kp][1], acc); }
        ST[mt] = acc; }
}

__device__ __forceinline__ void scan_wg(const Frame& F, const Args& AR, int w, bf16* OB_, unsigned& s2cnt) {
    LAS unsigned char* L = F.lds;
    int lane = lane_id(); asm volatile("" : "+v"(lane));
    const int wave = F.wave, tid = wave * 64 + lane;
    const bool sample = w >= 128;
    const int h = sample ? ((w - 128) * 32) >> 7 : (w & 15);
    const int nch = sample ? 1 : SEQ / 32, nitems = sample ? 32 : nch, ntok = sample ? DECS : 32;
    const bf16* PS = (const bf16*)(F.ws + WS_PS); const bf16* GB = (const bf16*)(F.ws + WS_GA);
    unsigned char* ring = F.ws + (sample ? WS_K + (size_t)(w - 128) * s3::RING_BYTES_WG : WS_RING + (size_t)w * s3::RING_BYTES_WG);
    __syncthreads();
    if (tid < 2) ((LAS unsigned*)(L + s3::XCH + 1024))[tid] = 0u;
    {
        const int j = tid >> 3, cb = (tid & 7) * 8;
        const float* p = AR.in[I_W2] + (size_t)j * DM + h * HD + cb; const f32x4 a0 = *(const f32x4*)p, a1 = *(const f32x4*)(p + 4);
        const float* p2 = AR.in[I_A2] + (size_t)j * DM + h * HD + cb; const f32x4 b0 = *(const f32x4*)p2, b1 = *(const f32x4*)(p2 + 4);
        const float wv[8] = {a0.x, a0.y, a0.z, a0.w, a1.x, a1.y, a1.z, a1.w}, av[8] = {b0.x, b0.y, b0.z, b0.w, b1.x, b1.y, b1.z, b1.w};
#pragma unroll
        for (int i = 0; i < 8; ++i) { *(LAS bf16*)(L + s3::W2T + (cb + i) * s3::P68 + 2 * j) = (bf16)cvtpk(wv[i], 0.f); *(LAS bf16*)(L + s3::A2T + (cb + i) * s3::P68 + 2 * j) = (bf16)cvtpk(av[i], 0.f); }
        for (int idx = tid; idx < 12 * 64; idx += NTHR) { const int arr = idx >> 6, c = idx & 63; const float* src;
            switch (arr) { case 0: src = AR.in[I_W0] + h * HD; break; case 1: src = AR.in[I_A0] + h * HD; break; case 2: src = AR.in[I_KK] + h * HD; break; case 3: src = AR.in[I_KA] + h * HD; break;
                case 4: src = AR.in[I_RK] + h * HD; break; case 5: src = AR.in[I_LNG] + h * HD; break; case 6: src = AR.in[I_LNB] + h * HD; break;
                case 7: src = AR.in[I_MU] + h * HD; break; case 8: src = AR.in[I_MU] + 1024 + h * HD; break; case 9: src = AR.in[I_MU] + 2048 + h * HD; break; case 10: src = AR.in[I_MU] + 3072; break; default: src = AR.in[I_MU] + 3136; break; }
            ((LAS float*)(L + s3::PAR))[idx] = src[c]; }
    }
    __syncthreads();
    const int nb = (nitems + 5) / 6;
    for (int j = 0; j <= nb; ++j) {
        int ln = lane; asm volatile("" : "+v"(ln));
        if (wave < 6) {
            const int item = 6 * j + wave;
            if (item < nitems) {
                int b, c; if (sample) { b = ((w - 128) * 32 + item) & 127; c = 0; } else { b = w >> 4; c = item; }
                const size_t row0 = sample ? (size_t)MP + (size_t)b * DECS : (size_t)b * SEQ + (size_t)c * 32;
                if (sample) s1_chunk<false>(AR, L, L + s3::SCR + wave * s3::SCRW, ring + (size_t)(item % s3::RING) * s3::R_SIZE, (LAS float*)(L + s3::GCRK) + (item % s3::RING) * 96, PS, row0, c == 0 ? (sample ? (const bf16*)(F.ws + WS_SROW) + (size_t)b * SHW : (const bf16*)(F.ws + WS_ZROW)) : nullptr, h, ntok, ln);
                else s1_chunk<true>(AR, L, L + s3::SCR + wave * s3::SCRW, ring + (size_t)(item % s3::RING) * s3::R_SIZE, (LAS float*)(L + s3::GCRK) + (item % s3::RING) * 96, PS, row0, c == 0 ? (sample ? (const bf16*)(F.ws + WS_SROW) + (size_t)b * SHW : (const bf16*)(F.ws + WS_ZROW)) : nullptr, h, ntok, ln);
            }
        } else if (j >= 1) {
            const int vt = wave - 6;
            LAS f32x4* STS = (LAS f32x4*)(L + SMALL_OFF) + vt * 512 + ln;
            f32x16 ST[2];
#pragma unroll
            for (int a = 0; a < 2; ++a)
#pragma unroll
                for (int g = 0; g < 4; ++g) { const f32x4 x = STS[(a * 4 + g) * 64]; ST[a][4 * g + 0] = x.x; ST[a][4 * g + 1] = x.y; ST[a][4 * g + 2] = x.z; ST[a][4 * g + 3] = x.w; }
            const int i0 = 6 * (j - 1);
            for (int i = 0; i < 6; ++i) { const int item = i0 + i; if (item >= nitems) break;
                int b, c; if (sample) { b = ((w - 128) * 32 + item) & 127; c = 0; } else { b = w >> 4; c = item; }
                const size_t row0 = sample ? (size_t)MP + (size_t)b * DECS : (size_t)b * SEQ + (size_t)c * 32;
                const int q = ln & 31, hi = ln >> 5;
                if (c == 0) {
#pragma unroll
                    for (int kt = 0; kt < 2; ++kt) { ST[kt] = ZERO16;
                        if (sample) { const float* sp = AR.in[I_SWKV] + ((size_t)(b * NH + h) * HD + 32 * vt + q) * HD + 32 * kt + 4 * hi;
#pragma unroll
                            for (int g = 0; g < 4; ++g) { const f32x4 x = *(const f32x4*)(sp + 8 * g); ST[kt][4 * g + 0] = x.x; ST[kt][4 * g + 1] = x.y; ST[kt][4 * g + 2] = x.z; ST[kt][4 * g + 3] = x.w; } } }
                }
                S2Pre cur; s2_prefetch(cur, ring + (size_t)(item % s3::RING) * s3::R_SIZE, vt, ln);
                s2_chunk(L, ring + (size_t)(item % s3::RING) * s3::R_SIZE, cur, (LAS const float*)(L + s3::GCRK) + (item % s3::RING) * 96, ST, GB, OB_, row0, h, ntok, vt, (unsigned)item, ln);
                if (c == nch - 1) {
                    float* dp = F.out + (sample ? O_SWKV : O_PWKV) + (size_t)(b * NH + h) * HD * HD;
#pragma unroll
                    for (int kt = 0; kt < 2; ++kt)
#pragma unroll
                        for (int g = 0; g < 4; ++g) *(f32x4*)(dp + (size_t)(32 * vt + q) * HD + 32 * kt + 8 * g + 4 * hi) = (f32x4){ST[kt][4 * g + 0], ST[kt][4 * g + 1], ST[kt][4 * g + 2], ST[kt][4 * g + 3]};
                }
            }
#pragma unroll
            for (int a = 0; a < 2; ++a)
#pragma unroll
                for (int g = 0; g < 4; ++g) STS[(a * 4 + g) * 64] = (f32x4){ST[a][4 * g + 0], ST[a][4 * g + 1], ST[a][4 * g + 2], ST[a][4 * g + 3]};
        }
        asm volatile("s_waitcnt vmcnt(0)" ::: "memory");
        __syncthreads();
    }
}
__device__ __forceinline__ void final_norm(const Frame& F, const Args& AR, float* dst) {
    const int gw = F.vcu * NWAVES + F.wave, NGW = F.G * NWAVES;
    const float* ss = (const float*)(F.ws + WS_SS); const int lane = lane_id(); const GAS f32x4* gr = (const GAS f32x4*)AR.in[I_FING] + lane;
    for (int m = gw; m < MT; m += NGW) {
        const float sc = 1.0f / sqrtf(ss[m] * (1.f / DM) + NORM_EPS);
        GAS f32x4* xr = (GAS f32x4*)(F.out + (size_t)m * DM) + lane;
        GAS f32x4* yr = (GAS f32x4*)(dst + (size_t)m * DM) + lane;
#pragma unroll
        for (int j = 0; j < 4; ++j) { const f32x4 v = xr[64 * j], g = gr[64 * j]; yr[64 * j] = v * sc * g; }
    }
}

#ifndef MK_PER_PHASE
#define MK_PER_PHASE 0
#endif
constexpr int N_PHASES = 9;
__global__ void __launch_bounds__(NTHR, 2) hybrid_fwd(Args args) {
    extern __shared__ __attribute__((aligned(16))) unsigned char lds[];
    Frame F;
    F.lds = (LAS unsigned char*)lds;
    F.wave = __builtin_amdgcn_readfirstlane(threadIdx.x >> 6);
    F.G = gridDim.x; { const int bx = blockIdx.x; F.vcu = (F.G % 8 == 0) ? (bx % 8) * (F.G / 8) + bx / 8 : bx; }
    F.out = args.out; F.ws = args.ws;
    volatile LAS unsigned* MISC = (volatile LAS unsigned*)(F.lds + MISC_OFF);
    for (int u = threadIdx.x; u < (LDS_BYTES - LDSCTL_OFF) / 4; u += NTHR) ((LAS unsigned*)(F.lds + LDSCTL_OFF))[u] = 0u;
    __syncthreads();
    XcdBarrier bar; bar.bar = (unsigned*)(F.ws + WS_CTL) + CW_BAR; bar.x = 0; bar.st = nullptr;
    if (!MK_PER_PHASE) bar = xcd_barrier_post((unsigned*)(F.ws + WS_CTL) + CW_BAR, MISC + 8);
    const int lo = args.ph_lo, hi = args.ph_hi;
#ifndef DUP
#define DUP 0
#endif
#define REP(k) for (int rep_ = ((DUP >> (k)) & 1) ? 0 : 1; rep_ < 2; ++rep_)
#ifndef PHMASK
#define PHMASK 0x1ff
#endif
#define IN(k) ((((PHMASK) >> (k)) & 1) && lo <= (k) && (k) < hi)
#define SEAM(k) do { if (IN(k) && IN((k) + 1)) xcd_barrier(bar, F.wave == 0 && lane_id() == 0); } while (0)

    if (IN(0)) { REP(0) p0_prologue(F, args); }
    SEAM(0);
    if (IN(1)) {
        pg8::Gemm g{(const bf16*)(F.ws + WS_XN), (const bf16*)(F.ws + WS_W1T), MT, N1A, DM}; pg8::StaticOrder S; S.init(MT, N1A, F.G, (int)blockIdx.x);
        EpiG1 E{0, F.ws, F.out, 0};
        REP(1) pg8::gemm_phase<EpiG1, pg8::StaticOrder, true, true>(F.lds, g, S, E, F.wave);
    }
    SEAM(1);
    if (IN(2)) { REP(2) { bf16* ob = (bf16*)(F.ws + (rep_ ? WS_Q : WS_PS)); attn_phase(F, args, ob); } }
    SEAM(2);
    if (IN(3)) {
        pg8::Gemm g{(const bf16*)(F.ws + WS_XN), (const bf16*)(F.ws + WS_W1T) + (size_t)N1A * DM, MT, 17 * 256, DM}; pg8::StaticOrder S; S.init(MT, 17 * 256, F.G, (int)blockIdx.x);
        EpiG1 E{1, F.ws, F.out, 0};
        REP(3) pg8::gemm_phase<EpiG1, pg8::StaticOrder, true, true>(F.lds, g, S, E, F.wave);
    }
    SEAM(3);
    if (IN(4)) { unsigned s2cnt = 0; const int bx = (int)blockIdx.x;
        REP(4) { bf16* ob = (bf16*)(F.ws + (rep_ ? WS_GA : WS_PS + (size_t)MT * SHW * 2 - (size_t)MT * DM * 2)); for (int w = bx; w < 192; w += F.G) scan_wg(F, args, w, ob, s2cnt); }
        if (F.G >= 256 ? bx >= 128 : true) {
            ShareOrder S;
            if (F.G >= 256) { if (bx < 192) S.init(MT, DM, 192, bx - 128, 1); else if (bx < 256) S.init(MT, DM, 192, 64 + 2 * (bx - 192), 2); else S.init(MT, DM, 192, 1 << 20, 1); }
            else S.init(MT, DM, F.G, bx, 1);
            { pg8::Gemm g{(const bf16*)(F.ws + WS_XN), (const bf16*)(F.ws + WS_W1T) + (size_t)6912 * DM, MT, DM, DM}; EpiG1 E{1, F.ws, F.out, 17};
              pg8::gemm_phase<EpiG1, ShareOrder, true, true>(F.lds, g, S, E, F.wave); }
            { pg8::Gemm g{(const bf16*)(F.ws + WS_Q), (const bf16*)(F.ws + WS_WAT), MT, DM, DM}; EpiGate E{0, (const bf16*)F.out, nullptr, (bf16*)F.out};
              REP(5) pg8::gemm_phase<EpiGate, ShareOrder, true, true>(F.lds, g, S, E, F.wave); }
            { pg8::Gemm g{(const bf16*)(F.ws + WS_XN), (const bf16*)(F.ws + WS_W1T) + (size_t)7936 * DM, MT, DM, DM}; EpiG1 E{1, F.ws, F.out, 21};
              pg8::gemm_phase<EpiG1, ShareOrder, true, true>(F.lds, g, S, E, F.wave); }
        } }
    SEAM(4);
    if (IN(6)) {
        pg8::Gemm g{(const bf16*)(F.ws + WS_GA), (const bf16*)(F.ws + WS_WBT), MT, DM, DM}; pg8::StaticOrder S; S.init(MT, DM, F.G, (int)blockIdx.x);
        EpiGate E{1, (const bf16*)F.out + (size_t)MT * DM, (const bf16*)F.out, (bf16*)(F.ws + WS_XN)};
        REP(6) pg8::gemm_phase<EpiGate, pg8::StaticOrder, true, true>(F.lds, g, S, E, F.wave);
    }
    SEAM(6);
    if (IN(7)) {
        pg8::Gemm g{(const bf16*)(F.ws + WS_XN), (const bf16*)(F.ws + WS_WOT), MT, DM, DM}; pg8::StaticOrder S; S.init(MT, DM, F.G, (int)blockIdx.x);
        REP(7) { EpiOut E{args.in[I_XP], args.in[I_XS], F.out, (float*)(F.ws + WS_SS + (rep_ ? 0 : 192 * 1024))};
        pg8::gemm_phase<EpiOut, pg8::StaticOrder, true, true>(F.lds, g, S, E, F.wave); }
    }
    SEAM(7);
    if (IN(8)) { REP(8) final_norm(F, args, rep_ ? F.out : (float*)(F.ws + WS_PS)); }
#undef IN
#undef SEAM
}

extern "C" void kernel_launch(void* const* d_in, const int* in_sizes, int n_in, void* d_out, int out_size, void* d_ws, size_t ws_size, hipStream_t stream) {
    static int grid = 0;
    if (grid == 0) {
        if (n_in != 24 || (size_t)out_size != O_END || ws_size < WS_END) { fprintf(stderr, "kernel_launch: unexpected sizes: n_in %d out %d ws %zu (need %zu)\n", n_in, out_size, ws_size, (size_t)WS_END); grid = -1; return; }
        int dev = 0, cus = 0;
        if (hipGetDevice(&dev) != hipSuccess || hipDeviceGetAttribute(&cus, hipDeviceAttributeMultiprocessorCount, dev) != hipSuccess) { grid = -1; return; }
        if (hipFuncSetAttribute((const void*)hybrid_fwd, hipFuncAttributeMaxDynamicSharedMemorySize, LDS_BYTES) != hipSuccess) { fprintf(stderr, "kernel_launch: hipFuncSetAttribute failed\n"); grid = -1; return; }
        int per_cu = 0;
        if (hipOccupancyMaxActiveBlocksPerMultiprocessor(&per_cu, (const void*)hybrid_fwd, NTHR, LDS_BYTES) != hipSuccess || per_cu < 1) fprintf(stderr, "kernel_launch: occupancy query says %d\n", per_cu);
        (void)hipGetLastError();
        grid = cus;
    }
    if (grid < 0) return;
    (void)hipMemsetAsync((char*)d_ws + WS_CTL, 0, CTL_ZERO_BYTES, stream);
    Args a{};
    for (int i = 0; i < 24; ++i) a.in[i] = (const float*)d_in[i];
    a.out = (float*)d_out; a.ws = (unsigned char*)d_ws;
#if MK_PER_PHASE
    for (int p = 0; p < N_PHASES; ++p) { a.ph_lo = p; a.ph_hi = p + 1; hipLaunchKernelGGL(hybrid_fwd, dim3(grid), dim3(NTHR), LDS_BYTES, stream, a); }
#else
    a.ph_lo = 0; a.ph_hi = N_PHASES; hipLaunchKernelGGL(hybrid_fwd, dim3(grid), dim3(NTHR), LDS_BYTES, stream, a);
#endif
}
```
